# Optimizing an MI355X kernel written in HIP

```python
import jax
import jax.numpy as jnp
from jax import lax
import numpy as np

D_MODEL = 1024
BATCH = 8
SEQ = 4096
DEPTH = 1

GRID_W = 64
CTX_LEN = 256
D_MIX = D_MODEL
D_FOURIER = D_MIX // 2
FOURIER_GROUPS = 4
FOURIER_GD = D_FOURIER // FOURIER_GROUPS
D_RG = D_MIX - D_FOURIER
RG_HEADS = 8
RG_HD = D_RG // RG_HEADS
D_IN = D_FOURIER + 2 * D_RG
CONV_W = 4
CONV_PAD_LO = 2
CONV_PAD_HI = CONV_W - 1 - CONV_PAD_LO
RG_C = 8.0
N_EXPERTS = 32
TOP_K = 4
D_FF = D_MODEL
SWIGLU_LIMIT = 7.0
SWIGLU_ALPHA = 1.702
MOE_BLOCK = 256
N_MOD = 6
EPS = 1e-6

kernel_name = 'hybrid_fourier_rglru_moe_dit'


def rmsnorm(x, g):
    xf = x.astype(jnp.float32)
    y = xf * lax.rsqrt(jnp.mean(xf * xf, axis=-1, keepdims=True) + EPS)
    return (y * g.astype(jnp.float32)).astype(x.dtype)


def modulate(h, shift, scale):
    return h * (1 + scale) + shift


def adaln_params(cond, w_mod, b_mod):
    m = jax.nn.silu(cond) @ w_mod + b_mod
    return [t[..., None, :] for t in jnp.split(m, N_MOD, axis=-1)]


def serpentine(t):
    b, n, ch = t.shape
    rows = n // GRID_W
    g = t.reshape(b, rows, GRID_W, ch)
    odd = (jnp.arange(rows) % 2 == 1)[None, :, None, None]
    return jnp.where(odd, g[:, :, ::-1], g).reshape(b, n, ch)


def dwconv_centred(t, w, bias):
    n = t.shape[1]
    tp = jnp.pad(t, ((0, 0), (CONV_PAD_LO, CONV_PAD_HI), (0, 0)))
    out = tp[:, 0:n] * w[0]
    for k in range(1, CONV_W):
        out = out + tp[:, k:k + n] * w[k]
    return out + bias


def blockdiag(t, w, bias):
    b, n, _ = t.shape
    th = t.reshape(b, n, RG_HEADS, RG_HD)
    return jnp.einsum('bnhi,hij->bnhj', th, w).reshape(b, n, D_RG) + bias


def rglru_coeffs(xc, w_a, b_a, w_x, b_x, lam):
    f32 = jnp.float32
    r = jax.nn.sigmoid(blockdiag(xc, w_a.astype(f32), b_a.astype(f32)))
    i = jax.nn.sigmoid(blockdiag(xc, w_x.astype(f32), b_x.astype(f32)))
    log_a = -RG_C * r * jax.nn.softplus(-lam.astype(f32))
    a = jnp.exp(log_a)
    drive = jnp.sqrt(-jnp.expm1(2.0 * log_a)) * (i * xc)
    return a, drive


def linear_recurrence(a, drive, h0):
    drive = drive.at[:, 0].add(a[:, 0] * h0)

    def combine(left, right):
        return (left[0] * right[0], right[0] * left[1] + right[1])

    _, h = lax.associative_scan(combine, (a, drive), axis=1)
    return h


def rglru_bidirectional(xr_lat, xr_ctx, conv_w, conv_b, w_a, b_a, w_x, b_x, lam):
    xc_lat = dwconv_centred(xr_lat, conv_w, conv_b).astype(jnp.float32)
    xc_ctx = dwconv_centred(xr_ctx, conv_w, conv_b).astype(jnp.float32)
    h0 = jnp.zeros((xr_ctx.shape[0], D_RG), jnp.float32)
    ys_lat = []
    ys_ctx = []
    for d in range(2):
        flip = (lambda t: t[:, ::-1]) if d == 1 else (lambda t: t)
        a_c, u_c = rglru_coeffs(flip(xc_ctx), w_a[d], b_a[d], w_x[d], b_x[d], lam[d])
        a_l, u_l = rglru_coeffs(flip(xc_lat), w_a[d], b_a[d], w_x[d], b_x[d], lam[d])
        h_c = linear_recurrence(a_c, u_c, h0)
        h_l = linear_recurrence(a_l, u_l, h_c[:, -1])
        ys_ctx.append(flip(h_c))
        ys_lat.append(flip(h_l))
    return ys_lat[0] + ys_lat[1], ys_ctx[0] + ys_ctx[1]


def fourier_mix(u, w_f):
    b, n, _ = u.shape
    g = u.astype(jnp.float32).reshape(b, n, FOURIER_GROUPS, FOURIER_GD)
    f = jnp.fft.fft2(g, axes=(1, 3), norm='ortho').real
    out = jnp.einsum('bngi,gij->bngj', f, w_f.astype(jnp.float32))
    return out.reshape(b, n, D_FOURIER).astype(u.dtype)


def merge_heads(fourier_out, rg_out, g_out_f, g_out_r, w_out):
    cat = jnp.concatenate([rmsnorm(fourier_out, g_out_f), rmsnorm(rg_out, g_out_r)], axis=-1)
    return cat @ w_out


def token_mixer(h_lat, h_ctx, w_in, w_fourier, conv_w, conv_b, rg_w_a, rg_b_a, rg_w_x, rg_b_x,
                rg_lam, g_out_f, g_out_r, w_out, with_ctx_out):
    cuts = [D_FOURIER, D_FOURIER + D_RG]
    f_lat, xr_lat, gr_lat = jnp.split(h_lat @ w_in, cuts, axis=-1)
    f_ctx, xr_ctx, gr_ctx = jnp.split(h_ctx @ w_in, cuts, axis=-1)
    rg_lat_s, rg_ctx = rglru_bidirectional(serpentine(xr_lat), xr_ctx, conv_w, conv_b,
                                           rg_w_a, rg_b_a, rg_w_x, rg_b_x, rg_lam)
    rg_lat = serpentine(rg_lat_s).astype(h_lat.dtype) * jax.nn.gelu(gr_lat)
    out_lat = merge_heads(fourier_mix(f_lat, w_fourier), rg_lat, g_out_f, g_out_r, w_out)
    if not with_ctx_out:
        return out_lat, None
    rg_c = rg_ctx.astype(h_ctx.dtype) * jax.nn.gelu(gr_ctx)
    out_ctx = merge_heads(fourier_mix(f_ctx, w_fourier), rg_c, g_out_f, g_out_r, w_out)
    return out_lat, out_ctx


def moe_ffn(h, w_router, b_router, w_gu, b_gu, w_down, b_down):
    shp = h.shape
    hf = h.reshape(-1, D_MODEL)
    n_tok = hf.shape[0]
    logits = (hf @ w_router).astype(jnp.float32) + b_router.astype(jnp.float32)
    top_val, top_idx = lax.top_k(logits, TOP_K)
    gates = jax.nn.softmax(top_val, axis=-1)
    n_assign = n_tok * TOP_K
    e_flat = top_idx.reshape(-1).astype(jnp.int32)
    tok_flat = jnp.arange(n_assign, dtype=jnp.int32) // TOP_K
    g_flat = gates.reshape(-1)
    order = jnp.argsort(e_flat)
    e_sorted = e_flat[order]
    counts = jnp.bincount(e_flat, length=N_EXPERTS).astype(jnp.int32)
    padded = (counts + MOE_BLOCK - 1) // MOE_BLOCK * MOE_BLOCK
    pad_end = jnp.cumsum(padded)
    pad_start = pad_end - padded
    grp_start = jnp.cumsum(counts) - counts
    dest = pad_start[e_sorted] + jnp.arange(n_assign, dtype=jnp.int32) - grp_start[e_sorted]
    n_blocks = -(-n_assign // MOE_BLOCK) + N_EXPERTS
    cap = n_blocks * MOE_BLOCK
    row_tok = jnp.zeros((cap,), jnp.int32).at[dest].set(tok_flat[order])
    row_gate = jnp.zeros((cap,), jnp.float32).at[dest].set(g_flat[order])
    blk_start = jnp.arange(n_blocks, dtype=jnp.int32) * MOE_BLOCK
    blk_expert = jnp.minimum(jnp.searchsorted(pad_end, blk_start, side='right'), N_EXPERTS - 1)

    def run_block(args):
        tok, gate, e = args
        xb = hf[tok]
        gu = xb @ w_gu[e] + b_gu[e]
        gt = jnp.minimum(gu[:, :D_FF], SWIGLU_LIMIT)
        up = jnp.clip(gu[:, D_FF:], -SWIGLU_LIMIT, SWIGLU_LIMIT)
        act = (up + 1) * (gt * jax.nn.sigmoid(SWIGLU_ALPHA * gt))
        out = act @ w_down[e] + b_down[e]
        return (out * gate[:, None]).astype(hf.dtype)

    outs = lax.map(run_block, (row_tok.reshape(n_blocks, MOE_BLOCK),
                               row_gate.reshape(n_blocks, MOE_BLOCK), blk_expert))
    y = jnp.zeros_like(hf).at[row_tok].add(outs.reshape(cap, D_MODEL))
    return y.reshape(shp)


def setup_inputs(seed: int = 0) -> dict:
    key = jax.random.key(seed)
    ks = jax.random.split(key, 32)

    def nrm(k, shape, scale):
        return jax.random.normal(k, shape, jnp.float32) * scale

    u = jax.random.uniform(ks[14], (DEPTH, 2, D_RG), jnp.float32, 0.9, 0.999)
    a0 = u ** (1.0 / RG_C)
    rg_lam = jnp.log(a0) - jnp.log1p(-a0)
    return {
        'x': nrm(ks[0], (BATCH, SEQ, D_MODEL), 1.0),
        'c': nrm(ks[1], (BATCH, D_MODEL), 1.0),
        'ctx': nrm(ks[2], (BATCH, CTX_LEN, D_MODEL), 1.0),
        'c_ctx': nrm(ks[3], (D_MODEL,), 1.0),
        'w_mod': nrm(ks[4], (DEPTH, D_MODEL, N_MOD * D_MODEL), 0.5 * D_MODEL ** -0.5),
        'b_mod': nrm(ks[5], (DEPTH, N_MOD * D_MODEL), 0.02),
        'g_norm_mix': 1.0 + nrm(ks[6], (DEPTH, D_MODEL), 0.02),
        'g_norm_ffn': 1.0 + nrm(ks[7], (DEPTH, D_MODEL), 0.02),
        'w_in': nrm(ks[8], (DEPTH, D_MODEL, D_IN), D_MODEL ** -0.5),
        'w_fourier': nrm(ks[9], (DEPTH, FOURIER_GROUPS, FOURIER_GD, FOURIER_GD), FOURIER_GD ** -0.5),
        'conv_w': nrm(ks[10], (DEPTH, CONV_W, D_RG), CONV_W ** -0.5),
        'conv_b': nrm(ks[11], (DEPTH, D_RG), 0.02),
        'rg_w_a': nrm(ks[12], (DEPTH, 2, RG_HEADS, RG_HD, RG_HD), RG_HD ** -0.5),
        'rg_b_a': nrm(ks[13], (DEPTH, 2, D_RG), 0.02),
        'rg_w_x': nrm(ks[15], (DEPTH, 2, RG_HEADS, RG_HD, RG_HD), RG_HD ** -0.5),
        'rg_b_x': nrm(ks[16], (DEPTH, 2, D_RG), 0.02),
        'rg_lam': rg_lam,
        'g_out_fourier': 1.0 + nrm(ks[17], (DEPTH, D_FOURIER), 0.02),
        'g_out_rg': 1.0 + nrm(ks[18], (DEPTH, D_RG), 0.02),
        'w_out': nrm(ks[19], (DEPTH, D_MIX, D_MODEL), D_MIX ** -0.5),
        'w_router': nrm(ks[20], (DEPTH, D_MODEL, N_EXPERTS), D_MODEL ** -0.5),
        'b_router': nrm(ks[21], (DEPTH, N_EXPERTS), 0.01),
        'w_gate_up': nrm(ks[22], (DEPTH, N_EXPERTS, D_MODEL, 2 * D_FF), D_MODEL ** -0.5),
        'b_gate_up': nrm(ks[23], (DEPTH, N_EXPERTS, 2 * D_FF), 0.01),
        'w_down': nrm(ks[24], (DEPTH, N_EXPERTS, D_FF, D_MODEL), D_FF ** -0.5),
        'b_down': nrm(ks[25], (DEPTH, N_EXPERTS, D_MODEL), 0.01),
        'g_final': 1.0 + nrm(ks[26], (D_MODEL,), 0.02),
    }


def reference(x, c, ctx, c_ctx, w_mod, b_mod, g_norm_mix, g_norm_ffn, w_in, w_fourier, conv_w,
              conv_b, rg_w_a, rg_b_a, rg_w_x, rg_b_x, rg_lam, g_out_fourier, g_out_rg, w_out,
              w_router, b_router, w_gate_up, b_gate_up, w_down, b_down, g_final):
    y = ctx
    for i in range(DEPTH):
        last = i == DEPTH - 1
        sh_m, sc_m, gt_m, sh_f, sc_f, gt_f = adaln_params(c, w_mod[i], b_mod[i])
        csh_m, csc_m, cgt_m, csh_f, csc_f, cgt_f = adaln_params(c_ctx, w_mod[i], b_mod[i])
        h_lat = modulate(rmsnorm(x, g_norm_mix[i]), sh_m, sc_m)
        h_ctx = modulate(rmsnorm(y, g_norm_mix[i]), csh_m, csc_m)
        mix_lat, mix_ctx = token_mixer(h_lat, h_ctx, w_in[i], w_fourier[i], conv_w[i], conv_b[i],
                                       rg_w_a[i], rg_b_a[i], rg_w_x[i], rg_b_x[i], rg_lam[i],
                                       g_out_fourier[i], g_out_rg[i], w_out[i], not last)
        x = x + gt_m * mix_lat
        h = modulate(rmsnorm(x, g_norm_ffn[i]), sh_f, sc_f)
        x = x + gt_f * moe_ffn(h, w_router[i], b_router[i], w_gate_up[i], b_gate_up[i],
                               w_down[i], b_down[i])
        if not last:
            y = y + cgt_m * mix_ctx
            hc = modulate(rmsnorm(y, g_norm_ffn[i]), csh_f, csc_f)
            y = y + cgt_f * moe_ffn(hc, w_router[i], b_router[i], w_gate_up[i], b_gate_up[i],
                                    w_down[i], b_down[i])
    return rmsnorm(x, g_final)
```

```cpp
#include <hip/hip_runtime.h>
#include <stdint.h>
#include <stdio.h>

#define DI __device__ __forceinline__
#define LAS __attribute__((address_space(3)))
typedef unsigned short bf16_t;
typedef short bf16x8 __attribute__((ext_vector_type(8)));
typedef float f32x4 __attribute__((ext_vector_type(4)));
typedef float f32x16 __attribute__((ext_vector_type(16)));
typedef unsigned u32x4 __attribute__((ext_vector_type(4)));
typedef unsigned u32x2 __attribute__((ext_vector_type(2)));

constexpr int D = 1024, NB = 8, SEQ = 4096, T = NB * SEQ, CTXL = 256, TC = NB * CTXL, TT = T + TC;
constexpr int DR = 512, NE = 32;
constexpr int CAP = (T * 4 / 256 + NE) * 256;
constexpr int NCH = 68;
constexpr float EPS = 1e-6f;
#ifndef N_LAUNCH_MODE
#define N_LAUNCH_MODE 0
#endif
constexpr int NPHASE = 11;

constexpr size_t MiB = 1u << 20;
constexpr size_t WS_CTL = 0, CTL_BYTES = 1 * MiB;
constexpr size_t WS_MOD = 1 * MiB;
constexpr size_t WS_RGW = 1 * MiB + 256 * 1024;
constexpr size_t WS_TILE = 1 * MiB + 512 * 1024;
constexpr size_t WS_CNT = 2 * MiB;
constexpr size_t WS_TOKE = 3 * MiB;
constexpr size_t WS_TOKG = 3 * MiB + 512 * 1024;
constexpr size_t WS_TOKS = 4 * MiB;
constexpr size_t WS_ROWTOK = 4 * MiB + 512 * 1024;
constexpr size_t WS_ROWGATE = 5 * MiB + 256 * 1024;
constexpr size_t WS_SUMP = 6 * MiB;
constexpr size_t WS_SUMH = 8 * MiB + 256 * 1024;
constexpr size_t WS_WIN2 = 11 * MiB;
constexpr size_t WS_WFS = 13 * MiB;
constexpr size_t WS_WOUT = 15 * MiB;
constexpr size_t WS_WDOWN = 17 * MiB;
constexpr size_t WS_X1 = 81 * MiB;
constexpr size_t WS_YA = 209 * MiB;
constexpr size_t WS_WGU = 481 * MiB;
constexpr size_t WS_H = 609 * MiB;
constexpr size_t WS_DFT = 677 * MiB;
constexpr size_t WS_XRGR = 741 * MiB;
constexpr size_t WS_UT = 809 * MiB;
constexpr size_t WS_FO = 873 * MiB;
constexpr size_t WS_SS = 905 * MiB;
constexpr size_t WS_CAF = 937 * MiB;
constexpr size_t WS_CAB = 969 * MiB;
constexpr size_t WS_ACT = 677 * MiB;
constexpr size_t WS_END = 1001 * MiB;
static_assert(WS_ACT + (size_t)CAP * 2048 <= WS_END && WS_YA + (size_t)CAP * 2048 <= WS_WGU && WS_ROWGATE + CAP * 4 <= WS_SUMP && WS_SUMH + 8 * 2 * 68 * 512 * 4 <= WS_WIN2, "ws map");

constexpr int CW_BAR = 4096;
constexpr int LDS_BYTES = 147456;
constexpr int MISC_OFF = 135168;

DI unsigned cvt_pk_bf16(float lo, float hi) { unsigned r; asm("v_cvt_pk_bf16_f32 %0, %1, %2" : "=v"(r) : "v"(lo), "v"(hi)); return r; }
DI float bflo(unsigned w) { return __uint_as_float(w << 16); }
DI float bfhi(unsigned w) { return __uint_as_float(w & 0xffff0000u); }
DI float bf2f(bf16_t b) { return __uint_as_float(((unsigned)b) << 16); }
DI bf16_t f2bf(float f) { return (bf16_t)(cvt_pk_bf16(f, 0.f) & 0xffffu); }
DI float wave_sum(float v) { v += __shfl_xor(v, 32); v += __shfl_xor(v, 16); v += __shfl_xor(v, 8); v += __shfl_xor(v, 4); v += __shfl_xor(v, 2); v += __shfl_xor(v, 1); return v; }
DI float sigmoidf_(float x) { return 1.0f / (1.0f + __expf(-x)); }
DI float gelu_tanh(float x) { const float z = 0.7978845608028654f * (x + 0.044715f * x * x * x); const float e = __expf(2.0f * z); return 0.5f * x * (2.0f - 2.0f / (1.0f + e)); }

#define XB_TMO      128
#define XB_XCNT(j)  (256  + 64 * (j))
#define XB_XSUB(j)  (1280 + 64 * (j))
#define XB_XGEN(j)  (2304 + 64 * (j))
#define XB_TOP      3328
#define XB_TOPGEN   3392
#define XCD_BAR_WORDS 3456
#define XB_SPIN_CAP (1u << 18)
DI unsigned xb_ld(unsigned* p)              { return __hip_atomic_load(p, __ATOMIC_RELAXED, __HIP_MEMORY_SCOPE_AGENT); }
DI unsigned xb_add(unsigned* p, unsigned v) { return __hip_atomic_fetch_add(p, v, __ATOMIC_RELAXED, __HIP_MEMORY_SCOPE_AGENT); }
DI unsigned xb_xcc_id() { return (unsigned)__builtin_amdgcn_s_getreg((3 << 11) | 20) & 0xFu; }
#define XB_SPIN(cond, bar) do { unsigned _sp = 0; while (cond) { __builtin_amdgcn_s_sleep(1); \
    if ((++_sp & 255u) == 0u) { if (xb_ld(&(bar)[XB_TMO])) break; if (_sp > XB_SPIN_CAP) { atomicAdd(&(bar)[XB_TMO], 1u); break; } } } } while (0)
struct XcdBarrier { unsigned* bar; unsigned x; volatile LAS unsigned* st; };
DI XcdBarrier xcd_barrier_post(unsigned* bar, volatile LAS unsigned* st) {
    XcdBarrier b; b.bar = bar; b.x = xb_xcc_id(); b.st = st;
    if (threadIdx.x == 0) (void)xb_add(&bar[XB_XCNT(b.x)], 1u);
    return b;
}
DI void xcd_barrier_complete(unsigned* bar, unsigned x, unsigned& nloc, unsigned& nx) {
    const unsigned G = gridDim.x * gridDim.y * gridDim.z;
    unsigned sum, cnt, mine, sp = 0u;
    for (;;) {
        sum = 0u; cnt = 0u; mine = 0u;
#pragma unroll
        for (unsigned j = 0; j < 16; ++j) { const unsigned c = xb_ld(&bar[XB_XCNT(j)]); sum += c; cnt += (c > 0u) ? 1u : 0u; mine = (j == x) ? c : mine; }
        if (sum == G) break;
        __builtin_amdgcn_s_sleep(1);
        if ((++sp & 255u) == 0u) { if (xb_ld(&bar[XB_TMO])) break; if (sp > XB_SPIN_CAP) { atomicAdd(&bar[XB_TMO], 1u); break; } }
    }
    nloc = mine > 0u ? mine : 1u; nx = cnt > 0u ? cnt : 1u;
}
DI void xcd_barrier(const XcdBarrier& b) {
    asm volatile("s_waitcnt vmcnt(0)" ::: "memory");
    __syncthreads();
    if (threadIdx.x == 0) {
        unsigned* bar = b.bar;
        __builtin_amdgcn_s_waitcnt(0);
        unsigned nloc = b.st[0], nx = b.st[1];
        if (nloc == 0u) { xcd_barrier_complete(bar, b.x, nloc, nx); b.st[0] = nloc; b.st[1] = nx; }
        const unsigned old = xb_add(&bar[XB_XSUB(b.x)], 1u);
        const unsigned gen = old / nloc;
        if (old + 1u == (gen + 1u) * nloc) {
            __builtin_amdgcn_fence(__ATOMIC_RELEASE, "agent");
            asm volatile("s_waitcnt vmcnt(0)" ::: "memory");
            const unsigned og = xb_add(&bar[XB_TOP], 1u);
            const unsigned tg = og / nx;
            if (og + 1u == (tg + 1u) * nx) xb_add(&bar[XB_TOPGEN], 1u);
            else XB_SPIN(xb_ld(&bar[XB_TOPGEN]) == tg, bar);
            __builtin_amdgcn_fence(__ATOMIC_ACQUIRE, "agent");
            xb_add(&bar[XB_XGEN(b.x)], 1u);
            asm volatile("s_waitcnt vmcnt(0)" ::: "memory");
        } else {
            XB_SPIN(xb_ld(&bar[XB_XGEN(b.x)]) == gen, bar);
            __builtin_amdgcn_fence(__ATOMIC_ACQUIRE, "agent");
            asm volatile("s_waitcnt vmcnt(0)" ::: "memory");
        }
    }
    __syncthreads();
}

namespace pg8 {
constexpr int BM = 256, BK = 64, HALF = 128, HTB = HALF * BK * 2, STAGE_BYTES = 8 * HTB;
DI int lds_byte(int r, int c) { const int st = (r >> 4) * 2 + (c >> 5), rr = r & 15, cc = c & 31, ob = rr * 64 + cc * 2; return st * 1024 + (ob ^ (((ob >> 9) & 1) << 5)); }
DI void stage_rc(int b, int& R, int& C) { const int st = b / 1024, sb = b % 1024, swz = sb ^ (((sb >> 9) & 1) << 5); R = (st >> 1) * 16 + swz / 64; C = (st & 1) * 32 + (swz % 64) / 2; }
DI int perm32(int rho) { const int n = rho >> 4, i = rho & 15; return 8 * (i >> 2) + 4 * n + (i & 3); }
struct Unit { int pm, pn, aux; };
struct Gemm { const bf16_t* A; const bf16_t* Bt; int K; };

template <class Epi, class Sched>
DI void gemm_phase(LAS unsigned char* lds, const Gemm g, const Sched& S, const Epi& E) {
    const int tid = threadIdx.x, wid = __builtin_amdgcn_readfirstlane(tid >> 6), lane = tid & 63, wr = wid >> 2, wc = wid & 3, fr = lane & 15, fq = lane >> 4;
    const int K = g.K, nt = K / BK;
    int RA[2], CA[2]; unsigned voffB[2];
#pragma unroll
    for (int i = 0; i < 2; ++i) { int R, C; stage_rc(tid * 16 + i * 8192, R, C); const int Rb = Epi::PERM ? ((R & ~31) + perm32(R & 31)) : R;
        RA[i] = R; CA[i] = C; voffB[i] = (unsigned)(Rb * K + C) * 2u; }
    const unsigned kstep = (unsigned)(BK * 2);
    const size_t hstep = (size_t)HALF * K * 2;
    const unsigned ldsw = (unsigned)wid * 1024u;
    const int aoff = lds_byte(wr * 64 + fr, fq * 8), boff = lds_byte(wc * 32 + fr, fq * 8);
#define PG8_SA(b, h) (((b) * 2 + (h)) * HTB)
#define PG8_SB(b, h) ((4 + (b) * 2 + (h)) * HTB)
#define PG8_STAGE_B(bufoff, gbase) do { _Pragma("unroll") for (int _i = 0; _i < 2; ++_i) \
        __builtin_amdgcn_global_load_lds((const unsigned*)((const char*)(gbase) + voffB[_i]), (LAS unsigned*)(lds + (bufoff) + ldsw + _i * 8192), 16, 0, 0); } while (0)
#define PG8_STAGE_A(bufoff, kb, o, h) do { _Pragma("unroll") for (int _i = 0; _i < 2; ++_i) \
        __builtin_amdgcn_global_load_lds((const unsigned*)((const char*)g.A + (size_t)(kb) + (o)[h][_i]), (LAS unsigned*)(lds + (bufoff) + ldsw + _i * 8192), 16, 0, 0); } while (0)
#define PG8_LDA(dst, b, h) do { _Pragma("unroll") for (int m = 0; m < 4; ++m) _Pragma("unroll") for (int k = 0; k < 2; ++k) dst[m][k] = *(const LAS bf16x8*)(lds + PG8_SA(b, h) + aoff + m * 2048 + k * 1024); } while (0)
#define PG8_LDB(dst, b, h) do { _Pragma("unroll") for (int n = 0; n < 2; ++n) _Pragma("unroll") for (int k = 0; k < 2; ++k) dst[n][k] = *(const LAS bf16x8*)(lds + PG8_SB(b, h) + boff + n * 2048 + k * 1024); } while (0)
#define PG8_MMA(ai, bj, At, Bt) do { __builtin_amdgcn_s_setprio(1); _Pragma("unroll") for (int m = 0; m < 4; ++m) _Pragma("unroll") for (int n = 0; n < 2; ++n) _Pragma("unroll") for (int k = 0; k < 2; ++k) \
        acc[ai][bj][m][n] = __builtin_amdgcn_mfma_f32_16x16x32_bf16(Bt[n][k], At[m][k], acc[ai][bj][m][n], 0, 0, 0); __builtin_amdgcn_s_setprio(0); } while (0)
#define PG8_WAIT_V(n) asm volatile("s_waitcnt vmcnt(" #n ")" ::: "memory")
#define PG8_WAIT_L(n) asm volatile("s_waitcnt lgkmcnt(" #n ")" ::: "memory")
#define PG8_BAR __builtin_amdgcn_s_barrier()
#define PG8_SCHED __builtin_amdgcn_sched_barrier(0)
    Unit cur, nxt; int ui = 0;
    if (!S.next(0, cur)) return;
    f32x4 acc[2][2][4][2];
#pragma unroll
    for (int a = 0; a < 2; ++a)
#pragma unroll
        for (int b = 0; b < 2; ++b)
#pragma unroll
            for (int m = 0; m < 4; ++m)
#pragma unroll
                for (int n = 0; n < 2; ++n) acc[a][b][m][n] = (f32x4){0.f, 0.f, 0.f, 0.f};
    bf16x8 At[4][2], B0[2][2], B1[2][2];
    unsigned oc[2][2], on[2][2];
    S.a_off(cur, RA, CA, K, oc);
    const char* cB = (const char*)g.Bt + S.b_off(cur, K);
    PG8_STAGE_B(PG8_SB(0, 0), cB); PG8_STAGE_A(PG8_SA(0, 0), 0u, oc, 0); PG8_STAGE_B(PG8_SB(0, 1), cB + hstep); PG8_STAGE_A(PG8_SA(0, 1), 0u, oc, 1);
    if (wr == 1) PG8_BAR;
    PG8_WAIT_V(4); PG8_BAR;
    PG8_STAGE_B(PG8_SB(1, 0), cB + kstep); PG8_STAGE_A(PG8_SA(1, 0), kstep, oc, 0); PG8_STAGE_B(PG8_SB(1, 1), cB + hstep + kstep);
    PG8_WAIT_V(6); PG8_BAR;
    for (;;) {
        const bool has_next = S.next(ui + 1, nxt);
        const char* nB = cB;
        if (has_next) { S.a_off(nxt, RA, CA, K, on); nB = (const char*)g.Bt + S.b_off(nxt, K); }
        else {
#pragma unroll
            for (int h = 0; h < 2; ++h)
#pragma unroll
                for (int i = 0; i < 2; ++i) on[h][i] = oc[h][i];
        }
        for (int t = 0; t < nt; t += 2) {
            const bool last = (t == nt - 2);
            const unsigned k1 = (unsigned)(t + 1) * kstep;
            const unsigned k2 = last ? 0u : (unsigned)(t + 2) * kstep, k3 = k2 + kstep;
            unsigned o2[2][2];
#pragma unroll
            for (int h = 0; h < 2; ++h)
#pragma unroll
                for (int i = 0; i < 2; ++i) o2[h][i] = last ? on[h][i] : oc[h][i];
            const char* b2 = last ? nB : cB + (size_t)(t + 2) * kstep; const char* b3 = b2 + kstep;
            PG8_LDB(B0, 0, 0); PG8_SCHED; PG8_LDA(At, 0, 0); PG8_STAGE_A(PG8_SA(1, 1), k1, oc, 1);
            PG8_WAIT_L(8); PG8_BAR; PG8_WAIT_L(0); PG8_MMA(0, 0, At, B0); PG8_BAR; PG8_SCHED;
            PG8_LDB(B1, 0, 1); PG8_STAGE_B(PG8_SB(0, 0), b2);
            PG8_BAR; PG8_WAIT_L(0); PG8_MMA(0, 1, At, B1); PG8_BAR;
            PG8_LDA(At, 0, 1); PG8_STAGE_A(PG8_SA(0, 0), k2, o2, 0);
            PG8_BAR; PG8_WAIT_L(0); PG8_MMA(1, 0, At, B0); PG8_BAR; PG8_SCHED;
            PG8_STAGE_B(PG8_SB(0, 1), b2 + hstep);
            PG8_WAIT_V(6); PG8_BAR; PG8_MMA(1, 1, At, B1); PG8_BAR;
            PG8_LDB(B0, 1, 0); PG8_SCHED; PG8_LDA(At, 1, 0); PG8_STAGE_A(PG8_SA(0, 1), k2, o2, 1);
            PG8_WAIT_L(8); PG8_BAR; PG8_WAIT_L(0); PG8_MMA(0, 0, At, B0); PG8_BAR; PG8_SCHED;
            PG8_LDB(B1, 1, 1); PG8_STAGE_B(PG8_SB(1, 0), b3);
            PG8_BAR; PG8_WAIT_L(0); PG8_MMA(0, 1, At, B1); PG8_BAR;
            PG8_LDA(At, 1, 1); PG8_STAGE_A(PG8_SA(1, 0), k3, o2, 0);
            PG8_BAR; PG8_WAIT_L(0); PG8_MMA(1, 0, At, B0); PG8_BAR; PG8_SCHED;
            PG8_STAGE_B(PG8_SB(1, 1), b3 + hstep);
            PG8_WAIT_V(6); PG8_BAR; PG8_MMA(1, 1, At, B1); PG8_BAR;
        }
        E(acc, cur, wr, wc, fr, fq);
        if (!has_next) break;
#pragma unroll
        for (int a = 0; a < 2; ++a)
#pragma unroll
            for (int b = 0; b < 2; ++b)
#pragma unroll
                for (int m = 0; m < 4; ++m)
#pragma unroll
                    for (int n = 0; n < 2; ++n) acc[a][b][m][n] = (f32x4){0.f, 0.f, 0.f, 0.f};
        cur = nxt; cB = nB; ++ui;
#pragma unroll
        for (int h = 0; h < 2; ++h)
#pragma unroll
            for (int i = 0; i < 2; ++i) oc[h][i] = on[h][i];
    }
    PG8_WAIT_V(0);
    if (wr == 0) PG8_BAR;
    PG8_BAR;
#undef PG8_SA
#undef PG8_SB
#undef PG8_STAGE_A
#undef PG8_STAGE_B
#undef PG8_LDA
#undef PG8_LDB
#undef PG8_MMA
#undef PG8_WAIT_V
#undef PG8_WAIT_L
#undef PG8_BAR
#undef PG8_SCHED
}

struct SchedPlain {
    int nM, nN, G, vcu;
    DI bool next(int i, Unit& u) const { const int L = i * G + vcu; if (L >= nM * nN) return false; u.pm = L / nN; u.pn = L % nN; u.aux = 0; return true; }
    DI void a_off(const Unit& u, const int (&R)[2], const int (&C)[2], int K, unsigned (&o)[2][2]) const {
#pragma unroll
        for (int h = 0; h < 2; ++h)
#pragma unroll
            for (int i = 0; i < 2; ++i) o[h][i] = (unsigned)((u.pm * 256 + h * 128 + R[i]) * K + C[i]) * 2u; }
    DI size_t b_off(const Unit& u, int K) const { return (size_t)u.pn * 256 * K * 2; }
};
struct SchedMoe {
    const int* tile; const int* rowtok; int nN, G, vcu;
    DI bool next(int i, Unit& u) const { const int nmt = tile[1000]; const int L = i * G + vcu; if (L >= nmt * nN) return false; u.pm = L / nN; u.pn = L % nN; u.aux = tile[u.pm]; return true; }
    DI void a_off(const Unit& u, const int (&R)[2], const int (&C)[2], int K, unsigned (&o)[2][2]) const {
        if (rowtok) {
            const int* p0 = rowtok + u.pm * 256 + R[0]; const int* p1 = rowtok + u.pm * 256 + R[1]; const int* p2 = p0 + 128; const int* p3 = p1 + 128;
            int t0, t1, t2, t3;
            asm volatile("global_load_dword %0, %4, off\n\tglobal_load_dword %1, %5, off\n\tglobal_load_dword %2, %6, off\n\tglobal_load_dword %3, %7, off\n\ts_waitcnt vmcnt(0)"
                         : "=&v"(t0), "=&v"(t1), "=&v"(t2), "=&v"(t3) : "v"(p0), "v"(p1), "v"(p2), "v"(p3) : "memory");
            o[0][0] = (unsigned)(t0 * K + C[0]) * 2u; o[0][1] = (unsigned)(t1 * K + C[1]) * 2u; o[1][0] = (unsigned)(t2 * K + C[0]) * 2u; o[1][1] = (unsigned)(t3 * K + C[1]) * 2u;
        } else {
#pragma unroll
            for (int h = 0; h < 2; ++h)
#pragma unroll
                for (int i = 0; i < 2; ++i) o[h][i] = (unsigned)((u.pm * 256 + h * 128 + R[i]) * K + C[i]) * 2u;
        }
    }
    DI size_t b_off(const Unit& u, int K) const { return (size_t)(u.aux * nN + u.pn) * 256 * K * 2; }
};

struct EpiBf16Plain {
    static constexpr bool PERM = true;
    bf16_t* O; int ldc;
    DI void operator()(const f32x4 (&acc)[2][2][4][2], const Unit& u, int wr, int wc, int fr, int fq) const {
        const int row0 = u.pm * BM + wr * 64 + fr, col0 = u.pn * BM + wc * 32 + 8 * fq;
#pragma unroll
        for (int ai = 0; ai < 2; ++ai)
#pragma unroll
            for (int m = 0; m < 4; ++m) { bf16_t* rowp = O + (size_t)(row0 + ai * HALF + m * 16) * ldc + col0;
#pragma unroll
                for (int bj = 0; bj < 2; ++bj) { const f32x4 v0 = acc[ai][bj][m][0], v1 = acc[ai][bj][m][1];
                    u32x4 w; w.x = cvt_pk_bf16(v0[0], v0[1]); w.y = cvt_pk_bf16(v0[2], v0[3]); w.z = cvt_pk_bf16(v1[0], v1[1]); w.w = cvt_pk_bf16(v1[2], v1[3]);
                    *(u32x4*)(rowp + bj * HALF) = w; } }
    }
};
struct EpiUt {
    static constexpr bool PERM = true;
    bf16_t* O;
    DI void operator()(const f32x4 (&acc)[2][2][4][2], const Unit& u, int wr, int wc, int fr, int fq) const {
        const int row0 = u.pm * BM + wr * 64 + fr, col0 = u.pn * BM + wc * 32 + 8 * fq;
        const int b = col0 >> 12, pos0 = col0 & 4095;
#pragma unroll
        for (int ai = 0; ai < 2; ++ai)
#pragma unroll
            for (int m = 0; m < 4; ++m) { bf16_t* rowp = O + ((size_t)(b * 1024 + row0 + ai * HALF + m * 16) << 12) + pos0;
#pragma unroll
                for (int bj = 0; bj < 2; ++bj) { const f32x4 v0 = acc[ai][bj][m][0], v1 = acc[ai][bj][m][1];
                    u32x4 w; w.x = cvt_pk_bf16(v0[0], v0[1]); w.y = cvt_pk_bf16(v0[2], v0[3]); w.z = cvt_pk_bf16(v1[0], v1[1]); w.w = cvt_pk_bf16(v1[2], v1[3]);
                    *(u32x4*)(rowp + bj * HALF) = w; } }
    }
};
struct EpiDft {
    static constexpr bool PERM = true;
    bf16_t* O;
    DI void operator()(const f32x4 (&acc)[2][2][4][2], const Unit& u, int wr, int wc, int fr, int fq) const {
        const int b = u.pn >> 1, row0 = b * 4096 + u.pm * BM + wr * 64 + fr, col0 = (u.pn & 1) * BM + wc * 32 + 8 * fq;
#pragma unroll
        for (int ai = 0; ai < 2; ++ai)
#pragma unroll
            for (int m = 0; m < 4; ++m) { bf16_t* rowp = O + (size_t)(row0 + ai * HALF + m * 16) * 512 + col0;
#pragma unroll
                for (int bj = 0; bj < 2; ++bj) { const f32x4 v0 = acc[ai][bj][m][0], v1 = acc[ai][bj][m][1];
                    u32x4 w; w.x = cvt_pk_bf16(v0[0], v0[1]); w.y = cvt_pk_bf16(v0[2], v0[3]); w.z = cvt_pk_bf16(v1[0], v1[1]); w.w = cvt_pk_bf16(v1[2], v1[3]);
                    *(u32x4*)(rowp + bj * HALF) = w; } }
    }
};
struct EpiResid {
    static constexpr bool PERM = false;
    const float* x; const float* mod; float* X1;
    DI void operator()(const f32x4 (&acc)[2][2][4][2], const Unit& u, int wr, int wc, int fr, int fq) const {
        const int row0 = u.pm * BM + wr * 64 + fr, col0 = u.pn * BM + wc * 32 + 4 * fq;
        const int b = (u.pm * BM) >> 12;
        f32x4 gt[2][2];
#pragma unroll
        for (int bj = 0; bj < 2; ++bj)
#pragma unroll
            for (int n = 0; n < 2; ++n) gt[bj][n] = *(const f32x4*)(mod + b * 6144 + 2048 + col0 + bj * HALF + n * 16);
#pragma unroll
        for (int ai = 0; ai < 2; ++ai)
#pragma unroll
            for (int m = 0; m < 4; ++m) { const size_t off = (size_t)(row0 + ai * HALF + m * 16) * D + col0;
#pragma unroll
                for (int bj = 0; bj < 2; ++bj)
#pragma unroll
                    for (int n = 0; n < 2; ++n) { const f32x4 xv = *(const f32x4*)(x + off + bj * HALF + n * 16); *(f32x4*)(X1 + off + bj * HALF + n * 16) = xv + gt[bj][n] * acc[ai][bj][m][n]; } }
    }
};
struct EpiAct {
    static constexpr bool PERM = true;
    const float* bgu; bf16_t* O;
    DI void operator()(const f32x4 (&acc)[2][2][4][2], const Unit& u, int wr, int wc, int fr, int fq) const {
        const int row0 = u.pm * BM + wr * 64 + fr, colj = u.pn * HALF + wc * 32 + 8 * fq;
        const float* bg = bgu + (size_t)u.aux * 2048 + colj;
        f32x4 bgv[2], buv[2];
#pragma unroll
        for (int n = 0; n < 2; ++n) { bgv[n] = *(const f32x4*)(bg + 4 * n); buv[n] = *(const f32x4*)(bg + 1024 + 4 * n); }
#pragma unroll
        for (int ai = 0; ai < 2; ++ai)
#pragma unroll
            for (int m = 0; m < 4; ++m) {
                float o[8];
#pragma unroll
                for (int n = 0; n < 2; ++n) { const f32x4 gv = acc[ai][0][m][n] + bgv[n], uv = acc[ai][1][m][n] + buv[n];
#pragma unroll
                    for (int j = 0; j < 4; ++j) { const float gt = fminf(gv[j], 7.0f); const float up = fminf(fmaxf(uv[j], -7.0f), 7.0f);
                        o[4 * n + j] = (up + 1.0f) * (gt * sigmoidf_(1.702f * gt)); } }
                u32x4 w; w.x = cvt_pk_bf16(o[0], o[1]); w.y = cvt_pk_bf16(o[2], o[3]); w.z = cvt_pk_bf16(o[4], o[5]); w.w = cvt_pk_bf16(o[6], o[7]);
                *(u32x4*)(O + (size_t)(row0 + ai * HALF + m * 16) * 1024 + colj) = w; }
    }
};
struct EpiDown {
    static constexpr bool PERM = true;
    const float* bd; const float* rowgate; bf16_t* O;
    DI void operator()(const f32x4 (&acc)[2][2][4][2], const Unit& u, int wr, int wc, int fr, int fq) const {
        const int row0 = u.pm * BM + wr * 64 + fr, col0 = u.pn * BM + wc * 32 + 8 * fq;
        const float* bp = bd + (size_t)u.aux * 1024 + col0;
        f32x4 bv[2][2];
#pragma unroll
        for (int bj = 0; bj < 2; ++bj)
#pragma unroll
            for (int n = 0; n < 2; ++n) bv[bj][n] = *(const f32x4*)(bp + bj * HALF + 4 * n);
#pragma unroll
        for (int ai = 0; ai < 2; ++ai)
#pragma unroll
            for (int m = 0; m < 4; ++m) { const int row = row0 + ai * HALF + m * 16; const float gsc = rowgate[row]; bf16_t* rowp = O + (size_t)row * 1024 + col0;
#pragma unroll
                for (int bj = 0; bj < 2; ++bj) { const f32x4 v0 = (acc[ai][bj][m][0] + bv[bj][0]) * gsc, v1 = (acc[ai][bj][m][1] + bv[bj][1]) * gsc;
                    u32x4 w; w.x = cvt_pk_bf16(v0[0], v0[1]); w.y = cvt_pk_bf16(v0[2], v0[3]); w.z = cvt_pk_bf16(v1[0], v1[1]); w.w = cvt_pk_bf16(v1[2], v1[3]);
                    *(u32x4*)(rowp + bj * HALF) = w; } }
    }
};
}

struct Args { const float* in[27]; float* out; unsigned char* ws; int ph_lo, ph_hi; };
struct Frame {
    LAS unsigned char* lds; int tid, lane, wave, G, blk, vcu;
    const float* in[27]; float* out; unsigned char* ws;
};
enum { I_X = 0, I_C, I_CTX, I_CCTX, I_WMOD, I_BMOD, I_GMIX, I_GFFN, I_WIN, I_WF, I_CONVW, I_CONVB, I_RGWA, I_RGBA, I_RGWX, I_RGBX, I_LAM, I_GOF, I_GOR, I_WOUT, I_WR, I_BR, I_WGU, I_BGU, I_WD, I_BD, I_GFIN };

constexpr int IT_ADA = 0, IT_FOLD = 24, IT_RGW = 56, IT_DFT = 88, IT_TR = 344;
constexpr int NTR_WIN = 8 * 8, NTR_WOUT = 8 * 8, NTR_WGU = 32 * 8 * 16, NTR_WD = 32 * 8 * 8;
constexpr int IT_END = IT_TR + NTR_WIN + NTR_WOUT + NTR_WGU + NTR_WD;

DI void p0_adaln(const Frame& F, int cb) {
    LAS float* sc = (LAS float*)F.lds; LAS float* red = (LAS float*)(F.lds + 36864);
    const float* c = F.in[I_C]; const float* cctx = F.in[I_CCTX]; const float* wmod = F.in[I_WMOD]; const float* bmod = F.in[I_BMOD];
    float* mod = (float*)(F.ws + WS_MOD);
    for (int i = F.tid; i < 9 * 1024; i += 512) { const int r = i >> 10, k = i & 1023; const float v = r < 8 ? c[r * 1024 + k] : cctx[k]; sc[i] = v / (1.0f + __expf(-v)); }
    __syncthreads();
    f32x4 acc[9];
#pragma unroll
    for (int r = 0; r < 9; ++r) acc[r] = (f32x4){0.f, 0.f, 0.f, 0.f};
    const float* wp = wmod + (size_t)(128 * F.wave) * 6144 + cb * 256 + 4 * F.lane;
    for (int kk = 0; kk < 128; kk += 8) {
        f32x4 wv[8];
#pragma unroll
        for (int j = 0; j < 8; ++j) wv[j] = *(const f32x4*)(wp + (size_t)(kk + j) * 6144);
#pragma unroll
        for (int j = 0; j < 8; ++j)
#pragma unroll
            for (int r = 0; r < 9; ++r) { const float s = sc[r * 1024 + 128 * F.wave + kk + j]; acc[r] += s * wv[j]; }
    }
#pragma unroll
    for (int r = 0; r < 9; ++r) *(LAS f32x4*)(red + (F.wave * 9 + r) * 256 + 4 * F.lane) = acc[r];
    __syncthreads();
    for (int i = F.tid; i < 9 * 256; i += 512) { const int r = i >> 8, cc = i & 255; float s = bmod[cb * 256 + cc];
        for (int w = 0; w < 8; ++w) s += red[(w * 9 + r) * 256 + cc];
        mod[r * 6144 + cb * 256 + cc] = s; }
    __syncthreads();
}

DI void p0_fold(const Frame& F, int it) {
    const int g = it >> 3, cs = (it >> 2) & 1, jb = it & 3;
    LAS float* tw = (LAS float*)F.lds;
    LAS float* wfs = tw + 128;
    LAS float* Fm = wfs + 128 * 32;
    LAS float* wa = Fm + 128 * 32;
    const float* wf = F.in[I_WF] + (size_t)g * 128 * 128; const float* win = F.in[I_WIN];
    bf16_t* WFS = (bf16_t*)(F.ws + WS_WFS);
    const float norm = 0.0013810679320049757f;
    if (F.tid < 128) { const float rev = (float)F.tid * (1.0f / 128.0f); tw[F.tid] = cs ? __builtin_amdgcn_sinf(rev) : __builtin_amdgcn_cosf(rev); }
    for (int i = F.tid; i < 128 * 32; i += 512) { const int l = i >> 5, jj = i & 31; wfs[i] = wf[l * 128 + 32 * jb + jj]; }
    __syncthreads();
    { const int jj = F.tid & 31, j0 = F.tid >> 5;
      for (int i = 0; i < 8; ++i) { const int j = j0 + 16 * i; float s = 0.f;
          for (int l = 0; l < 128; ++l) s += tw[(l * j) & 127] * wfs[l * 32 + jj];
          Fm[j * 32 + jj] = s * norm; } }
    __syncthreads();
    const int kk = F.tid & 63, jq = F.tid >> 6;
    for (int k0 = 0; k0 < 1024; k0 += 64) {
        for (int i = F.tid; i < 64 * 128; i += 512) { const int r = i >> 7, j = i & 127; wa[r * 129 + j] = win[(size_t)(k0 + r) * 1536 + g * 128 + j]; }
        __syncthreads();
        float s0 = 0.f, s1 = 0.f, s2 = 0.f, s3 = 0.f;
        for (int j = 0; j < 128; ++j) { const float a = wa[kk * 129 + j]; const f32x4 f = *(LAS f32x4*)(Fm + j * 32 + 4 * jq); s0 += a * f[0]; s1 += a * f[1]; s2 += a * f[2]; s3 += a * f[3]; }
        const int chb = g * 128 + 32 * jb + 4 * jq;
        WFS[(size_t)((chb + 0) * 2 + cs) * 1024 + k0 + kk] = f2bf(s0);
        WFS[(size_t)((chb + 1) * 2 + cs) * 1024 + k0 + kk] = f2bf(s1);
        WFS[(size_t)((chb + 2) * 2 + cs) * 1024 + k0 + kk] = f2bf(s2);
        WFS[(size_t)((chb + 3) * 2 + cs) * 1024 + k0 + kk] = f2bf(s3);
        __syncthreads();
    }
}
DI void p0_rgw(const Frame& F, int it) {
    const int type = it >> 4, d = (it >> 3) & 1, h = it & 7;
    const float* src = (type ? F.in[I_RGWX] : F.in[I_RGWA]) + (size_t)(d * 8 + h) * 4096;
    bf16_t* dst = (bf16_t*)(F.ws + WS_RGW) + (size_t)((d * 2 + type) * 8 + h) * 4096;
    for (int i = F.tid; i < 4096; i += 512) { const int j = i >> 6, ii = i & 63; dst[i] = f2bf(src[ii * 64 + j]); }
}
DI void p0_dft(const Frame& F, int it) {
    bf16_t* Dm = (bf16_t*)(F.ws + WS_DFT);
    for (int i = F.tid; i < 16 * 1024; i += 512) { const int k = 16 * it + (i >> 10), c8 = i & 1023; const int cs = c8 >> 9, n0 = (c8 & 511) * 8;
        float v[8];
#pragma unroll
        for (int j = 0; j < 8; ++j) { const float rev = (float)((k * (n0 + j)) & 4095) * (1.0f / 4096.0f); v[j] = cs ? -__builtin_amdgcn_sinf(rev) : __builtin_amdgcn_cosf(rev); }
        u32x4 w; w.x = cvt_pk_bf16(v[0], v[1]); w.y = cvt_pk_bf16(v[2], v[3]); w.z = cvt_pk_bf16(v[4], v[5]); w.w = cvt_pk_bf16(v[6], v[7]);
        *(u32x4*)(Dm + (size_t)k * 8192 + cs * 4096 + n0) = w; }
}
DI void p0_transpose(const Frame& F, const float* src, int ldn, int k0, int n0, bf16_t* dst, int drow0) {
    LAS float* tl = (LAS float*)F.lds;
    float v[32];
    int tid = F.tid; asm volatile("" : "+v"(tid));
    const float* sp = src + (size_t)(k0 + (tid >> 7)) * ldn + n0 + (tid & 127);
#pragma unroll
    for (int i = 0; i < 32; ++i) { v[i] = sp[(size_t)(4 * i) * ldn]; }
#pragma unroll
    for (int i = 0; i < 32; ++i) { const int idx = tid + 512 * i; tl[(idx >> 7) * 129 + (idx & 127)] = v[i]; }
    __syncthreads();
#pragma unroll
    for (int i = 0; i < 16; ++i) { const int idx = tid + 512 * i; const int n = idx >> 6, kp = idx & 63;
        const unsigned w = cvt_pk_bf16(tl[(2 * kp) * 129 + n], tl[(2 * kp + 1) * 129 + n]);
        *(unsigned*)(dst + (size_t)(drow0 + n) * 1024 + k0 + 2 * kp) = w; }
    __syncthreads();
}
DI void phase0(const Frame& F) {
    for (int it = F.blk; it < IT_END; it += F.G) {
#ifndef P0_MASK
#define P0_MASK 31
#endif
        if (it < IT_FOLD) { if (P0_MASK & 1) p0_adaln(F, it); }
        else if (it < IT_RGW) { if (P0_MASK & 2) p0_fold(F, it - IT_FOLD); }
        else if (it < IT_DFT) { if (P0_MASK & 4) p0_rgw(F, it - IT_RGW); }
        else if (it < IT_TR) { if (P0_MASK & 8) p0_dft(F, it - IT_DFT); }
        else if (P0_MASK & 16) {
            int j = it - IT_TR;
            if (j < NTR_WIN) { const int kt = j >> 3, ntl = j & 7; p0_transpose(F, F.in[I_WIN], 1536, kt * 128, 512 + ntl * 128, (bf16_t*)(F.ws + WS_WIN2), ntl * 128); }
            else if ((j -= NTR_WIN) < NTR_WOUT) { const int kt = j >> 3, ntl = j & 7; p0_transpose(F, F.in[I_WOUT], 1024, kt * 128, ntl * 128, (bf16_t*)(F.ws + WS_WOUT), ntl * 128); }
            else if ((j -= NTR_WOUT) < NTR_WGU) { const int e = j >> 7, kt = (j >> 4) & 7, ntl = j & 15;
                p0_transpose(F, F.in[I_WGU] + (size_t)e * 1024 * 2048, 2048, kt * 128, ntl * 128, (bf16_t*)(F.ws + WS_WGU), e * 2048 + 256 * (ntl & 7) + 128 * (ntl >> 3)); }
            else { j -= NTR_WGU; const int e = j >> 6, kt = (j >> 3) & 7, ntl = j & 7;
                p0_transpose(F, F.in[I_WD] + (size_t)e * 1024 * 1024, 1024, kt * 128, ntl * 128, (bf16_t*)(F.ws + WS_WDOWN), e * 1024 + ntl * 128); }
        }
    }
}

DI void phase1(const Frame& F) {
    const float* x = F.in[I_X]; const float* ctx = F.in[I_CTX]; const float* g = F.in[I_GMIX]; const float* mod = (const float*)(F.ws + WS_MOD);
    bf16_t* H = (bf16_t*)(F.ws + WS_H);
    for (int it = 0;; ++it) {
        const int row = (it * F.G + F.blk) * 8 + F.wave; if (row >= TT) break;
        const float* xr = row < T ? x + (size_t)row * D : ctx + (size_t)(row - T) * D; const int bi = row < T ? (row >> 12) : 8;
        f32x4 v[4]; float ss = 0.f;
#pragma unroll
        for (int q = 0; q < 4; ++q) { v[q] = *(const f32x4*)(xr + 4 * F.lane + 256 * q); ss += v[q][0] * v[q][0] + v[q][1] * v[q][1] + v[q][2] * v[q][2] + v[q][3] * v[q][3]; }
        ss = wave_sum(ss); const float rstd = rsqrtf(ss * (1.0f / 1024.0f) + EPS);
#pragma unroll
        for (int q = 0; q < 4; ++q) { const int k = 4 * F.lane + 256 * q;
            const f32x4 gg = *(const f32x4*)(g + k), sh = *(const f32x4*)(mod + bi * 6144 + k), sc = *(const f32x4*)(mod + bi * 6144 + 1024 + k);
            const f32x4 y = v[q] * rstd * gg * (1.0f + sc) + sh;
            u32x2 w; w.x = cvt_pk_bf16(y[0], y[1]); w.y = cvt_pk_bf16(y[2], y[3]);
            *(u32x2*)(H + (size_t)row * D + k) = w; }
    }
}

DI int serp_tok(int b, int P) { const int rr = P >> 6, cc = P & 63; return b * SEQ + (rr << 6) + ((rr & 1) ? 63 - cc : cc); }
DI void phase_rg(const Frame& F) {
    LAS unsigned char* xcl = F.lds;
    const bf16_t* XR = (const bf16_t*)(F.ws + WS_XRGR); const bf16_t* RGW = (const bf16_t*)(F.ws + WS_RGW);
    const float* convw = F.in[I_CONVW]; const float* convb = F.in[I_CONVB];
    float* sumP = (float*)(F.ws + WS_SUMP); float* sumH = (float*)(F.ws + WS_SUMH);
    bf16_t* SSb = (bf16_t*)(F.ws + WS_SS); bf16_t* CAF = (bf16_t*)(F.ws + WS_CAF); bf16_t* CAB = (bf16_t*)(F.ws + WS_CAB);
    const int tid = F.tid, lane = F.lane, hh = F.wave, hf = lane >> 5;
    for (int u = F.blk; u < 544; u += F.G) {
        const bool lat = u < 512; const int b = lat ? (u >> 6) : ((u - 512) >> 2), r = lat ? (u & 63) : ((u - 512) & 3); const int L = lat ? SEQ : CTXL;
        {
            const int cg = tid & 63; float w[4][8], bs[8];
#pragma unroll
            for (int k = 0; k < 4; ++k) { const f32x4 a = *(const f32x4*)(convw + k * 512 + 8 * cg), c2 = *(const f32x4*)(convw + k * 512 + 8 * cg + 4);
                w[k][0] = a[0]; w[k][1] = a[1]; w[k][2] = a[2]; w[k][3] = a[3]; w[k][4] = c2[0]; w[k][5] = c2[1]; w[k][6] = c2[2]; w[k][7] = c2[3]; }
            { const f32x4 a = *(const f32x4*)(convb + 8 * cg), c2 = *(const f32x4*)(convb + 8 * cg + 4); bs[0] = a[0]; bs[1] = a[1]; bs[2] = a[2]; bs[3] = a[3]; bs[4] = c2[0]; bs[5] = c2[1]; bs[6] = c2[2]; bs[7] = c2[3]; }
#pragma unroll
            for (int i = 0; i < 8; ++i) { const int p = (tid >> 6) + 8 * i; float a[8];
#pragma unroll
                for (int j = 0; j < 8; ++j) a[j] = bs[j];
#pragma unroll
                for (int k = 0; k < 4; ++k) { const int P = 64 * r + p + k - 2;
                    if (P >= 0 && P < L) { const int tk = lat ? serp_tok(b, P) : T + b * CTXL + P; const u32x4 xv = *(const u32x4*)(XR + (size_t)tk * 1024 + 8 * cg);
#pragma unroll
                        for (int j = 0; j < 4; ++j) { a[2 * j] += w[k][2 * j] * bflo(xv[j]); a[2 * j + 1] += w[k][2 * j + 1] * bfhi(xv[j]); } } }
                u32x4 o; o.x = cvt_pk_bf16(a[0], a[1]); o.y = cvt_pk_bf16(a[2], a[3]); o.z = cvt_pk_bf16(a[4], a[5]); o.w = cvt_pk_bf16(a[6], a[7]);
                *(LAS u32x4*)(xcl + p * 1040 + cg * 16) = o; }
        }
        __syncthreads();
        const int cidx = lat ? 4 + r : r; const int tokbase = b * SEQ + 64 * r;
#pragma unroll 1
        for (int nt = 0; nt < 2; ++nt) {
            const int chl = 32 * nt + (lane & 31), ch = 64 * hh + chl;
            f32x16 hlf[2];
#pragma unroll
            for (int d = 0; d < 2; ++d) {
                f32x16 ar[2], ai[2];
#pragma unroll
                for (int t = 0; t < 2; ++t)
#pragma unroll
                    for (int i = 0; i < 16; ++i) { ar[t][i] = 0.f; ai[t][i] = 0.f; }
                const bf16_t* wr_ = RGW + (size_t)(((d * 2 + 0) * 8 + hh) * 64 + chl) * 64; const bf16_t* wi_ = RGW + (size_t)(((d * 2 + 1) * 8 + hh) * 64 + chl) * 64;
#pragma unroll
                for (int ks = 0; ks < 4; ++ks) {
                    const bf16x8 br = *(const bf16x8*)(wr_ + 16 * ks + 8 * hf), bi = *(const bf16x8*)(wi_ + 16 * ks + 8 * hf);
#pragma unroll
                    for (int t = 0; t < 2; ++t) { const int m = lane & 31; const int pos = 32 * ((m >> 2) & 1) + 16 * t + 4 * (m >> 3) + (m & 3);
                        const bf16x8 a = *(const LAS bf16x8*)(xcl + pos * 1040 + (64 * hh + 16 * ks + 8 * hf) * 2);
                        ar[t] = __builtin_amdgcn_mfma_f32_32x32x16_bf16(a, br, ar[t], 0, 0, 0); ai[t] = __builtin_amdgcn_mfma_f32_32x32x16_bf16(a, bi, ai[t], 0, 0, 0); }
                }
                const float ba = F.in[I_RGBA][d * 512 + ch], bx = F.in[I_RGBX][d * 512 + ch], lam = F.in[I_LAM][d * 512 + ch];
                const float nl = -lam; const float sp8 = 8.0f * (fmaxf(nl, 0.f) + log1pf(expf(-fabsf(nl))));
#pragma unroll
                for (int t = 0; t < 2; ++t)
#pragma unroll
                    for (int i = 0; i < 16; ++i) { const int p = 32 * hf + 16 * t + i;
                        const float rr = sigmoidf_(ar[t][i] + ba), ii = sigmoidf_(ai[t][i] + bx); const float a = __expf(-sp8 * rr);
                        const float xcv = bf2f(*(const LAS bf16_t*)(xcl + p * 1040 + ch * 2));
                        ar[t][i] = a; ai[t][i] = sqrtf(fmaxf(1.0f - a * a, 0.f)) * ii * xcv; }
                float hl = 0.f, ca = 1.f;
                if (d == 0) {
#pragma unroll
                    for (int t = 0; t < 2; ++t)
#pragma unroll
                        for (int i = 0; i < 16; ++i) { const float a = ar[t][i]; hl = a * hl + ai[t][i]; ca *= a; ai[t][i] = hl; ar[t][i] = ca; }
                    const float P0 = __shfl(ca, lane & 31), H0 = __shfl(hl, lane & 31);
                    if (hf == 1) {
#pragma unroll
                        for (int t = 0; t < 2; ++t)
#pragma unroll
                            for (int i = 0; i < 16; ++i) { ai[t][i] += ar[t][i] * H0; ar[t][i] *= P0; }
                        sumP[(size_t)((b * 2 + 0) * NCH + cidx) * 512 + ch] = ar[1][15]; sumH[(size_t)((b * 2 + 0) * NCH + cidx) * 512 + ch] = ai[1][15];
                    }
                    hlf[0] = ai[0]; hlf[1] = ai[1];
                    if (lat) {
                        const int p0 = 32 * hf; bf16_t* pc = CAF + (size_t)(tokbase + ((r & 1) ? 63 - p0 : p0)) * 512 + ch; const long stride = (r & 1) ? -512 : 512;
#pragma unroll
                        for (int t = 0; t < 2; ++t)
#pragma unroll
                            for (int i = 0; i < 16; ++i) { *pc = f2bf(ar[t][i]); pc += stride; asm volatile("" : "+v"(pc)); }
                    }
                } else {
#pragma unroll
                    for (int t = 1; t >= 0; --t)
#pragma unroll
                        for (int i = 15; i >= 0; --i) { const float a = ar[t][i]; hl = a * hl + ai[t][i]; ca *= a; ai[t][i] = hl; ar[t][i] = ca; }
                    const float P1 = __shfl(ca, (lane & 31) + 32), H1 = __shfl(hl, (lane & 31) + 32);
                    if (hf == 0) {
#pragma unroll
                        for (int t = 0; t < 2; ++t)
#pragma unroll
                            for (int i = 0; i < 16; ++i) { ai[t][i] += ar[t][i] * H1; ar[t][i] *= P1; }
                        sumP[(size_t)((b * 2 + 1) * NCH + cidx) * 512 + ch] = ar[0][0]; sumH[(size_t)((b * 2 + 1) * NCH + cidx) * 512 + ch] = ai[0][0];
                    }
                    if (lat) {
                        const int p0 = 32 * hf; const size_t o0 = (size_t)(tokbase + ((r & 1) ? 63 - p0 : p0)) * 512 + ch; bf16_t* pc = CAB + o0; bf16_t* ps = SSb + o0; const long stride = (r & 1) ? -512 : 512;
#pragma unroll
                        for (int t = 0; t < 2; ++t)
#pragma unroll
                            for (int i = 0; i < 16; ++i) { *pc = f2bf(ar[t][i]); *ps = f2bf(hlf[t][i] + ai[t][i]); pc += stride; ps += stride; asm volatile("" : "+v"(pc), "+v"(ps)); }
                    }
                }
            }
        }
        __syncthreads();
    }
}

DI void phase_cat(const Frame& F) {
    LAS float* cinf = (LAS float*)F.lds; LAS float* cinb = cinf + 512;
    const float* sumP = (const float*)(F.ws + WS_SUMP); const float* sumH = (const float*)(F.ws + WS_SUMH);
    const bf16_t* SSb = (const bf16_t*)(F.ws + WS_SS); const bf16_t* CAF = (const bf16_t*)(F.ws + WS_CAF); const bf16_t* CAB = (const bf16_t*)(F.ws + WS_CAB);
    const bf16_t* XRGR = (const bf16_t*)(F.ws + WS_XRGR); const bf16_t* FO = (const bf16_t*)(F.ws + WS_FO); bf16_t* CAT = (bf16_t*)(F.ws + WS_UT);
    const float* gof = F.in[I_GOF]; const float* gor = F.in[I_GOR];
    for (int u = F.blk; u < 512; u += F.G) {
        const int b = u >> 6, r = u & 63;
        { const int t = F.tid; float hfw = 0.f, hbw = 0.f;
          const float* pf = sumP + (size_t)((b * 2 + 0) * NCH) * 512 + t; const float* qf = sumH + (size_t)((b * 2 + 0) * NCH) * 512 + t;
          for (int c = 0; c < 4 + r; ++c) hfw = pf[c * 512] * hfw + qf[c * 512];
          const float* pb = sumP + (size_t)((b * 2 + 1) * NCH) * 512 + t; const float* qb = sumH + (size_t)((b * 2 + 1) * NCH) * 512 + t;
          for (int c = 3; c >= 0; --c) hbw = pb[c * 512] * hbw + qb[c * 512];
          for (int c = NCH - 1; c > 4 + r; --c) hbw = pb[c * 512] * hbw + qb[c * 512];
          cinf[t] = hfw; cinb[t] = hbw; }
        __syncthreads();
        float cf[8], cb[8], gf[8], gr_[8];
#pragma unroll
        for (int j = 0; j < 8; ++j) { cf[j] = cinf[8 * F.lane + j]; cb[j] = cinb[8 * F.lane + j]; gf[j] = gof[8 * F.lane + j]; gr_[j] = gor[8 * F.lane + j]; }
        for (int i = 0; i < 8; ++i) {
            const int tk = b * SEQ + 64 * r + F.wave * 8 + i;
            const u32x4 s4 = *(const u32x4*)(SSb + (size_t)tk * 512 + 8 * F.lane), a4 = *(const u32x4*)(CAF + (size_t)tk * 512 + 8 * F.lane), b4 = *(const u32x4*)(CAB + (size_t)tk * 512 + 8 * F.lane);
            const u32x4 g4 = *(const u32x4*)(XRGR + (size_t)tk * 1024 + 512 + 8 * F.lane), f4 = *(const u32x4*)(FO + (size_t)tk * 512 + 8 * F.lane);
            float rg[8], fo[8]; float sr = 0.f, sf = 0.f;
#pragma unroll
            for (int j = 0; j < 4; ++j) {
                const float y0 = bflo(s4[j]) + bflo(a4[j]) * cf[2 * j] + bflo(b4[j]) * cb[2 * j], y1 = bfhi(s4[j]) + bfhi(a4[j]) * cf[2 * j + 1] + bfhi(b4[j]) * cb[2 * j + 1];
                rg[2 * j] = y0 * gelu_tanh(bflo(g4[j])); rg[2 * j + 1] = y1 * gelu_tanh(bfhi(g4[j]));
                fo[2 * j] = bflo(f4[j]); fo[2 * j + 1] = bfhi(f4[j]);
                sr += rg[2 * j] * rg[2 * j] + rg[2 * j + 1] * rg[2 * j + 1]; sf += fo[2 * j] * fo[2 * j] + fo[2 * j + 1] * fo[2 * j + 1]; }
            sr = wave_sum(sr); sf = wave_sum(sf);
            const float rr = rsqrtf(sr * (1.0f / 512.0f) + EPS), rf = rsqrtf(sf * (1.0f / 512.0f) + EPS);
            u32x4 of, orr;
            of.x = cvt_pk_bf16(fo[0] * rf * gf[0], fo[1] * rf * gf[1]); of.y = cvt_pk_bf16(fo[2] * rf * gf[2], fo[3] * rf * gf[3]); of.z = cvt_pk_bf16(fo[4] * rf * gf[4], fo[5] * rf * gf[5]); of.w = cvt_pk_bf16(fo[6] * rf * gf[6], fo[7] * rf * gf[7]);
            orr.x = cvt_pk_bf16(rg[0] * rr * gr_[0], rg[1] * rr * gr_[1]); orr.y = cvt_pk_bf16(rg[2] * rr * gr_[2], rg[3] * rr * gr_[3]); orr.z = cvt_pk_bf16(rg[4] * rr * gr_[4], rg[5] * rr * gr_[5]); orr.w = cvt_pk_bf16(rg[6] * rr * gr_[6], rg[7] * rr * gr_[7]);
            *(u32x4*)(CAT + (size_t)tk * 1024 + 8 * F.lane) = of; *(u32x4*)(CAT + (size_t)tk * 1024 + 512 + 8 * F.lane) = orr;
        }
        __syncthreads();
    }
}

DI void phase_router(const Frame& F) {
    LAS float* wrT = (LAS float*)F.lds;
    LAS int* wcnt = (LAS int*)(F.lds + MISC_OFF + 1024);
    const float* wrt = F.in[I_WR]; const float* brt = F.in[I_BR]; const float* g = F.in[I_GFFN]; const float* mod = (const float*)(F.ws + WS_MOD);
    const float* X1 = (const float*)(F.ws + WS_X1); bf16_t* H = (bf16_t*)(F.ws + WS_H);
    int* toke = (int*)(F.ws + WS_TOKE); float* tokg = (float*)(F.ws + WS_TOKG); int* cnt = (int*)(F.ws + WS_CNT);
    for (int i = 0; i < 16; ++i) { const int idx = F.tid + 512 * i; const int e = idx & 31, kq = idx >> 5;
        f32x4 v; v[0] = wrt[(4 * kq + 0) * 32 + e]; v[1] = wrt[(4 * kq + 1) * 32 + e]; v[2] = wrt[(4 * kq + 2) * 32 + e]; v[3] = wrt[(4 * kq + 3) * 32 + e];
        *(LAS f32x4*)(wrT + e * 1024 + 4 * (kq ^ e)) = v; }
    if (F.tid < 256) wcnt[F.tid] = 0;
    __syncthreads();
    float br[32];
#pragma unroll
    for (int e = 0; e < 32; ++e) br[e] = brt[e];
    for (int it = 0;; ++it) {
        const int row = (it * F.G + F.blk) * 8 + F.wave; if (row >= T) break;
        const int bi = row >> 12;
        f32x4 v[4]; float ss = 0.f;
#pragma unroll
        for (int q = 0; q < 4; ++q) { v[q] = *(const f32x4*)(X1 + (size_t)row * D + 4 * F.lane + 256 * q); ss += v[q][0] * v[q][0] + v[q][1] * v[q][1] + v[q][2] * v[q][2] + v[q][3] * v[q][3]; }
        ss = wave_sum(ss); const float rstd = rsqrtf(ss * (1.0f / 1024.0f) + EPS);
#pragma unroll
        for (int q = 0; q < 4; ++q) { const int k = 4 * F.lane + 256 * q;
            const f32x4 gg = *(const f32x4*)(g + k), sh = *(const f32x4*)(mod + bi * 6144 + 3072 + k), sc = *(const f32x4*)(mod + bi * 6144 + 4096 + k);
            v[q] = v[q] * rstd * gg * (1.0f + sc) + sh;
            u32x2 w; w.x = cvt_pk_bf16(v[q][0], v[q][1]); w.y = cvt_pk_bf16(v[q][2], v[q][3]);
            *(u32x2*)(H + (size_t)row * D + k) = w; }
        float lg[32];
#pragma unroll
        for (int e = 0; e < 32; ++e) { float s = 0.f;
#pragma unroll
            for (int q = 0; q < 4; ++q) { const f32x4 w = *(const LAS f32x4*)(wrT + e * 1024 + 4 * ((F.lane + 64 * q) ^ e)); s += v[q][0] * w[0] + v[q][1] * w[1] + v[q][2] * w[2] + v[q][3] * w[3]; }
            lg[e] = wave_sum(s) + br[e]; }
        int sel[4]; float val[4];
#pragma unroll
        for (int p = 0; p < 4; ++p) { float best = -3.0e38f; int bi2 = 0;
#pragma unroll
            for (int e = 0; e < 32; ++e) { const bool taken = (p > 0 && e == sel[0]) || (p > 1 && e == sel[1]) || (p > 2 && e == sel[2]); if (!taken && lg[e] > best) { best = lg[e]; bi2 = e; } }
            sel[p] = bi2; val[p] = best; }
        const float e0 = 1.0f, e1 = __expf(val[1] - val[0]), e2 = __expf(val[2] - val[0]), e3 = __expf(val[3] - val[0]); const float inv = 1.0f / (e0 + e1 + e2 + e3);
        if (F.lane < 4) { const int se = F.lane == 0 ? sel[0] : F.lane == 1 ? sel[1] : F.lane == 2 ? sel[2] : sel[3]; const float sg = (F.lane == 0 ? e0 : F.lane == 1 ? e1 : F.lane == 2 ? e2 : e3) * inv;
            toke[row * 4 + F.lane] = se; tokg[row * 4 + F.lane] = sg; wcnt[F.wave * 32 + se] += 1; }
    }
    __syncthreads();
    if (F.tid < 256) cnt[F.blk * 256 + F.tid] = wcnt[F.tid];
    __syncthreads();
}

DI void phase_slots(const Frame& F) {
    LAS int* part = (LAS int*)F.lds;
    LAS int* tot = part + 1024; LAS int* bef = tot + 32; LAS int* pst = bef + 32; LAS int* base = pst + 32;
    const int* cnt = (const int*)(F.ws + WS_CNT); const int* toke = (const int*)(F.ws + WS_TOKE); const float* tokg = (const float*)(F.ws + WS_TOKG);
    int* toks = (int*)(F.ws + WS_TOKS); int* rowtok = (int*)(F.ws + WS_ROWTOK); float* rowgate = (float*)(F.ws + WS_ROWGATE); int* tile = (int*)(F.ws + WS_TILE);
    const int nrows = F.G * 8;
    { const int e = F.tid & 31, pt = F.tid >> 5; int sa = 0, sb = 0; const int per = (nrows + 15) / 16;
      for (int rw = pt * per; rw < (pt + 1) * per && rw < nrows; ++rw) { const int c = cnt[rw * 32 + e]; sa += c; if (rw < F.blk * 8) sb += c; }
      part[pt * 32 + e] = sa; part[512 + pt * 32 + e] = sb; }
    __syncthreads();
    if (F.tid < 32) { int sa = 0, sb = 0; for (int pt = 0; pt < 16; ++pt) { sa += part[pt * 32 + F.tid]; sb += part[512 + pt * 32 + F.tid]; } tot[F.tid] = sa; bef[F.tid] = sb; }
    __syncthreads();
    if (F.tid == 0) { int run = 0; for (int e = 0; e < 32; ++e) { pst[e] = run; run += (tot[e] + 255) / 256 * 256; }
        if (F.blk == 0) { tile[1000] = run / 256; } }
    __syncthreads();
    if (F.tid < 256) { const int w = F.tid >> 5, e = F.tid & 31; int s = pst[e] + bef[e]; for (int w2 = 0; w2 < w; ++w2) s += cnt[(F.blk * 8 + w2) * 32 + e]; base[w * 32 + e] = s; }
    if (F.blk == 0) { for (int i = F.tid; i < 544; i += 512) { int e = 0; for (int q = 0; q < 32; ++q) if (i * 256 >= pst[q] + (tot[q] + 255) / 256 * 256) e = q + 1; tile[i] = e < 31 ? e : 31; } }
    if (F.blk < 32) { const int e = F.blk; const int s0 = pst[e] + tot[e], s1 = pst[e] + (tot[e] + 255) / 256 * 256; for (int s = s0 + F.tid; s < s1; s += 512) { rowtok[s] = 0; rowgate[s] = 0.f; } }
    __syncthreads();
    for (int it = 0;; ++it) {
        const int row = (it * F.G + F.blk) * 8 + F.wave; if (row >= T) break;
        if (F.lane < 4) { const int e = toke[row * 4 + F.lane]; const int s = base[F.wave * 32 + e]; base[F.wave * 32 + e] = s + 1;
            toks[row * 4 + F.lane] = s; rowtok[s] = row; rowgate[s] = tokg[row * 4 + F.lane]; }
    }
    __syncthreads();
}

DI void phase_final(const Frame& F) {
    const float* X1 = (const float*)(F.ws + WS_X1); const bf16_t* YA = (const bf16_t*)(F.ws + WS_YA); const int* toks = (const int*)(F.ws + WS_TOKS);
    const float* mod = (const float*)(F.ws + WS_MOD); const float* gfin = F.in[I_GFIN]; float* out = F.out;
    for (int it = 0;; ++it) {
        const int row = (it * F.G + F.blk) * 8 + F.wave; if (row >= T) break;
        const int bi = row >> 12;
        int sl[4];
#pragma unroll
        for (int k = 0; k < 4; ++k) sl[k] = toks[row * 4 + k];
        float ss = 0.f; f32x4 xo[2][2];
#pragma unroll
        for (int q = 0; q < 2; ++q) { const int c0 = 8 * (F.lane + 64 * q);
            float m[8];
#pragma unroll
            for (int j = 0; j < 8; ++j) m[j] = 0.f;
#pragma unroll
            for (int k = 0; k < 4; ++k) { const u32x4 y = *(const u32x4*)(YA + (size_t)sl[k] * 1024 + c0);
#pragma unroll
                for (int j = 0; j < 4; ++j) { m[2 * j] += bflo(y[j]); m[2 * j + 1] += bfhi(y[j]); } }
#pragma unroll
            for (int hq = 0; hq < 2; ++hq) { const f32x4 xv = *(const f32x4*)(X1 + (size_t)row * D + c0 + 4 * hq), gt = *(const f32x4*)(mod + bi * 6144 + 5120 + c0 + 4 * hq);
                f32x4 mm; mm[0] = m[4 * hq]; mm[1] = m[4 * hq + 1]; mm[2] = m[4 * hq + 2]; mm[3] = m[4 * hq + 3];
                const f32x4 x2 = xv + gt * mm; xo[q][hq] = x2; ss += x2[0] * x2[0] + x2[1] * x2[1] + x2[2] * x2[2] + x2[3] * x2[3]; } }
        ss = wave_sum(ss); const float rstd = rsqrtf(ss * (1.0f / 1024.0f) + EPS);
#pragma unroll
        for (int q = 0; q < 2; ++q)
#pragma unroll
            for (int hq = 0; hq < 2; ++hq) { const int c0 = 8 * (F.lane + 64 * q) + 4 * hq; const f32x4 gg = *(const f32x4*)(gfin + c0); *(f32x4*)(out + (size_t)row * D + c0) = xo[q][hq] * rstd * gg; }
    }
}

__global__ void __launch_bounds__(512, 2) fwd_kernel(Args args) {
    extern __shared__ __attribute__((aligned(16))) unsigned char lds_raw[];
    Frame F;
    F.lds = (LAS unsigned char*)lds_raw; F.tid = threadIdx.x; F.lane = F.tid & 63; F.wave = __builtin_amdgcn_readfirstlane(F.tid >> 6);
    F.G = gridDim.x; F.blk = blockIdx.x; F.vcu = (F.G % 8 == 0) ? (F.blk % 8) * (F.G / 8) + F.blk / 8 : F.blk;
#pragma unroll
    for (int i = 0; i < 27; ++i) F.in[i] = args.in[i];
    F.out = args.out; F.ws = args.ws;
    volatile LAS unsigned* MISC = (volatile LAS unsigned*)(F.lds + MISC_OFF);
    if (F.tid < 64) MISC[F.tid] = 0u;
    __syncthreads();
    const int lo = args.ph_lo, hi = args.ph_hi;
    unsigned* barw = (unsigned*)(F.ws + WS_CTL) + CW_BAR;
    XcdBarrier bar; bar.bar = barw; bar.x = 0; bar.st = nullptr;
    if (hi - lo > 1) bar = xcd_barrier_post(barw, MISC + 8);
#ifndef PH_MASK
#define PH_MASK 0x7ff
#endif
#define IN(k) (((PH_MASK >> (k)) & 1) && lo <= (k) && (k) < hi)
#define SEAM(k) do { if (IN(k) && IN((k) + 1)) xcd_barrier(bar); } while (0)
    LAS unsigned char* ring = F.lds;

    if (IN(0)) { phase0(F); } SEAM(0);
    if (IN(1)) { phase1(F); } SEAM(1);
    if (IN(2)) {
        {
            pg8::Gemm g{(const bf16_t*)(F.ws + WS_H), (const bf16_t*)(F.ws + WS_WIN2), 1024};
            pg8::SchedPlain S{TT / 256, 4, F.G, F.vcu}; pg8::EpiBf16Plain E{(bf16_t*)(F.ws + WS_XRGR), 1024};
            pg8::gemm_phase(ring, g, S, E);
        }
        {
            pg8::Gemm g{(const bf16_t*)(F.ws + WS_WFS), (const bf16_t*)(F.ws + WS_H), 1024};
            pg8::SchedPlain S{4, T / 256, F.G, F.vcu}; pg8::EpiUt E{(bf16_t*)(F.ws + WS_UT)};
            pg8::gemm_phase(ring, g, S, E);
        }
    } SEAM(2);
    if (IN(3)) {
#ifndef SKIP_DFT
        {
            pg8::Gemm g{(const bf16_t*)(F.ws + WS_DFT), (const bf16_t*)(F.ws + WS_UT), 8192};
            pg8::SchedPlain S{16, 16, F.G, F.vcu}; pg8::EpiDft E{(bf16_t*)(F.ws + WS_FO)};
            pg8::gemm_phase(ring, g, S, E);
        }
#endif
#ifndef SKIP_RG
        phase_rg(F);
#endif
    } SEAM(3);
    if (IN(4)) { phase_cat(F); } SEAM(4);
    if (IN(5)) {
        pg8::Gemm g{(const bf16_t*)(F.ws + WS_UT), (const bf16_t*)(F.ws + WS_WOUT), 1024};
        pg8::SchedPlain S{T / 256, 4, F.G, F.vcu}; pg8::EpiResid E{F.in[I_X], (const float*)(F.ws + WS_MOD), (float*)(F.ws + WS_X1)};
        pg8::gemm_phase(ring, g, S, E);
    } SEAM(5);
    if (IN(6)) { phase_router(F); } SEAM(6);
    if (IN(7)) { phase_slots(F); } SEAM(7);
    if (IN(8)) {
        pg8::Gemm g{(const bf16_t*)(F.ws + WS_H), (const bf16_t*)(F.ws + WS_WGU), 1024};
        pg8::SchedMoe S{(const int*)(F.ws + WS_TILE), (const int*)(F.ws + WS_ROWTOK), 8, F.G, F.vcu}; pg8::EpiAct E{F.in[I_BGU], (bf16_t*)(F.ws + WS_ACT)};
        pg8::gemm_phase(ring, g, S, E);
    } SEAM(8);
    if (IN(9)) {
        pg8::Gemm g{(const bf16_t*)(F.ws + WS_ACT), (const bf16_t*)(F.ws + WS_WDOWN), 1024};
        pg8::SchedMoe S{(const int*)(F.ws + WS_TILE), nullptr, 4, F.G, F.vcu}; pg8::EpiDown E{F.in[I_BD], (const float*)(F.ws + WS_ROWGATE), (bf16_t*)(F.ws + WS_YA)};
        pg8::gemm_phase(ring, g, S, E);
    } SEAM(9);
    if (IN(10)) { phase_final(F); }
#undef IN
#undef SEAM
}

extern "C" void kernel_launch(void* const* d_in, const int* in_sizes, int n_in, void* d_out, int out_size, void* d_ws, size_t ws_size, hipStream_t stream) {
    static int grid = 0;
    if (grid == 0) {
        if (n_in != 27 || out_size != T * D || ws_size < WS_END) { fprintf(stderr, "kernel_launch: unexpected shapes (n_in %d out %d ws %zu)\n", n_in, out_size, ws_size); grid = -1; return; }
        int dev = 0, cus = 0, per_cu = 0;
        if (hipGetDevice(&dev) != hipSuccess || hipDeviceGetAttribute(&cus, hipDeviceAttributeMultiprocessorCount, dev) != hipSuccess) { grid = -1; return; }
        if (hipFuncSetAttribute((const void*)fwd_kernel, hipFuncAttributeMaxDynamicSharedMemorySize, LDS_BYTES) != hipSuccess) { fprintf(stderr, "kernel_launch: hipFuncSetAttribute failed\n"); grid = -1; return; }
        if (hipOccupancyMaxActiveBlocksPerMultiprocessor(&per_cu, (const void*)fwd_kernel, 512, LDS_BYTES) != hipSuccess || per_cu < 1) { fprintf(stderr, "kernel_launch: occupancy query says %d\n", per_cu); }
        (void)hipGetLastError();
        grid = cus;
    }
    if (grid < 0) return;
    (void)hipMemsetAsync((char*)d_ws + WS_CTL, 0, CTL_BYTES, stream);
    Args a{};
    for (int i = 0; i < 27; ++i) a.in[i] = (const float*)d_in[i];
    a.out = (float*)d_out; a.ws = (unsigned char*)d_ws;
#if N_LAUNCH_MODE == 1
    a.ph_lo = 0; a.ph_hi = NPHASE;
    hipLaunchKernelGGL(fwd_kernel, dim3(grid), dim3(512), LDS_BYTES, stream, a);
#else
    for (int p = 0; p < NPHASE; ++p) { a.ph_lo = p; a.ph_hi = p + 1; hipLaunchKernelGGL(fwd_kernel, dim3(grid), dim3(512), LDS_BYTES, stream, a); }
#endif
}
```

```cpp
#include <hip/hip_runtime.h>
#include <stdint.h>
#include <stdio.h>

#define DI __device__ __forceinline__
#define LAS __attribute__((address_space(3)))
typedef unsigned short bf16_t;
typedef short bf16x8 __attribute__((ext_vector_type(8)));
typedef float f32x4 __attribute__((ext_vector_type(4)));
typedef float f32x16 __attribute__((ext_vector_type(16)));
typedef unsigned u32x4 __attribute__((ext_vector_type(4)));
typedef unsigned u32x2 __attribute__((ext_vector_type(2)));
typedef int i32x4 __attribute__((ext_vector_type(4)));
typedef int i32x8 __attribute__((ext_vector_type(8)));

constexpr int D = 1024, NB = 8, SEQ = 4096, T = NB * SEQ, CTXL = 256, TC = NB * CTXL, TT = T + TC;
constexpr int DR = 512, NE = 32;
constexpr int CAP = (T * 4 / 256 + NE) * 256;
constexpr int NCH = 68;
constexpr float EPS = 1e-6f;
#ifndef N_LAUNCH_MODE
#define N_LAUNCH_MODE 1
#endif
constexpr int NPHASE = 12;

constexpr size_t MiB = 1u << 20;
constexpr size_t WS_CTL = 0, CTL_BYTES = 1 * MiB;
constexpr size_t WS_MOD = 1 * MiB;
constexpr size_t WS_RGW = 1 * MiB + 256 * 1024;
constexpr size_t WS_TILE = 1 * MiB + 512 * 1024;
constexpr size_t WS_CNT = 2 * MiB;
constexpr size_t WS_CF = 2 * MiB + 256 * 1024;
constexpr size_t WS_WMF = 2 * MiB + 512 * 1024;
constexpr size_t WS_TOKE = 3 * MiB;
constexpr size_t WS_TOKG = 3 * MiB + 512 * 1024;
constexpr size_t WS_TOKS = 4 * MiB;
constexpr size_t WS_ROWTOK = 4 * MiB + 512 * 1024;
constexpr size_t WS_ROWGATE = 5 * MiB + 256 * 1024;
constexpr size_t WS_SUMP = 6 * MiB;
constexpr size_t WS_SUMH = 8 * MiB + 256 * 1024;
constexpr size_t WS_WIN = 11 * MiB;
constexpr size_t WS_WOUT = 15 * MiB;
constexpr size_t WS_WDOWN = 17 * MiB;
constexpr size_t WS_WGU = 49 * MiB;
constexpr size_t WS_H = 113 * MiB;
constexpr size_t WS_GMIX = 181 * MiB;
constexpr size_t WS_YA = 309 * MiB;
constexpr size_t WS_XP = 581 * MiB;
constexpr size_t WS_ZG = 683 * MiB;
constexpr size_t WS_CAT = 747 * MiB;
constexpr size_t WS_SS = 843 * MiB;
constexpr size_t WS_CAF = 875 * MiB;
constexpr size_t WS_CAB = 907 * MiB;
constexpr size_t WS_ACT = 581 * MiB;
constexpr size_t WS_END = 939 * MiB;
static_assert(WS_ACT + (size_t)CAP * 1024 <= WS_CAT && WS_YA + (size_t)CAP * 2048 <= WS_XP && WS_XP + (size_t)TT * 3072 <= WS_ZG && WS_ROWGATE + CAP * 4 <= WS_SUMP && WS_SUMH + 8 * 2 * 68 * 512 * 4 <= WS_WIN, "ws map");

constexpr int CW_BAR = 4096;
constexpr int LDS_BYTES = 163840;
constexpr int MISC_OFF = 135168;
constexpr int UT_OFF = MISC_OFF + 2048, RTL_OFF = MISC_OFF + 2560, BL_OFF = MISC_OFF + 11264, MAXU = 17;
static_assert(RTL_OFF + MAXU * 512 <= BL_OFF && BL_OFF + MAXU * 1024 <= LDS_BYTES, "LDS map");

DI unsigned cvt_pk_bf16(float lo, float hi) { unsigned r; asm("v_cvt_pk_bf16_f32 %0, %1, %2" : "=v"(r) : "v"(lo), "v"(hi)); return r; }
DI float bflo(unsigned w) { return __uint_as_float(w << 16); }
DI float bfhi(unsigned w) { return __uint_as_float(w & 0xffff0000u); }
DI float bf2f(bf16_t b) { return __uint_as_float(((unsigned)b) << 16); }
DI bf16_t f2bf(float f) { return (bf16_t)(cvt_pk_bf16(f, 0.f) & 0xffffu); }
DI unsigned cvt_pk_fp8x4(float a, float b, float c, float d) { unsigned r = 0; r = __builtin_amdgcn_cvt_pk_fp8_f32(a, b, r, false); r = __builtin_amdgcn_cvt_pk_fp8_f32(c, d, r, true); return r; }
DI float wave_sum(float v) { v += __shfl_xor(v, 32); v += __shfl_xor(v, 16); v += __shfl_xor(v, 8); v += __shfl_xor(v, 4); v += __shfl_xor(v, 2); v += __shfl_xor(v, 1); return v; }
DI float sigmoidf_(float x) { return __builtin_amdgcn_rcpf(1.0f + __expf(-x)); }
DI float gelu_tanh(float x) { const float z = 0.7978845608028654f * (x + 0.044715f * x * x * x); const float e = __expf(2.0f * z); return x * (1.0f - __builtin_amdgcn_rcpf(1.0f + e)); }

#define XB_TMO      128
#define XB_XCNT(j)  (256  + 64 * (j))
#define XB_XSUB(j)  (1280 + 64 * (j))
#define XB_XGEN(j)  (2304 + 64 * (j))
#define XB_TOP      3328
#define XB_TOPGEN   3392
#define XCD_BAR_WORDS 3456
#define XB_SPIN_CAP (1u << 18)
DI unsigned xb_ld(unsigned* p)              { return __hip_atomic_load(p, __ATOMIC_RELAXED, __HIP_MEMORY_SCOPE_AGENT); }
DI unsigned xb_add(unsigned* p, unsigned v) { return __hip_atomic_fetch_add(p, v, __ATOMIC_RELAXED, __HIP_MEMORY_SCOPE_AGENT); }
DI unsigned xb_xcc_id() { return (unsigned)__builtin_amdgcn_s_getreg((3 << 11) | 20) & 0xFu; }
#define XB_SPIN(cond, bar) do { unsigned _sp = 0; while (cond) { __builtin_amdgcn_s_sleep(1); \
    if ((++_sp & 255u) == 0u) { if (xb_ld(&(bar)[XB_TMO])) break; if (_sp > XB_SPIN_CAP) { atomicAdd(&(bar)[XB_TMO], 1u); break; } } } } while (0)
struct XcdBarrier { unsigned* bar; unsigned x; volatile LAS unsigned* st; };
DI XcdBarrier xcd_barrier_post(unsigned* bar, volatile LAS unsigned* st) {
    XcdBarrier b; b.bar = bar; b.x = xb_xcc_id(); b.st = st;
    if (threadIdx.x == 0) (void)xb_add(&bar[XB_XCNT(b.x)], 1u);
    return b;
}
DI void xcd_barrier_complete(unsigned* bar, unsigned x, unsigned& nloc, unsigned& nx) {
    const unsigned G = gridDim.x * gridDim.y * gridDim.z;
    unsigned sum, cnt, mine, sp = 0u;
    for (;;) {
        sum = 0u; cnt = 0u; mine = 0u;
#pragma unroll
        for (unsigned j = 0; j < 16; ++j) { const unsigned c = xb_ld(&bar[XB_XCNT(j)]); sum += c; cnt += (c > 0u) ? 1u : 0u; mine = (j == x) ? c : mine; }
        if (sum == G) break;
        __builtin_amdgcn_s_sleep(1);
        if ((++sp & 255u) == 0u) { if (xb_ld(&bar[XB_TMO])) break; if (sp > XB_SPIN_CAP) { atomicAdd(&bar[XB_TMO], 1u); break; } }
    }
    nloc = mine > 0u ? mine : 1u; nx = cnt > 0u ? cnt : 1u;
}
DI void xcd_barrier(const XcdBarrier& b) {
    asm volatile("s_waitcnt vmcnt(0)" ::: "memory");
    __syncthreads();
    if (threadIdx.x == 0) {
        unsigned* bar = b.bar;
        __builtin_amdgcn_s_waitcnt(0);
        unsigned nloc = b.st[0], nx = b.st[1];
        if (nloc == 0u) { xcd_barrier_complete(bar, b.x, nloc, nx); b.st[0] = nloc; b.st[1] = nx; }
        const unsigned old = xb_add(&bar[XB_XSUB(b.x)], 1u);
        const unsigned gen = old / nloc;
        if (old + 1u == (gen + 1u) * nloc) {
            __builtin_amdgcn_fence(__ATOMIC_RELEASE, "agent");
            asm volatile("s_waitcnt vmcnt(0)" ::: "memory");
            const unsigned og = xb_add(&bar[XB_TOP], 1u);
            const unsigned tg = og / nx;
            if (og + 1u == (tg + 1u) * nx) xb_add(&bar[XB_TOPGEN], 1u);
            else XB_SPIN(xb_ld(&bar[XB_TOPGEN]) == tg, bar);
            __builtin_amdgcn_fence(__ATOMIC_ACQUIRE, "agent");
            xb_add(&bar[XB_XGEN(b.x)], 1u);
            asm volatile("s_waitcnt vmcnt(0)" ::: "memory");
        } else {
            XB_SPIN(xb_ld(&bar[XB_XGEN(b.x)]) == gen, bar);
            __builtin_amdgcn_fence(__ATOMIC_ACQUIRE, "agent");
            asm volatile("s_waitcnt vmcnt(0)" ::: "memory");
        }
    }
    __syncthreads();
}

namespace pg8 {
constexpr int BM = 256, BK = 64, HALF = 128, HTB = HALF * BK * 2, STAGE_BYTES = 8 * HTB;
DI int lds_byte(int r, int c) { const int st = (r >> 4) * 2 + (c >> 5), rr = r & 15, cc = c & 31, ob = rr * 64 + cc * 2; return st * 1024 + (ob ^ (((ob >> 9) & 1) << 5)); }
DI void stage_rc(int b, int& R, int& C) { const int st = b / 1024, sb = b % 1024, swz = sb ^ (((sb >> 9) & 1) << 5); R = (st >> 1) * 16 + swz / 64; C = (st & 1) * 32 + (swz % 64) / 2; }
DI int perm32(int rho) { const int n = rho >> 4, i = rho & 15; return 8 * (i >> 2) + 4 * n + (i & 3); }
struct Unit { int pm, pn, aux, ix; };
struct Gemm { const bf16_t* A; const bf16_t* Bt; int K; };

template <class Epi, class Sched>
DI void gemm_phase(LAS unsigned char* lds, const Gemm g, const Sched& S, const Epi& E) {
    const int tid = threadIdx.x, wid = __builtin_amdgcn_readfirstlane(tid >> 6), lane = tid & 63, wr = wid >> 2, wc = wid & 3, fr = lane & 15, fq = lane >> 4;
    const int K = g.K, nt = K / BK;
    int RA[2], CA[2]; unsigned voffB[2];
#pragma unroll
    for (int i = 0; i < 2; ++i) { int R, C; stage_rc(tid * 16 + i * 8192, R, C); const int Rb = Epi::PERM ? ((R & ~31) + perm32(R & 31)) : R;
        RA[i] = R; CA[i] = C; voffB[i] = (unsigned)(Rb * K + C) * 2u; }
    const unsigned kstep = (unsigned)(BK * 2);
    const size_t hstep = (size_t)HALF * K * 2;
    const unsigned ldsw = (unsigned)wid * 1024u;
    const int aoff = lds_byte(wr * 64 + fr, fq * 8), boff = lds_byte(wc * 32 + fr, fq * 8);
#define PG8_SA(b, h) (((b) * 2 + (h)) * HTB)
#define PG8_SB(b, h) ((4 + (b) * 2 + (h)) * HTB)
#define PG8_STAGE_B(bufoff, gbase) do { _Pragma("unroll") for (int _i = 0; _i < 2; ++_i) \
        __builtin_amdgcn_global_load_lds((const unsigned*)((const char*)(gbase) + voffB[_i]), (LAS unsigned*)(lds + (bufoff) + ldsw + _i * 8192), 16, 0, 0); } while (0)
#define PG8_STAGE_A(bufoff, kb, o, h) do { _Pragma("unroll") for (int _i = 0; _i < 2; ++_i) \
        __builtin_amdgcn_global_load_lds((const unsigned*)((const char*)g.A + (size_t)(kb) + (o)[h][_i]), (LAS unsigned*)(lds + (bufoff) + ldsw + _i * 8192), 16, 0, 0); } while (0)
#define PG8_LDA(dst, b, h) do { if constexpr (Epi::FP8) { _Pragma("unroll") for (int m = 0; m < 4; ++m) { \
            const i32x4 lo_ = *(const LAS i32x4*)(lds + PG8_SA(b, h) + aoff + m * 2048), hi_ = *(const LAS i32x4*)(lds + PG8_SA(b, h) + aoff + m * 2048 + 1024); \
            dst##8[m] = __builtin_shufflevector(lo_, hi_, 0, 1, 2, 3, 4, 5, 6, 7); } } \
        else { _Pragma("unroll") for (int m = 0; m < 4; ++m) _Pragma("unroll") for (int k = 0; k < 2; ++k) dst[m][k] = *(const LAS bf16x8*)(lds + PG8_SA(b, h) + aoff + m * 2048 + k * 1024); } } while (0)
#define PG8_LDB(dst, b, h) do { if constexpr (Epi::FP8) { _Pragma("unroll") for (int n = 0; n < 2; ++n) { \
            const i32x4 lo_ = *(const LAS i32x4*)(lds + PG8_SB(b, h) + boff + n * 2048), hi_ = *(const LAS i32x4*)(lds + PG8_SB(b, h) + boff + n * 2048 + 1024); \
            dst##8[n] = __builtin_shufflevector(lo_, hi_, 0, 1, 2, 3, 4, 5, 6, 7); } } \
        else { _Pragma("unroll") for (int n = 0; n < 2; ++n) _Pragma("unroll") for (int k = 0; k < 2; ++k) dst[n][k] = *(const LAS bf16x8*)(lds + PG8_SB(b, h) + boff + n * 2048 + k * 1024); } } while (0)
#define PG8_MMA(ai, bj, At, Bt) do { __builtin_amdgcn_s_setprio(1); \
        if constexpr (Epi::FP8) { _Pragma("unroll") for (int m = 0; m < 4; ++m) _Pragma("unroll") for (int n = 0; n < 2; ++n) \
            asm volatile("v_mfma_scale_f32_16x16x128_f8f6f4 %0, %1, %2, %0, %3, %4 op_sel_hi:[0,0,0]" : "+v"(acc[ai][bj][m][n]) : "v"(Bt##8[n]), "v"(At##8[m]), "v"(scale_w_), "v"(scale_a_)); } \
        else { _Pragma("unroll") for (int m = 0; m < 4; ++m) _Pragma("unroll") for (int n = 0; n < 2; ++n) _Pragma("unroll") for (int k = 0; k < 2; ++k) \
            acc[ai][bj][m][n] = __builtin_amdgcn_mfma_f32_16x16x32_bf16(Bt[n][k], At[m][k], acc[ai][bj][m][n], 0, 0, 0); } \
        __builtin_amdgcn_s_setprio(0); } while (0)
#define PG8_WAIT_V(n) asm volatile("s_waitcnt vmcnt(" #n ")" ::: "memory")
#define PG8_WAIT_L(n) asm volatile("s_waitcnt lgkmcnt(" #n ")" ::: "memory")
#define PG8_BAR __builtin_amdgcn_s_barrier()
#define PG8_SCHED __builtin_amdgcn_sched_barrier(0)
    Unit cur, nxt; int ui = 0;
    if (!S.next(0, cur)) return;
    f32x4 acc[2][2][4][2];
#pragma unroll
    for (int a = 0; a < 2; ++a)
#pragma unroll
        for (int b = 0; b < 2; ++b)
#pragma unroll
            for (int m = 0; m < 4; ++m)
#pragma unroll
                for (int n = 0; n < 2; ++n) acc[a][b][m][n] = (f32x4){0.f, 0.f, 0.f, 0.f};
    int scale_w_ = Epi::SCALE_W, scale_a_ = 0x7f7f7f7f; asm volatile("" : "+v"(scale_w_), "+v"(scale_a_));
    bf16x8 At[4][2], B0[2][2], B1[2][2]; i32x8 At8[4], B08[2], B18[2];
    unsigned oc[2][2], on[2][2];
    S.a_off(cur, RA, CA, K, oc);
    const char* cB = (const char*)g.Bt + S.b_off(cur, K);
    PG8_STAGE_B(PG8_SB(0, 0), cB); PG8_STAGE_A(PG8_SA(0, 0), 0u, oc, 0); PG8_STAGE_B(PG8_SB(0, 1), cB + hstep); PG8_STAGE_A(PG8_SA(0, 1), 0u, oc, 1);
    if (wr == 1) PG8_BAR;
    PG8_WAIT_V(4); PG8_BAR;
    PG8_STAGE_B(PG8_SB(1, 0), cB + kstep); PG8_STAGE_A(PG8_SA(1, 0), kstep, oc, 0); PG8_STAGE_B(PG8_SB(1, 1), cB + hstep + kstep);
    PG8_WAIT_V(6); PG8_BAR;
    for (;;) {
        const bool has_next = S.next(ui + 1, nxt);
        const char* nB = cB;
        if (has_next) { S.a_off(nxt, RA, CA, K, on); nB = (const char*)g.Bt + S.b_off(nxt, K); }
        else {
#pragma unroll
            for (int h = 0; h < 2; ++h)
#pragma unroll
                for (int i = 0; i < 2; ++i) on[h][i] = oc[h][i];
        }
#pragma unroll 1
        for (int t = 0; t < nt; t += 2) {
            const bool last = (t == nt - 2);
            const unsigned k1 = (unsigned)(t + 1) * kstep;
            const unsigned k2 = last ? 0u : (unsigned)(t + 2) * kstep, k3 = k2 + kstep;
            unsigned o2[2][2];
#pragma unroll
            for (int h = 0; h < 2; ++h)
#pragma unroll
                for (int i = 0; i < 2; ++i) o2[h][i] = last ? on[h][i] : oc[h][i];
            const char* b2 = last ? nB : cB + (size_t)(t + 2) * kstep; const char* b3 = b2 + kstep;
            PG8_LDB(B0, 0, 0); PG8_SCHED; PG8_LDA(At, 0, 0); PG8_STAGE_A(PG8_SA(1, 1), k1, oc, 1);
            PG8_WAIT_L(8); PG8_BAR; PG8_WAIT_L(0); PG8_MMA(0, 0, At, B0); PG8_BAR; PG8_SCHED;
            PG8_LDB(B1, 0, 1); PG8_STAGE_B(PG8_SB(0, 0), b2);
            PG8_BAR; PG8_WAIT_L(0); PG8_MMA(0, 1, At, B1); PG8_BAR;
            PG8_LDA(At, 0, 1); PG8_STAGE_A(PG8_SA(0, 0), k2, o2, 0);
            PG8_BAR; PG8_WAIT_L(0); PG8_MMA(1, 0, At, B0); PG8_BAR; PG8_SCHED;
            PG8_STAGE_B(PG8_SB(0, 1), b2 + hstep);
            PG8_WAIT_V(6); PG8_BAR; PG8_MMA(1, 1, At, B1); PG8_BAR;
            PG8_LDB(B0, 1, 0); PG8_SCHED; PG8_LDA(At, 1, 0); PG8_STAGE_A(PG8_SA(0, 1), k2, o2, 1);
            PG8_WAIT_L(8); PG8_BAR; PG8_WAIT_L(0); PG8_MMA(0, 0, At, B0); PG8_BAR; PG8_SCHED;
            PG8_LDB(B1, 1, 1); PG8_STAGE_B(PG8_SB(1, 0), b3);
            PG8_BAR; PG8_WAIT_L(0); PG8_MMA(0, 1, At, B1); PG8_BAR;
            PG8_LDA(At, 1, 1); PG8_STAGE_A(PG8_SA(1, 0), k3, o2, 0);
            PG8_BAR; PG8_WAIT_L(0); PG8_MMA(1, 0, At, B0); PG8_BAR; PG8_SCHED;
            PG8_STAGE_B(PG8_SB(1, 1), b3 + hstep);
            PG8_WAIT_V(6); PG8_BAR; PG8_MMA(1, 1, At, B1); PG8_BAR;
        }
        if constexpr (Epi::FP8) asm volatile("s_nop 15\n\ts_nop 15" ::: "memory");
        E(acc, cur, wr, wc, fr, fq);
        if (!has_next) break;
#pragma unroll
        for (int a = 0; a < 2; ++a)
#pragma unroll
            for (int b = 0; b < 2; ++b)
#pragma unroll
                for (int m = 0; m < 4; ++m)
#pragma unroll
                    for (int n = 0; n < 2; ++n) acc[a][b][m][n] = (f32x4){0.f, 0.f, 0.f, 0.f};
        cur = nxt; cB = nB; ++ui;
#pragma unroll
        for (int h = 0; h < 2; ++h)
#pragma unroll
            for (int i = 0; i < 2; ++i) oc[h][i] = on[h][i];
    }
    PG8_WAIT_V(0);
    if (wr == 0) PG8_BAR;
    PG8_BAR;
#undef PG8_SA
#undef PG8_SB
#undef PG8_STAGE_A
#undef PG8_STAGE_B
#undef PG8_LDA
#undef PG8_LDB
#undef PG8_MMA
#undef PG8_WAIT_V
#undef PG8_WAIT_L
#undef PG8_BAR
#undef PG8_SCHED
}

struct SchedPlain {
    int nM, nN, G, vcu;
    DI bool next(int i, Unit& u) const { const int L = i * G + vcu; if (L >= nM * nN) return false; u.pm = L / nN; u.pn = L % nN; u.aux = 0; u.ix = i; return true; }
    DI void a_off(const Unit& u, const int (&R)[2], const int (&C)[2], int K, unsigned (&o)[2][2]) const {
#pragma unroll
        for (int h = 0; h < 2; ++h)
#pragma unroll
            for (int i = 0; i < 2; ++i) o[h][i] = (unsigned)((u.pm * 256 + h * 128 + R[i]) * K + C[i]) * 2u; }
    DI size_t b_off(const Unit& u, int K) const { return (size_t)u.pn * 256 * K * 2; }
};
struct SchedMoe {
    LAS const int* ut; LAS const unsigned short* rtl; int nN, G, vcu; bool gather;
    static DI void setup(LAS unsigned char* lds, const int* tile, const int* rowtok, const float* bias, int nN, int G, int vcu, int tid, bool rev) {
        LAS int* ut = (LAS int*)(lds + UT_OFF); LAS unsigned short* rtl = (LAS unsigned short*)(lds + RTL_OFF); LAS float* bl = (LAS float*)(lds + BL_OFF);
        __syncthreads();
        const int nmt = tile[1000]; int nu = 0;
        for (int i = 0; i < MAXU; ++i) { const int L = i * G + vcu; if (L < nmt * nN) nu = i + 1; }
        if (tid < MAXU) { const int L = tid * G + vcu; if (L < nmt * nN) { const int pm = rev ? nmt - 1 - L / nN : L / nN; ut[1 + 2 * tid] = pm; ut[2 + 2 * tid] = tile[pm]; } }
        if (tid == 0) ut[0] = nu;
        for (int i = tid >> 8; i < nu; i += 2) { const int L = i * G + vcu, pm = rev ? nmt - 1 - L / nN : L / nN, pn = L % nN, e = tile[pm], c = tid & 255;
            if (rowtok) rtl[i * 256 + c] = (unsigned short)rowtok[pm * 256 + c];
            bl[i * 256 + c] = nN == 8 ? bias[(size_t)e * 2048 + (c >> 7) * 1024 + 128 * pn + (c & 127)] : bias[(size_t)e * 1024 + 256 * pn + c]; }
        __syncthreads();
    }
    DI bool next(int i, Unit& u) const { if (i >= ut[0]) return false; const int L = i * G + vcu; u.pm = ut[1 + 2 * i]; u.pn = L % nN; u.aux = ut[2 + 2 * i]; u.ix = i; return true; }
    DI void a_off(const Unit& u, const int (&R)[2], const int (&C)[2], int K, unsigned (&o)[2][2]) const {
        if (gather) {
            LAS const unsigned short* rp = rtl + u.ix * 256;
            const int t0 = rp[R[0]], t1 = rp[R[1]], t2 = rp[128 + R[0]], t3 = rp[128 + R[1]];
            o[0][0] = (unsigned)(t0 * K + C[0]) * 2u; o[0][1] = (unsigned)(t1 * K + C[1]) * 2u; o[1][0] = (unsigned)(t2 * K + C[0]) * 2u; o[1][1] = (unsigned)(t3 * K + C[1]) * 2u;
        } else {
#pragma unroll
            for (int h = 0; h < 2; ++h)
#pragma unroll
                for (int i = 0; i < 2; ++i) o[h][i] = (unsigned)((u.pm * 256 + h * 128 + R[i]) * K + C[i]) * 2u;
        }
    }
    DI size_t b_off(const Unit& u, int K) const { return (size_t)(u.aux * nN + u.pn) * 256 * K * 2; }
};

struct EpiBf16Plain {
    static constexpr bool PERM = true, FP8 = false; static constexpr int SCALE_W = 0x7f7f7f7f;
    bf16_t* O; int ldc;
    DI void operator()(const f32x4 (&acc)[2][2][4][2], const Unit& u, int wr, int wc, int fr, int fq) const {
        const int row0 = u.pm * BM + wr * 64 + fr, col0 = u.pn * BM + wc * 32 + 8 * fq;
#pragma unroll
        for (int ai = 0; ai < 2; ++ai)
#pragma unroll
            for (int m = 0; m < 4; ++m) { bf16_t* rowp = O + (size_t)(row0 + ai * HALF + m * 16) * ldc + col0;
#pragma unroll
                for (int bj = 0; bj < 2; ++bj) { const f32x4 v0 = acc[ai][bj][m][0], v1 = acc[ai][bj][m][1];
                    u32x4 w; w.x = cvt_pk_bf16(v0[0], v0[1]); w.y = cvt_pk_bf16(v0[2], v0[3]); w.z = cvt_pk_bf16(v1[0], v1[1]); w.w = cvt_pk_bf16(v1[2], v1[3]);
                    *(u32x4*)(rowp + bj * HALF) = w; } }
    }
};
struct EpiGmix {
    static constexpr bool PERM = true, FP8 = false; static constexpr int SCALE_W = 0x7f7f7f7f;
    const float* mod; bf16_t* O;
    DI void operator()(const f32x4 (&acc)[2][2][4][2], const Unit& u, int wr, int wc, int fr, int fq) const {
        const int row0 = u.pm * BM + wr * 64 + fr, col0 = u.pn * BM + wc * 32 + 8 * fq;
        const int b = (u.pm * BM) >> 12;
        f32x4 gt[2][2];
#pragma unroll
        for (int bj = 0; bj < 2; ++bj)
#pragma unroll
            for (int n = 0; n < 2; ++n) gt[bj][n] = *(const f32x4*)(mod + b * 6144 + 2048 + col0 + bj * HALF + 4 * n);
#pragma unroll
        for (int ai = 0; ai < 2; ++ai)
#pragma unroll
            for (int m = 0; m < 4; ++m) { bf16_t* rowp = O + (size_t)(row0 + ai * HALF + m * 16) * D + col0;
#pragma unroll
                for (int bj = 0; bj < 2; ++bj) { const f32x4 v0 = acc[ai][bj][m][0] * gt[bj][0], v1 = acc[ai][bj][m][1] * gt[bj][1];
                    u32x4 w; w.x = cvt_pk_bf16(v0[0], v0[1]); w.y = cvt_pk_bf16(v0[2], v0[3]); w.z = cvt_pk_bf16(v1[0], v1[1]); w.w = cvt_pk_bf16(v1[2], v1[3]);
                    *(u32x4*)(rowp + bj * HALF) = w; } }
    }
};
typedef float f32x2 __attribute__((ext_vector_type(2)));
struct EpiAct {
    static constexpr bool PERM = true, FP8 = true; static constexpr int SCALE_W = 0x7a7a7a7a;
    LAS const float* bl; unsigned char* O;
    DI void operator()(const f32x4 (&acc)[2][2][4][2], const Unit& u, int wr, int wc, int fr, int fq) const {
        const int row0 = u.pm * BM + wr * 64 + fr, cl = wc * 32 + 8 * fq, colj = u.pn * HALF + cl;
        LAS const float* bp = bl + u.ix * 256 + cl;
        f32x4 bgv[2], buv[2];
#pragma unroll
        for (int n = 0; n < 2; ++n) { bgv[n] = *(LAS const f32x4*)(bp + 4 * n); buv[n] = *(LAS const f32x4*)(bp + 128 + 4 * n); }
#pragma unroll
        for (int ai = 0; ai < 2; ++ai)
#pragma unroll
            for (int m = 0; m < 4; ++m) {
                f32x2 o[4];
#pragma unroll
                for (int n = 0; n < 2; ++n) { const f32x4 gv = acc[ai][0][m][n] + bgv[n], uv = acc[ai][1][m][n] + buv[n];
#pragma unroll
                    for (int j = 0; j < 2; ++j) {
                        f32x2 gt, up; gt.x = fminf(gv[2 * j], 7.0f); gt.y = fminf(gv[2 * j + 1], 7.0f); up.x = __builtin_amdgcn_fmed3f(uv[2 * j], -7.0f, 7.0f); up.y = __builtin_amdgcn_fmed3f(uv[2 * j + 1], -7.0f, 7.0f);
                        const f32x2 z = gt * (-1.702f * 1.44269504089f); f32x2 e; e.x = __builtin_amdgcn_exp2f(z.x); e.y = __builtin_amdgcn_exp2f(z.y);
                        const f32x2 d = e + 1.0f; f32x2 r; r.x = __builtin_amdgcn_rcpf(d.x); r.y = __builtin_amdgcn_rcpf(d.y);
                        o[2 * n + j] = (up + 1.0f) * (gt * r); } }
                u32x2 w; w.x = cvt_pk_fp8x4(o[0].x, o[0].y, o[1].x, o[1].y); w.y = cvt_pk_fp8x4(o[2].x, o[2].y, o[3].x, o[3].y);
                *(u32x2*)(O + (size_t)(row0 + ai * HALF + m * 16) * 1024 + colj) = w; }
    }
};
struct EpiDown {
    static constexpr bool PERM = true, FP8 = true; static constexpr int SCALE_W = 0x7a7a7a7a;
    LAS const float* bl; unsigned char* O;
    DI void operator()(const f32x4 (&acc)[2][2][4][2], const Unit& u, int wr, int wc, int fr, int fq) const {
        const int row0 = u.pm * BM + wr * 64 + fr, cl = wc * 32 + 8 * fq, col0 = u.pn * BM + cl;
        LAS const float* bp = bl + u.ix * 256 + cl;
        f32x4 bv[2][2];
#pragma unroll
        for (int bj = 0; bj < 2; ++bj)
#pragma unroll
            for (int n = 0; n < 2; ++n) bv[bj][n] = *(LAS const f32x4*)(bp + bj * HALF + 4 * n);
#pragma unroll
        for (int ai = 0; ai < 2; ++ai)
#pragma unroll
            for (int m = 0; m < 4; ++m) { unsigned char* rowp = O + (size_t)(row0 + ai * HALF + m * 16) * 1024 + col0;
#pragma unroll
                for (int bj = 0; bj < 2; ++bj) { const f32x4 v0 = acc[ai][bj][m][0] + bv[bj][0], v1 = acc[ai][bj][m][1] + bv[bj][1];
                    u32x2 w; w.x = cvt_pk_fp8x4(v0[0], v0[1], v0[2], v0[3]); w.y = cvt_pk_fp8x4(v1[0], v1[1], v1[2], v1[3]);
                    *(u32x2*)(rowp + bj * HALF) = w; } }
    }
};
}

struct Args { const float* in[27]; float* out; unsigned char* ws; int ph_lo, ph_hi; };
struct Frame {
    LAS unsigned char* lds; int tid, lane, wave, G, blk, vcu;
    const float* in[27]; float* out; unsigned char* ws;
};
enum { I_X = 0, I_C, I_CTX, I_CCTX, I_WMOD, I_BMOD, I_GMIX, I_GFFN, I_WIN, I_WF, I_CONVW, I_CONVB, I_RGWA, I_RGBA, I_RGWX, I_RGBX, I_LAM, I_GOF, I_GOR, I_WOUT, I_WR, I_BR, I_WGU, I_BGU, I_WD, I_BD, I_GFIN };

constexpr int IT_TR = 8 + 24 + 1 + 32;

DI void p0_adaln(const Frame& F, int cb) {
    LAS float* sc = (LAS float*)F.lds; LAS float* red = (LAS float*)(F.lds + 36864);
    const float* c = F.in[I_C]; const float* cctx = F.in[I_CCTX]; const float* wmod = F.in[I_WMOD]; const float* bmod = F.in[I_BMOD];
    float* mod = (float*)(F.ws + WS_MOD);
    for (int i = F.tid; i < 9 * 1024; i += 512) { const int r = i >> 10, k = i & 1023; const float v = r < 8 ? c[r * 1024 + k] : cctx[k]; sc[i] = v / (1.0f + __expf(-v)); }
    __syncthreads();
    f32x4 acc[9];
#pragma unroll
    for (int r = 0; r < 9; ++r) acc[r] = (f32x4){0.f, 0.f, 0.f, 0.f};
    const float* wp = wmod + (size_t)(128 * F.wave) * 6144 + cb * 256 + 4 * F.lane;
    for (int kk = 0; kk < 128; kk += 8) {
        f32x4 wv[8];
#pragma unroll
        for (int j = 0; j < 8; ++j) wv[j] = *(const f32x4*)(wp + (size_t)(kk + j) * 6144);
#pragma unroll
        for (int j = 0; j < 8; ++j)
#pragma unroll
            for (int r = 0; r < 9; ++r) { const float s = sc[r * 1024 + 128 * F.wave + kk + j]; acc[r] += s * wv[j]; }
    }
#pragma unroll
    for (int r = 0; r < 9; ++r) *(LAS f32x4*)(red + (F.wave * 9 + r) * 256 + 4 * F.lane) = acc[r];
    __syncthreads();
    for (int i = F.tid; i < 9 * 256; i += 512) { const int r = i >> 8, cc = i & 255; float s = bmod[cb * 256 + cc];
        for (int w = 0; w < 8; ++w) s += red[(w * 9 + r) * 256 + cc];
        mod[r * 6144 + cb * 256 + cc] = s; }
    __syncthreads();
}

DI void p0_wmf(const Frame& F, int it) {
    const int g = it >> 1, rip = it & 1;
    LAS float* tw = (LAS float*)F.lds;
    LAS float* wfs = tw + 128;
    LAS float* Fm = wfs + 128 * 128;
    const float* wf = F.in[I_WF] + (size_t)g * 128 * 128;
    bf16_t* WMF = (bf16_t*)(F.ws + WS_WMF);
    const float norm = 0.0013810679320049757f;
    __syncthreads();
    if (F.tid < 128) { const float rev = (float)F.tid * (1.0f / 128.0f); tw[F.tid] = rip ? __builtin_amdgcn_sinf(rev) : __builtin_amdgcn_cosf(rev); }
    for (int i = F.tid; i < 128 * 128; i += 512) wfs[i] = wf[i];
    __syncthreads();
    { const int jp = F.tid & 127, j0 = F.tid >> 7; float sacc[32];
#pragma unroll
      for (int i = 0; i < 32; ++i) sacc[i] = 0.f;
#pragma unroll 4
      for (int l = 0; l < 128; ++l) { const float w = wfs[l * 128 + jp];
#pragma unroll
          for (int i = 0; i < 32; ++i) sacc[i] += tw[(l * (j0 + 4 * i)) & 127] * w; }
#pragma unroll
      for (int i = 0; i < 32; ++i) Fm[(j0 + 4 * i) * 128 + jp] = sacc[i] * norm; }
    __syncthreads();
    for (int i = 0; i < 4; ++i) { const int idx = F.tid + 512 * i;
        const int ln = idx & 63, nt = (idx >> 6) & 3, sx = (idx >> 8) & 1, jt = idx >> 9; const int hh = ln >> 5, n = ln & 31;
        float v[8];
#pragma unroll
        for (int jj = 0; jj < 8; ++jj) v[jj] = Fm[(32 * jt + 16 * sx + 8 * (jj >> 2) + 4 * hh + (jj & 3)) * 128 + 32 * nt + n];
        u32x4 w; w.x = cvt_pk_bf16(v[0], v[1]); w.y = cvt_pk_bf16(v[2], v[3]); w.z = cvt_pk_bf16(v[4], v[5]); w.w = cvt_pk_bf16(v[6], v[7]);
        *(u32x4*)(WMF + ((size_t)((((g * 2 + rip) * 4 + jt) * 2 + sx) * 4 + nt) * 64 + ln) * 8) = w; }
    __syncthreads();
}
DI void p0_cf(const Frame& F) {
    bf16_t* CF = (bf16_t*)(F.ws + WS_CF);
    for (int i = 0; i < 4; ++i) { const int idx = F.tid + 512 * i; const int ln = idx & 63, ks = (idx >> 6) & 7, rip = (idx >> 9) & 1, pt = idx >> 10; const int hh = ln >> 5, p = 32 * pt + (ln & 31);
        float v[8];
#pragma unroll
        for (int jj = 0; jj < 8; ++jj) { const int k2 = 16 * ks + 8 * hh + jj, ri = k2 >> 6, c = k2 & 63; const float rev = (float)((c * p) & 63) * (1.0f / 64.0f);
            const float cs = __builtin_amdgcn_cosf(rev), sn = __builtin_amdgcn_sinf(rev); v[jj] = rip == 0 ? (ri == 0 ? cs : sn) : (ri == 0 ? -sn : cs); }
        u32x4 w; w.x = cvt_pk_bf16(v[0], v[1]); w.y = cvt_pk_bf16(v[2], v[3]); w.z = cvt_pk_bf16(v[4], v[5]); w.w = cvt_pk_bf16(v[6], v[7]);
        *(u32x4*)(CF + (size_t)idx * 8) = w; }
}
DI void p0_rgw(const Frame& F, int it) {
    const int type = it >> 4, d = (it >> 3) & 1, h = it & 7;
    const float* src = (type ? F.in[I_RGWX] : F.in[I_RGWA]) + (size_t)(d * 8 + h) * 4096;
    bf16_t* dst = (bf16_t*)(F.ws + WS_RGW) + (size_t)((d * 2 + type) * 8 + h) * 4096;
    for (int i = F.tid; i < 4096; i += 512) { const int j = i >> 6, ii = i & 63; dst[i] = f2bf(src[ii * 64 + j]); }
}
DI void p0_tr_fp8(const float* src, int ldn, int k0, int n0, unsigned char* dst, int dbase, bool gu, int lane) {
    const float* sp = src + (size_t)k0 * ldn + n0 + 4 * lane;
    f32x4 v[32];
#pragma unroll
    for (int i = 0; i < 32; ++i) v[i] = *(const f32x4*)(sp + (size_t)i * ldn);
#pragma unroll
    for (int c = 0; c < 4; ++c) { const int n = n0 + 4 * lane + c; const int jn = n & 1023; const int drow = dbase + (gu ? 256 * (jn >> 7) + 128 * (n >> 10) + (jn & 127) : n);
        unsigned char* dp = dst + (size_t)drow * 1024 + k0;
#pragma unroll
        for (int h = 0; h < 2; ++h) { u32x4 w;
            w.x = cvt_pk_fp8x4(32.f * v[16 * h + 0][c], 32.f * v[16 * h + 1][c], 32.f * v[16 * h + 2][c], 32.f * v[16 * h + 3][c]); w.y = cvt_pk_fp8x4(32.f * v[16 * h + 4][c], 32.f * v[16 * h + 5][c], 32.f * v[16 * h + 6][c], 32.f * v[16 * h + 7][c]);
            w.z = cvt_pk_fp8x4(32.f * v[16 * h + 8][c], 32.f * v[16 * h + 9][c], 32.f * v[16 * h + 10][c], 32.f * v[16 * h + 11][c]); w.w = cvt_pk_fp8x4(32.f * v[16 * h + 12][c], 32.f * v[16 * h + 13][c], 32.f * v[16 * h + 14][c], 32.f * v[16 * h + 15][c]);
            *(u32x4*)(dp + h * 16) = w; } }
}
DI void p0_tr_bf16(const float* src, int ldn, int k0, int n0, bf16_t* dst, int lane) {
    const float* sp = src + (size_t)k0 * ldn + n0 + 4 * lane;
    f32x4 v[32];
#pragma unroll
    for (int i = 0; i < 32; ++i) v[i] = *(const f32x4*)(sp + (size_t)i * ldn);
#pragma unroll
    for (int c = 0; c < 4; ++c) { bf16_t* dp = dst + (size_t)(n0 + 4 * lane + c) * 1024 + k0;
#pragma unroll
        for (int h = 0; h < 4; ++h) { u32x4 w; w.x = cvt_pk_bf16(v[8 * h][c], v[8 * h + 1][c]); w.y = cvt_pk_bf16(v[8 * h + 2][c], v[8 * h + 3][c]); w.z = cvt_pk_bf16(v[8 * h + 4][c], v[8 * h + 5][c]); w.w = cvt_pk_bf16(v[8 * h + 6][c], v[8 * h + 7][c]);
            *(u32x4*)(dp + h * 8) = w; } }
}
constexpr int WT_WIN = 6 * 32, WT_WOUT = 4 * 32, WT_WGU = 32 * 8 * 32, WT_WD = 32 * 4 * 32, WT_END = WT_WIN + WT_WOUT + WT_WGU + WT_WD;
constexpr int CW_Q0 = 512, CW_Q1 = 576;
DI void phase0(const Frame& F) {
    unsigned* ctl = (unsigned*)(F.ws + WS_CTL);
    volatile LAS int* bq = (volatile LAS int*)(F.lds + MISC_OFF + 64);
    for (;;) {
        __syncthreads();
        if (F.tid == 0) bq[0] = (int)__hip_atomic_fetch_add(ctl + CW_Q0, 1u, __ATOMIC_RELAXED, __HIP_MEMORY_SCOPE_AGENT);
        __syncthreads();
        const int q = bq[0]; if (q >= IT_TR) break;
        if (q < 8) p0_wmf(F, q);
        else if (q < 32) p0_adaln(F, q - 8);
        else if (q < 33) p0_cf(F);
        else p0_rgw(F, q - 33);
    }
#pragma unroll 1
    for (int rnd = 0;; ++rnd) {
        if ((rnd & 1) == 0) { __syncthreads(); if (F.tid == 0) bq[0] = (int)__hip_atomic_fetch_add(ctl + CW_Q1, 16u, __ATOMIC_RELAXED, __HIP_MEMORY_SCOPE_AGENT); __syncthreads(); }
        const int wi = bq[0] + 8 * (rnd & 1) + F.wave; if (bq[0] >= WT_END) break;
        if (wi >= WT_END) continue;
        int j = wi;
        if (j < WT_WGU) { const int e = j >> 8, kb = (j >> 3) & 31, nb = j & 7;
            p0_tr_fp8(F.in[I_WGU] + (size_t)e * 1024 * 2048, 2048, kb * 32, nb * 256, (unsigned char*)(F.ws + WS_WGU), e * 2048, true, F.lane); }
        else if ((j -= WT_WGU) < WT_WD) { const int e = j >> 7, kb = (j >> 2) & 31, nb = j & 3;
            p0_tr_fp8(F.in[I_WD] + (size_t)e * 1024 * 1024, 1024, kb * 32, nb * 256, (unsigned char*)(F.ws + WS_WDOWN), e * 1024, false, F.lane); }
        else if ((j -= WT_WD) < WT_WIN) { const int kb = j / 6, nb = j % 6; p0_tr_bf16(F.in[I_WIN], 1536, kb * 32, nb * 256, (bf16_t*)(F.ws + WS_WIN), F.lane); }
        else { j -= WT_WIN; const int kb = j >> 2, nb = j & 3; p0_tr_bf16(F.in[I_WOUT], 1024, kb * 32, nb * 256, (bf16_t*)(F.ws + WS_WOUT), F.lane); }
    }
}

template <int NR> DI void norm_rows(const float* xr, const float* g, const float* modb, bf16_t* hrow, int lane) {
    f32x4 v[NR][4]; float ss[NR];
#pragma unroll
    for (int r = 0; r < NR; ++r)
#pragma unroll
        for (int q = 0; q < 4; ++q) v[r][q] = *(const f32x4*)(xr + (size_t)r * D + 4 * lane + 256 * q);
#pragma unroll
    for (int r = 0; r < NR; ++r) { float a = 0.f;
#pragma unroll
        for (int q = 0; q < 4; ++q) a += v[r][q][0] * v[r][q][0] + v[r][q][1] * v[r][q][1] + v[r][q][2] * v[r][q][2] + v[r][q][3] * v[r][q][3];
        ss[r] = rsqrtf(wave_sum(a) * (1.0f / 1024.0f) + EPS); }
#pragma unroll
    for (int q = 0; q < 4; ++q) { const int k = 4 * lane + 256 * q;
        const f32x4 gg = *(const f32x4*)(g + k), sh = *(const f32x4*)(modb + k), sc = *(const f32x4*)(modb + 1024 + k); const f32x4 gm = gg * (1.0f + sc);
#pragma unroll
        for (int r = 0; r < NR; ++r) { const f32x4 y = v[r][q] * ss[r] * gm + sh;
            u32x2 w; w.x = cvt_pk_bf16(y[0], y[1]); w.y = cvt_pk_bf16(y[2], y[3]);
            *(u32x2*)(hrow + (size_t)r * D + k) = w; } }
}
struct SchedOne { int pm, pn; bool used;
    DI bool next(int i, pg8::Unit& u) const { if (i > 0) return false; u.pm = pm; u.pn = pn; u.aux = 0; u.ix = 0; return true; }
    DI void a_off(const pg8::Unit& u, const int (&R)[2], const int (&C)[2], int K, unsigned (&o)[2][2]) const {
#pragma unroll
        for (int h = 0; h < 2; ++h)
#pragma unroll
            for (int i = 0; i < 2; ++i) o[h][i] = (unsigned)((u.pm * 256 + h * 128 + R[i]) * K + C[i]) * 2u; }
    DI size_t b_off(const pg8::Unit& u, int K) const { return (size_t)u.pn * 256 * K * 2; }
};
DI void phase1(const Frame& F) {
    const float* x = F.in[I_X]; const float* ctx = F.in[I_CTX]; const float* g = F.in[I_GMIX]; const float* mod = (const float*)(F.ws + WS_MOD);
    bf16_t* H = (bf16_t*)(F.ws + WS_H);
    if (F.blk < 16 && F.G > 16) {
        const int mt = F.blk >> 1;
#pragma unroll 1
        for (int i = 0; i < 4; ++i) { const int rr = 256 * mt + 32 * F.wave + 8 * i; norm_rows<8>(ctx + (size_t)rr * D, g, mod + 8 * 6144, H + (size_t)(T + rr) * D, F.lane); }
        asm volatile("s_waitcnt vmcnt(0)" ::: "memory"); __syncthreads();
        pg8::Gemm gg{(const bf16_t*)(F.ws + WS_H), (const bf16_t*)(F.ws + WS_WIN), 1024};
        SchedOne S{T / 256 + mt, 2 + (F.blk & 1), true}; pg8::EpiBf16Plain E{(bf16_t*)(F.ws + WS_XP), 1536};
        pg8::gemm_phase(F.lds, gg, S, E);
    } else {
        const int nb = F.G > 16 ? F.G - 16 : F.G, bb = F.G > 16 ? F.blk - 16 : F.blk;
#pragma unroll 1
        for (int it = 0;; ++it) {
            const int row = ((it * nb + bb) * 8 + F.wave) * 4; if (row >= T) break;
            norm_rows<4>(x + (size_t)row * D, g, mod + (row >> 12) * 6144, H + (size_t)row * D, F.lane);
        }
        if (F.G <= 16) {
            for (int row = F.blk * 8 + F.wave; row < TC; row += F.G * 8) norm_rows<1>(ctx + (size_t)row * D, g, mod + 8 * 6144, H + (size_t)(T + row) * D, F.lane);
        }
    }
}

DI int serp_tok(int b, int P) { const int rr = P >> 6, cc = P & 63; return b * SEQ + (rr << 6) + ((rr & 1) ? 63 - cc : cc); }
DI void rg_unit(const Frame& F, int u) {
    LAS unsigned char* xcl = F.lds;
    const bf16_t* XR = (const bf16_t*)(F.ws + WS_XP) + 512; const bf16_t* RGW = (const bf16_t*)(F.ws + WS_RGW);
    const float* convw = F.in[I_CONVW]; const float* convb = F.in[I_CONVB];
    float* sumP = (float*)(F.ws + WS_SUMP); float* sumH = (float*)(F.ws + WS_SUMH);
    bf16_t* SSb = (bf16_t*)(F.ws + WS_SS); bf16_t* CAF = (bf16_t*)(F.ws + WS_CAF); bf16_t* CAB = (bf16_t*)(F.ws + WS_CAB);
    int tid = F.tid; asm volatile("" : "+v"(tid));
    const int lane = tid & 63, hh = F.wave, hf = lane >> 5;
    {
        const bool lat = u < 512; const int b = lat ? (u >> 6) : ((u - 512) >> 2), r = lat ? (u & 63) : ((u - 512) & 3); const int L = lat ? SEQ : CTXL;
        {
            const int cg = tid & 63; float w[4][8], bs[8];
#pragma unroll
            for (int k = 0; k < 4; ++k) { const f32x4 a = *(const f32x4*)(convw + k * 512 + 8 * cg), c2 = *(const f32x4*)(convw + k * 512 + 8 * cg + 4);
                w[k][0] = a[0]; w[k][1] = a[1]; w[k][2] = a[2]; w[k][3] = a[3]; w[k][4] = c2[0]; w[k][5] = c2[1]; w[k][6] = c2[2]; w[k][7] = c2[3]; }
            { const f32x4 a = *(const f32x4*)(convb + 8 * cg), c2 = *(const f32x4*)(convb + 8 * cg + 4); bs[0] = a[0]; bs[1] = a[1]; bs[2] = a[2]; bs[3] = a[3]; bs[4] = c2[0]; bs[5] = c2[1]; bs[6] = c2[2]; bs[7] = c2[3]; }
#pragma unroll
            for (int i = 0; i < 8; ++i) { const int p = (tid >> 6) + 8 * i; float a[8];
#pragma unroll
                for (int j = 0; j < 8; ++j) a[j] = bs[j];
#pragma unroll
                for (int k = 0; k < 4; ++k) { const int P = 64 * r + p + k - 2;
                    if (P >= 0 && P < L) { const int tk = lat ? serp_tok(b, P) : T + b * CTXL + P; const u32x4 xv = *(const u32x4*)(XR + (size_t)tk * 1536 + 8 * cg);
#pragma unroll
                        for (int j = 0; j < 4; ++j) { a[2 * j] += w[k][2 * j] * bflo(xv[j]); a[2 * j + 1] += w[k][2 * j + 1] * bfhi(xv[j]); } } }
                u32x4 o; o.x = cvt_pk_bf16(a[0], a[1]); o.y = cvt_pk_bf16(a[2], a[3]); o.z = cvt_pk_bf16(a[4], a[5]); o.w = cvt_pk_bf16(a[6], a[7]);
                *(LAS u32x4*)(xcl + p * 1040 + cg * 16) = o; }
        }
        __syncthreads();
        const int cidx = lat ? 4 + r : r; const int tokbase = b * SEQ + 64 * r;
#pragma unroll 1
        for (int nt = 0; nt < 2; ++nt) {
            const int chl = 32 * nt + (lane & 31), ch = 64 * hh + chl;
            unsigned hlp[2][8];
#pragma unroll
            for (int d = 0; d < 2; ++d) {
                f32x16 ar[2], ai[2];
#pragma unroll
                for (int t = 0; t < 2; ++t)
#pragma unroll
                    for (int i = 0; i < 16; ++i) { ar[t][i] = 0.f; ai[t][i] = 0.f; }
                const bf16_t* wr_ = RGW + (size_t)(((d * 2 + 0) * 8 + hh) * 64 + chl) * 64; const bf16_t* wi_ = RGW + (size_t)(((d * 2 + 1) * 8 + hh) * 64 + chl) * 64;
#pragma unroll
                for (int ks = 0; ks < 4; ++ks) {
                    const bf16x8 br = *(const bf16x8*)(wr_ + 16 * ks + 8 * hf), bi = *(const bf16x8*)(wi_ + 16 * ks + 8 * hf);
#pragma unroll
                    for (int t = 0; t < 2; ++t) { const int m = lane & 31; const int pos = 32 * ((m >> 2) & 1) + 16 * t + 4 * (m >> 3) + (m & 3);
                        const bf16x8 a = *(const LAS bf16x8*)(xcl + pos * 1040 + (64 * hh + 16 * ks + 8 * hf) * 2);
                        ar[t] = __builtin_amdgcn_mfma_f32_32x32x16_bf16(a, br, ar[t], 0, 0, 0); ai[t] = __builtin_amdgcn_mfma_f32_32x32x16_bf16(a, bi, ai[t], 0, 0, 0); }
                }
                const float ba = F.in[I_RGBA][d * 512 + ch], bx = F.in[I_RGBX][d * 512 + ch], lam = F.in[I_LAM][d * 512 + ch];
                const float nl = -lam; const float sp8 = 8.0f * (fmaxf(nl, 0.f) + log1pf(expf(-fabsf(nl))));
#pragma unroll
                for (int t = 0; t < 2; ++t)
#pragma unroll
                    for (int i = 0; i < 16; ++i) { const int p = 32 * hf + 16 * t + i;
                        const float rr = sigmoidf_(ar[t][i] + ba), ii = sigmoidf_(ai[t][i] + bx); const float a = __expf(-sp8 * rr);
                        const float xcv = bf2f(*(const LAS bf16_t*)(xcl + p * 1040 + ch * 2));
                        ar[t][i] = a; ai[t][i] = __builtin_amdgcn_sqrtf(fmaxf(1.0f - a * a, 0.f)) * ii * xcv; }
                float hl = 0.f, ca = 1.f;
                if (d == 0) {
#pragma unroll
                    for (int t = 0; t < 2; ++t)
#pragma unroll
                        for (int i = 0; i < 16; ++i) { const float a = ar[t][i]; hl = a * hl + ai[t][i]; ca *= a; ai[t][i] = hl; ar[t][i] = ca; }
                    const float P0 = __shfl(ca, lane & 31), H0 = __shfl(hl, lane & 31);
                    if (hf == 1) {
#pragma unroll
                        for (int t = 0; t < 2; ++t)
#pragma unroll
                            for (int i = 0; i < 16; ++i) { ai[t][i] += ar[t][i] * H0; ar[t][i] *= P0; }
                        sumP[(size_t)((b * 2 + 0) * NCH + cidx) * 512 + ch] = ar[1][15]; sumH[(size_t)((b * 2 + 0) * NCH + cidx) * 512 + ch] = ai[1][15];
                    }
#pragma unroll
                    for (int t = 0; t < 2; ++t)
#pragma unroll
                        for (int i = 0; i < 8; ++i) hlp[t][i] = cvt_pk_bf16(ai[t][2 * i], ai[t][2 * i + 1]);
                    if (lat) {
                        const int p0 = 32 * hf; bf16_t* pc = CAF + (size_t)(tokbase + ((r & 1) ? 63 - p0 : p0)) * 512 + ch; const long stride = (r & 1) ? -512 : 512;
#pragma unroll
                        for (int t = 0; t < 2; ++t)
#pragma unroll
                            for (int i = 0; i < 16; ++i) { *pc = f2bf(ar[t][i]); pc += stride; asm volatile("" : "+v"(pc)); }
                    }
                } else {
#pragma unroll
                    for (int t = 1; t >= 0; --t)
#pragma unroll
                        for (int i = 15; i >= 0; --i) { const float a = ar[t][i]; hl = a * hl + ai[t][i]; ca *= a; ai[t][i] = hl; ar[t][i] = ca; }
                    const float P1 = __shfl(ca, (lane & 31) + 32), H1 = __shfl(hl, (lane & 31) + 32);
                    if (hf == 0) {
#pragma unroll
                        for (int t = 0; t < 2; ++t)
#pragma unroll
                            for (int i = 0; i < 16; ++i) { ai[t][i] += ar[t][i] * H1; ar[t][i] *= P1; }
                        sumP[(size_t)((b * 2 + 1) * NCH + cidx) * 512 + ch] = ar[0][0]; sumH[(size_t)((b * 2 + 1) * NCH + cidx) * 512 + ch] = ai[0][0];
                    }
                    if (lat) {
                        const int p0 = 32 * hf; const size_t o0 = (size_t)(tokbase + ((r & 1) ? 63 - p0 : p0)) * 512 + ch; bf16_t* pc = CAB + o0; bf16_t* ps = SSb + o0; const long stride = (r & 1) ? -512 : 512;
#pragma unroll
                        for (int t = 0; t < 2; ++t)
#pragma unroll
                            for (int i = 0; i < 16; ++i) { *pc = f2bf(ar[t][i]); *ps = f2bf(((i & 1) ? bfhi(hlp[t][i >> 1]) : bflo(hlp[t][i >> 1])) + ai[t][i]); pc += stride; ps += stride; asm volatile("" : "+v"(pc), "+v"(ps)); }
                    }
                }
            }
        }
        __syncthreads();
    }
}

typedef short s16x4 __attribute__((ext_vector_type(4)));
DI unsigned pk_bf16c(float a, float b) { typedef float f2_ __attribute__((ext_vector_type(2))); typedef __bf16 b2_ __attribute__((ext_vector_type(2))); const b2_ r = __builtin_convertvector((f2_){a, b}, b2_); return __builtin_bit_cast(unsigned, r); }
DI unsigned img_off(int row, int ch) { return 256u * row + 16u * (ch ^ (((row & 3) << 2) | ((row >> 2) & 3))); }
DI unsigned tr_addr(int lane, int cc, int t) { const int h = lane >> 5, blk = (lane >> 4) & 1, q4 = (lane & 15) >> 2, p = lane & 3; return img_off(8 * h + 4 * t + q4, 4 * cc + 2 * blk + (p >> 1)) + 8u * (p & 1); }

constexpr int FFTA_OFF = 81920;
DI void fftR_table(const Frame& F) {
#pragma unroll 1
    for (int i = 0; i < 2; ++i) { const int idx = F.tid + 512 * i; const int ln = idx & 63, ks = (idx >> 6) & 3, mt = idx >> 8; const int h = ln >> 5, m = ln & 31;
        float v[8];
#pragma unroll
        for (int jj = 0; jj < 8; ++jj) { const int r = 16 * ks + 8 * h + jj, q = 32 * (mt & 1) + m; const float rev = (float)((r * q) & 63) * (1.0f / 64.0f); v[jj] = mt < 2 ? __builtin_amdgcn_cosf(rev) : -__builtin_amdgcn_sinf(rev); }
        u32x4 w; w.x = pk_bf16c(v[0], v[1]); w.y = pk_bf16c(v[2], v[3]); w.z = pk_bf16c(v[4], v[5]); w.w = pk_bf16c(v[6], v[7]);
        *(LAS u32x4*)(F.lds + FFTA_OFF + idx * 16) = w; }
}
DI void fftR_unit(const Frame& F, int u) {
    int lane = F.lane; asm volatile("" : "+v"(lane));
    const int h = lane >> 5, m = lane & 31;
    const bf16_t* XP = (const bf16_t*)(F.ws + WS_XP); bf16_t* ZG = (bf16_t*)(F.ws + WS_ZG);
    const unsigned ldsb = (unsigned)(__SIZE_TYPE__)F.lds;
    {
        const int b = u >> 6, c = u & 63;
        __syncthreads();
#pragma unroll
        for (int i = 0; i < 8; ++i) { const int idx = F.tid + 512 * i; const int r = idx >> 6, ch8 = idx & 63;
            const u32x4 v = *(const u32x4*)(XP + (size_t)(b * SEQ + 64 * r + c) * 1536 + 8 * ch8);
            *(LAS u32x4*)(F.lds + (ch8 >> 4) * 16384 + img_off(r, ch8 & 15)) = v; }
        __syncthreads();
#pragma unroll 1
        for (int nn = 0; nn < 2; ++nn) {
            const int nt = F.wave * 2 + nn, slab = nt >> 2, cc = nt & 3;
            const unsigned a0 = ldsb + slab * 16384 + tr_addr(lane, cc, 0), a1 = ldsb + slab * 16384 + tr_addr(lane, cc, 1);
            s16x4 lo[4], hi[4];
            asm volatile("ds_read_b64_tr_b16 %0, %8\n\tds_read_b64_tr_b16 %1, %9\n\tds_read_b64_tr_b16 %2, %8 offset:4096\n\tds_read_b64_tr_b16 %3, %9 offset:4096\n\t"
                         "ds_read_b64_tr_b16 %4, %8 offset:8192\n\tds_read_b64_tr_b16 %5, %9 offset:8192\n\tds_read_b64_tr_b16 %6, %8 offset:12288\n\tds_read_b64_tr_b16 %7, %9 offset:12288\n\ts_waitcnt lgkmcnt(0)"
                         : "=&v"(lo[0]), "=&v"(hi[0]), "=&v"(lo[1]), "=&v"(hi[1]), "=&v"(lo[2]), "=&v"(hi[2]), "=&v"(lo[3]), "=&v"(hi[3]) : "v"(a0), "v"(a1) : "memory");
            f32x16 acc[4];
#pragma unroll
            for (int mt = 0; mt < 4; ++mt)
#pragma unroll
                for (int i = 0; i < 16; ++i) acc[mt][i] = 0.f;
#pragma unroll
            for (int ks = 0; ks < 4; ++ks) { const bf16x8 Bf = __builtin_shufflevector(lo[ks], hi[ks], 0, 1, 2, 3, 4, 5, 6, 7);
#pragma unroll
                for (int mt = 0; mt < 4; ++mt) { const bf16x8 Af = *(const LAS bf16x8*)(F.lds + FFTA_OFF + ((mt * 4 + ks) * 64 + lane) * 16); acc[mt] = __builtin_amdgcn_mfma_f32_32x32x16_bf16(Af, Bf, acc[mt], 0, 0, 0); } }
            const int ch = 32 * nt + m;
#pragma unroll
            for (int qh = 0; qh < 2; ++qh) {
                bf16_t* pz = ZG + ((size_t)((b * 64 + 32 * qh + 4 * h) * 2) * 64 + c) * 512 + ch;
#pragma unroll
                for (int i = 0; i < 16; ++i) { const int q = 32 * qh + (i & 3) + 8 * (i >> 2) + 4 * h;
                    const float rev = (float)((c * q) & 4095) * (1.0f / 4096.0f); const float cw = __builtin_amdgcn_cosf(rev), sw = __builtin_amdgcn_sinf(rev);
                    const float yr = acc[qh][i], yi = acc[2 + qh][i];
                    pz[0] = (bf16_t)(pk_bf16c(yr * cw + yi * sw, 0.f) & 0xffffu); pz[64 * 512] = (bf16_t)(pk_bf16c(yi * cw - yr * sw, 0.f) & 0xffffu);
                    pz += ((i & 3) == 3 ? 5 : 1) * (2 * 64 * 512); asm volatile("" : "+v"(pz)); }
            }
        }
    }
}
constexpr int CW_Q3 = 640;
DI void phase3(const Frame& F) {
    unsigned* ctl = (unsigned*)(F.ws + WS_CTL);
    volatile LAS int* bq = (volatile LAS int*)(F.lds + MISC_OFF + 64);
    fftR_table(F);
    int cur = F.blk;
    while (cur < 544 + 512) {
        int nxt = 0; if (F.tid == 0) nxt = F.G + (int)__hip_atomic_fetch_add(ctl + CW_Q3, 1u, __ATOMIC_RELAXED, __HIP_MEMORY_SCOPE_AGENT);
        if (cur < 544) rg_unit(F, cur); else fftR_unit(F, cur - 544);
        __syncthreads(); if (F.tid == 0) bq[0] = nxt; __syncthreads(); cur = bq[0];
    }
    __syncthreads();
}

constexpr int FRED_OFF = 131072;
DI void fftC_unit(const Frame& F, int u) {
    int lane = F.lane; asm volatile("" : "+v"(lane));
    const int h = lane >> 5, m = lane & 31, g = F.wave >> 1, pt = F.wave & 1;
    const unsigned ldsb = (unsigned)(__SIZE_TYPE__)F.lds + g * 32768;
    unsigned ta[4][2];
#pragma unroll
    for (int jt = 0; jt < 4; ++jt) { ta[jt][0] = ldsb + tr_addr(lane, jt, 0); ta[jt][1] = ldsb + tr_addr(lane, jt, 1); }
    const bf16_t* ZG = (const bf16_t*)(F.ws + WS_ZG); const bf16_t* CF = (const bf16_t*)(F.ws + WS_CF); const bf16_t* WMF = (const bf16_t*)(F.ws + WS_WMF); bf16_t* CAT = (bf16_t*)(F.ws + WS_CAT);
    LAS float* fred = (LAS float*)(F.lds + FRED_OFF);
    {
        const int b = u >> 6, q = u & 63;
        __syncthreads();
        const bf16_t* zsrc = ZG + (size_t)(b * 64 + q) * 2 * 64 * 512;
#pragma unroll
        for (int i = 0; i < 16; ++i) { const int idx = F.tid + 512 * i; const int k2 = idx >> 6, ch8 = idx & 63;
            const u32x4 v = *(const u32x4*)(zsrc + (size_t)k2 * 512 + 8 * ch8);
            *(LAS u32x4*)(F.lds + (ch8 >> 4) * 32768 + img_off(k2, ch8 & 15)) = v; }
        __syncthreads();
        f32x16 out[4];
#pragma unroll
        for (int n = 0; n < 4; ++n)
#pragma unroll
            for (int i = 0; i < 16; ++i) out[n][i] = 0.f;
#pragma unroll 1
        for (int rj = 0; rj < 4; ++rj) {
            const int rip = rj >> 1, jp = rj & 1;
            f32x16 xt[2];
#pragma unroll
            for (int jt = 0; jt < 2; ++jt)
#pragma unroll
                for (int i = 0; i < 16; ++i) xt[jt][i] = 0.f;
            const unsigned t00 = ta[0][0], t01 = ta[0][1], t10 = ta[1][0], t11 = ta[1][1], t20 = ta[2][0], t21 = ta[2][1], t30 = ta[3][0], t31 = ta[3][1];
            const unsigned a0 = jp ? t20 : t00, a1 = jp ? t21 : t01, a2 = jp ? t30 : t10, a3 = jp ? t31 : t11;
#pragma unroll 2
            for (int ks = 0; ks < 8; ++ks) {
                const bf16x8 Bc = *(const bf16x8*)(CF + ((size_t)((pt * 2 + rip) * 8 + ks) * 64 + lane) * 8);
                s16x4 lo[2], hi[2]; const unsigned ko = 4096u * ks;
                asm volatile("ds_read_b64_tr_b16 %0, %4\n\tds_read_b64_tr_b16 %1, %5\n\tds_read_b64_tr_b16 %2, %6\n\tds_read_b64_tr_b16 %3, %7\n\ts_waitcnt lgkmcnt(0)"
                             : "=&v"(lo[0]), "=&v"(hi[0]), "=&v"(lo[1]), "=&v"(hi[1]) : "v"(a0 + ko), "v"(a1 + ko), "v"(a2 + ko), "v"(a3 + ko) : "memory");
#pragma unroll
                for (int jt = 0; jt < 2; ++jt) { const bf16x8 Af = __builtin_shufflevector(lo[jt], hi[jt], 0, 1, 2, 3, 4, 5, 6, 7); xt[jt] = __builtin_amdgcn_mfma_f32_32x32x16_bf16(Af, Bc, xt[jt], 0, 0, 0); }
            }
#pragma unroll
            for (int jt = 0; jt < 2; ++jt)
#pragma unroll
                for (int sx = 0; sx < 2; ++sx) {
                    u32x4 w; w.x = pk_bf16c(xt[jt][8 * sx + 0], xt[jt][8 * sx + 1]); w.y = pk_bf16c(xt[jt][8 * sx + 2], xt[jt][8 * sx + 3]); w.z = pk_bf16c(xt[jt][8 * sx + 4], xt[jt][8 * sx + 5]); w.w = pk_bf16c(xt[jt][8 * sx + 6], xt[jt][8 * sx + 7]);
                    const bf16x8 Af = __builtin_bit_cast(bf16x8, w);
                    const bf16_t* wp = WMF + ((size_t)((((g * 2 + rip) * 4 + 2 * jp + jt) * 2 + sx) * 4) * 64 + lane) * 8;
#pragma unroll
                    for (int n = 0; n < 4; ++n) { const bf16x8 Bw = *(const bf16x8*)(wp + (size_t)n * 64 * 8); out[n] = __builtin_amdgcn_mfma_f32_32x32x16_bf16(Af, Bw, out[n], 0, 0, 0); }
                    asm volatile("" ::: "memory");
                }
        }
#pragma unroll
        for (int i = 0; i < 16; ++i) { float a = out[0][i] * out[0][i] + out[1][i] * out[1][i] + out[2][i] * out[2][i] + out[3][i] * out[3][i];
            a += __shfl_xor(a, 1); a += __shfl_xor(a, 2); a += __shfl_xor(a, 4); a += __shfl_xor(a, 8); a += __shfl_xor(a, 16);
            if (m == 0) fred[g * 64 + 32 * pt + (i & 3) + 8 * (i >> 2) + 4 * h] = a;
            asm volatile("" ::: "memory"); }
        __syncthreads();
        float gsc[4];
#pragma unroll
        for (int n = 0; n < 4; ++n) gsc[n] = F.in[I_GOF][128 * g + 32 * n + m];
        bf16_t* pf = CAT + ((size_t)(b * SEQ + 64 * (32 * pt + 4 * h) + q)) * 1024 + 128 * g + m;
#pragma unroll
        for (int i = 0; i < 16; ++i) { const int p = 32 * pt + (i & 3) + 8 * (i >> 2) + 4 * h;
            const float tot = (fred[p] + fred[64 + p]) + (fred[128 + p] + fred[192 + p]); const float rs = rsqrtf(tot * (1.0f / 512.0f) + EPS);
#pragma unroll
            for (int n = 0; n < 4; ++n) pf[32 * n] = (bf16_t)(pk_bf16c(out[n][i] * rs * gsc[n], 0.f) & 0xffffu);
            pf += ((i & 3) == 3 ? 5 : 1) * (64 * 1024); asm volatile("" : "+v"(pf) :: "memory"); }
    }
}

DI void catrg_unit(const Frame& F, int u) {
    LAS float* cinf = (LAS float*)F.lds; LAS float* cinb = cinf + 512;
    const float* sumP = (const float*)(F.ws + WS_SUMP); const float* sumH = (const float*)(F.ws + WS_SUMH);
    const bf16_t* SSb = (const bf16_t*)(F.ws + WS_SS); const bf16_t* CAF = (const bf16_t*)(F.ws + WS_CAF); const bf16_t* CAB = (const bf16_t*)(F.ws + WS_CAB);
    const bf16_t* GR = (const bf16_t*)(F.ws + WS_XP) + 1024; bf16_t* CAT = (bf16_t*)(F.ws + WS_CAT);
    const float* gor = F.in[I_GOR];
    {
        const int b = u >> 6, r = u & 63;
        __syncthreads();
        { const int t = F.tid; float hfw = 0.f, hbw = 0.f;
          const float* pf = sumP + (size_t)((b * 2 + 0) * NCH) * 512 + t; const float* qf = sumH + (size_t)((b * 2 + 0) * NCH) * 512 + t;
#pragma unroll 8
          for (int c = 0; c < 4 + r; ++c) hfw = pf[c * 512] * hfw + qf[c * 512];
          const float* pb = sumP + (size_t)((b * 2 + 1) * NCH) * 512 + t; const float* qb = sumH + (size_t)((b * 2 + 1) * NCH) * 512 + t;
          for (int c = 3; c >= 0; --c) hbw = pb[c * 512] * hbw + qb[c * 512];
#pragma unroll 8
          for (int c = NCH - 1; c > 4 + r; --c) hbw = pb[c * 512] * hbw + qb[c * 512];
          cinf[t] = hfw; cinb[t] = hbw; }
        __syncthreads();
        float cf[8], cb[8], gr_[8];
#pragma unroll
        for (int j = 0; j < 8; ++j) { cf[j] = cinf[8 * F.lane + j]; cb[j] = cinb[8 * F.lane + j]; gr_[j] = gor[8 * F.lane + j]; }
#pragma unroll 2
        for (int i = 0; i < 8; ++i) {
            const int tk = b * SEQ + 64 * r + F.wave * 8 + i;
            const u32x4 s4 = *(const u32x4*)(SSb + (size_t)tk * 512 + 8 * F.lane), a4 = *(const u32x4*)(CAF + (size_t)tk * 512 + 8 * F.lane), b4 = *(const u32x4*)(CAB + (size_t)tk * 512 + 8 * F.lane);
            const u32x4 g4 = *(const u32x4*)(GR + (size_t)tk * 1536 + 8 * F.lane);
            float rg[8]; float sr = 0.f;
#pragma unroll
            for (int j = 0; j < 4; ++j) {
                const float y0 = bflo(s4[j]) + bflo(a4[j]) * cf[2 * j] + bflo(b4[j]) * cb[2 * j], y1 = bfhi(s4[j]) + bfhi(a4[j]) * cf[2 * j + 1] + bfhi(b4[j]) * cb[2 * j + 1];
                rg[2 * j] = y0 * gelu_tanh(bflo(g4[j])); rg[2 * j + 1] = y1 * gelu_tanh(bfhi(g4[j]));
                sr += rg[2 * j] * rg[2 * j] + rg[2 * j + 1] * rg[2 * j + 1]; }
            sr = wave_sum(sr);
            const float rr = rsqrtf(sr * (1.0f / 512.0f) + EPS);
            u32x4 orr;
            orr.x = cvt_pk_bf16(rg[0] * rr * gr_[0], rg[1] * rr * gr_[1]); orr.y = cvt_pk_bf16(rg[2] * rr * gr_[2], rg[3] * rr * gr_[3]); orr.z = cvt_pk_bf16(rg[4] * rr * gr_[4], rg[5] * rr * gr_[5]); orr.w = cvt_pk_bf16(rg[6] * rr * gr_[6], rg[7] * rr * gr_[7]);
            *(u32x4*)(CAT + (size_t)tk * 1024 + 512 + 8 * F.lane) = orr;
        }
    }
}
constexpr int CW_Q4 = 768;
DI void phase4(const Frame& F) {
    unsigned* ctl = (unsigned*)(F.ws + WS_CTL);
    volatile LAS int* bq = (volatile LAS int*)(F.lds + MISC_OFF + 64);
    int cur = F.blk;
    while (cur < 1024) {
        int nxt = 0; if (F.tid == 0) nxt = F.G + (int)__hip_atomic_fetch_add(ctl + CW_Q4, 1u, __ATOMIC_RELAXED, __HIP_MEMORY_SCOPE_AGENT);
        if (cur < 512) fftC_unit(F, cur); else catrg_unit(F, cur - 512);
        __syncthreads(); if (F.tid == 0) bq[0] = nxt; __syncthreads(); cur = bq[0];
    }
    __syncthreads();
}

DI void phase_router(const Frame& F) {
    LAS unsigned char* WTh = F.lds; LAS unsigned char* WTl = F.lds + 65536;
    LAS float* cbl = (LAS float*)(F.lds + 131072);
    LAS int* wcnt = (LAS int*)(F.lds + MISC_OFF + 1024);
    const float* wrt = F.in[I_WR]; const float* brt = F.in[I_BR]; const float* g = F.in[I_GFFN]; const float* mod = (const float*)(F.ws + WS_MOD);
    const float* X = F.in[I_X]; const bf16_t* GM = (const bf16_t*)(F.ws + WS_GMIX); unsigned char* H8 = (unsigned char*)(F.ws + WS_H); bf16_t* X1B = (bf16_t*)(F.ws + WS_CAT);
    int* toke = (int*)(F.ws + WS_TOKE); float* tokg = (float*)(F.ws + WS_TOKG); int* cnt = (int*)(F.ws + WS_CNT);
    if (F.tid < 256) wcnt[F.tid] = 0;
    int bcur = -1;
    for (int it = 0;; ++it) {
        const int row0 = (it * F.G + F.blk) * 128; if (row0 >= T) break;
        const int b = row0 >> 12;
        const float* shp = mod + b * 6144 + 3072; const float* scp = mod + b * 6144 + 4096;
        if (b != bcur) {
            bcur = b; __syncthreads();
#pragma unroll 1
            for (int i0 = 0; i0 < 64; i0 += 16) {
                float wv[16], gv[16];
#pragma unroll
                for (int i = 0; i < 16; ++i) { const int idx = F.tid + 512 * (i0 + i); const int k = idx >> 5; wv[i] = wrt[idx]; gv[i] = g[k] * (1.0f + scp[k]); }
#pragma unroll
                for (int i = 0; i < 16; ++i) { const int idx = F.tid + 512 * (i0 + i); const int e = idx & 31, k = idx >> 5;
                    const float v = gv[i] * wv[i]; const unsigned hi = cvt_pk_bf16(v, 0.f) & 0xffffu; const float lo = v - __uint_as_float(hi << 16);
                    const int kk = k & 31, chn = 4 * (k >> 5) + ((kk & 15) >> 2), jj = (kk & 3) + 4 * (kk >> 4);
                    const int off = e * 2048 + ((chn ^ (e & 15)) << 4) + jj * 2;
                    *(LAS bf16_t*)(WTh + off) = (bf16_t)hi; *(LAS bf16_t*)(WTl + off) = f2bf(lo); }
            }
            { float sacc[4] = {0.f, 0.f, 0.f, 0.f};
#pragma unroll
              for (int i = 0; i < 16; ++i) { const int k = F.lane + 64 * i; const float sv = shp[k]; const f32x4 w4 = *(const f32x4*)(wrt + k * 32 + 4 * F.wave);
                  sacc[0] += sv * w4[0]; sacc[1] += sv * w4[1]; sacc[2] += sv * w4[2]; sacc[3] += sv * w4[3]; }
#pragma unroll
              for (int q = 0; q < 4; ++q) { const float tsum = wave_sum(sacc[q]); if (F.lane == 0) cbl[4 * F.wave + q] = tsum + brt[4 * F.wave + q]; } }
            __syncthreads();
        }
        const int tl = F.lane & 15, kg = F.lane >> 4; const int tok = row0 + 16 * F.wave + tl;
        f32x4 acc0 = (f32x4){0.f, 0.f, 0.f, 0.f}, acc1 = acc0; float ssq = 0.f;
        const float* xp = X + (size_t)tok * D + 4 * kg; const bf16_t* gp = GM + (size_t)tok * D + 4 * kg;
#pragma unroll 8
        for (int ks = 0; ks < 32; ++ks) {
            f32x4 xa = *(const f32x4*)(xp + 32 * ks), xb = *(const f32x4*)(xp + 32 * ks + 16);
            const u32x2 ga = *(const u32x2*)(gp + 32 * ks), gb = *(const u32x2*)(gp + 32 * ks + 16);
            xa[0] += bflo(ga.x); xa[1] += bfhi(ga.x); xa[2] += bflo(ga.y); xa[3] += bfhi(ga.y); xb[0] += bflo(gb.x); xb[1] += bfhi(gb.x); xb[2] += bflo(gb.y); xb[3] += bfhi(gb.y);
            ssq += xa[0] * xa[0] + xa[1] * xa[1] + xa[2] * xa[2] + xa[3] * xa[3] + xb[0] * xb[0] + xb[1] * xb[1] + xb[2] * xb[2] + xb[3] * xb[3];
            u32x4 hv, lv;
            hv.x = cvt_pk_bf16(xa[0], xa[1]); hv.y = cvt_pk_bf16(xa[2], xa[3]); hv.z = cvt_pk_bf16(xb[0], xb[1]); hv.w = cvt_pk_bf16(xb[2], xb[3]);
            lv.x = cvt_pk_bf16(xa[0] - bflo(hv.x), xa[1] - bfhi(hv.x)); lv.y = cvt_pk_bf16(xa[2] - bflo(hv.y), xa[3] - bfhi(hv.y));
            lv.z = cvt_pk_bf16(xb[0] - bflo(hv.z), xb[1] - bfhi(hv.z)); lv.w = cvt_pk_bf16(xb[2] - bflo(hv.w), xb[3] - bfhi(hv.w));
            { bf16_t* xo_ = X1B + (size_t)tok * D + 4 * kg + 32 * ks; u32x2 s0_, s1_; s0_.x = hv.x; s0_.y = hv.y; s1_.x = hv.z; s1_.y = hv.w; *(u32x2*)xo_ = s0_; *(u32x2*)(xo_ + 16) = s1_; }
            const bf16x8 Bh = __builtin_bit_cast(bf16x8, hv), Bl = __builtin_bit_cast(bf16x8, lv);
            const int ch = ((4 * ks + kg) ^ tl) << 4;
            const bf16x8 A0h = *(const LAS bf16x8*)(WTh + tl * 2048 + ch), A0l = *(const LAS bf16x8*)(WTl + tl * 2048 + ch);
            const bf16x8 A1h = *(const LAS bf16x8*)(WTh + (16 + tl) * 2048 + ch), A1l = *(const LAS bf16x8*)(WTl + (16 + tl) * 2048 + ch);
            acc0 = __builtin_amdgcn_mfma_f32_16x16x32_bf16(A0h, Bh, acc0, 0, 0, 0); acc0 = __builtin_amdgcn_mfma_f32_16x16x32_bf16(A0h, Bl, acc0, 0, 0, 0); acc0 = __builtin_amdgcn_mfma_f32_16x16x32_bf16(A0l, Bh, acc0, 0, 0, 0);
            acc1 = __builtin_amdgcn_mfma_f32_16x16x32_bf16(A1h, Bh, acc1, 0, 0, 0); acc1 = __builtin_amdgcn_mfma_f32_16x16x32_bf16(A1h, Bl, acc1, 0, 0, 0); acc1 = __builtin_amdgcn_mfma_f32_16x16x32_bf16(A1l, Bh, acc1, 0, 0, 0);
        }
        ssq += __shfl_xor(ssq, 16); ssq += __shfl_xor(ssq, 32);
        const float rstd = rsqrtf(ssq * (1.0f / 1024.0f) + EPS);
        float lg[8];
#pragma unroll
        for (int i = 0; i < 4; ++i) { lg[i] = rstd * acc0[i] + cbl[4 * kg + i]; lg[4 + i] = rstd * acc1[i] + cbl[16 + 4 * kg + i]; }
        int sel[4]; float val[4];
#pragma unroll
        for (int p = 0; p < 4; ++p) {
            float bv = lg[0]; int bi = 4 * kg;
#pragma unroll
            for (int i = 1; i < 8; ++i) { const int ei = (i < 4 ? 0 : 12) + 4 * kg + i; if (lg[i] > bv) { bv = lg[i]; bi = ei; } }
#pragma unroll
            for (int o = 16; o <= 32; o <<= 1) { const float ov = __shfl_xor(bv, o); const int oi = __shfl_xor(bi, o); if (ov > bv || (ov == bv && oi < bi)) { bv = ov; bi = oi; } }
            sel[p] = bi; val[p] = bv;
#pragma unroll
            for (int i = 0; i < 8; ++i) { const int ei = (i < 4 ? 0 : 12) + 4 * kg + i; if (ei == bi) lg[i] = -3.0e38f; }
        }
        const float e1 = __expf(val[1] - val[0]), e2 = __expf(val[2] - val[0]), e3 = __expf(val[3] - val[0]); const float inv = 1.0f / (1.0f + e1 + e2 + e3);
        if (kg == 0) {
            *(i32x4*)(toke + (size_t)tok * 4) = (i32x4){sel[0], sel[1], sel[2], sel[3]}; *(f32x4*)(tokg + (size_t)tok * 4) = (f32x4){inv, e1 * inv, e2 * inv, e3 * inv};
#pragma unroll
            for (int p = 0; p < 4; ++p) __hip_atomic_fetch_add(wcnt + F.wave * 32 + sel[p], 1, __ATOMIC_RELAXED, __HIP_MEMORY_SCOPE_WORKGROUP);
        }
        asm volatile("s_waitcnt vmcnt(0)" ::: "memory");
        float gm[16], sh[16];
#pragma unroll
        for (int q = 0; q < 4; ++q) { const f32x4 gg = *(const f32x4*)(g + 16 * F.lane + 4 * q), sc = *(const f32x4*)(scp + 16 * F.lane + 4 * q), s4 = *(const f32x4*)(shp + 16 * F.lane + 4 * q);
#pragma unroll
            for (int jx = 0; jx < 4; ++jx) { gm[4 * q + jx] = gg[jx] * (1.0f + sc[jx]); sh[4 * q + jx] = s4[jx]; } }
#pragma unroll 4
        for (int t = 0; t < 16; ++t) {
            const float rs = __shfl(rstd, t); const size_t ro = (size_t)(row0 + 16 * F.wave + t) * D + 16 * F.lane;
            f32x4 xv[4];
            { const u32x4 g0 = *(const u32x4*)(X1B + ro), g1 = *(const u32x4*)(X1B + ro + 8);
              xv[0][0] = bflo(g0.x); xv[0][1] = bfhi(g0.x); xv[0][2] = bflo(g0.y); xv[0][3] = bfhi(g0.y); xv[1][0] = bflo(g0.z); xv[1][1] = bfhi(g0.z); xv[1][2] = bflo(g0.w); xv[1][3] = bfhi(g0.w);
              xv[2][0] = bflo(g1.x); xv[2][1] = bfhi(g1.x); xv[2][2] = bflo(g1.y); xv[2][3] = bfhi(g1.y); xv[3][0] = bflo(g1.z); xv[3][1] = bfhi(g1.z); xv[3][2] = bflo(g1.w); xv[3][3] = bfhi(g1.w); }
            u32x4 w;
            w.x = cvt_pk_fp8x4(xv[0][0] * rs * gm[0] + sh[0], xv[0][1] * rs * gm[1] + sh[1], xv[0][2] * rs * gm[2] + sh[2], xv[0][3] * rs * gm[3] + sh[3]);
            w.y = cvt_pk_fp8x4(xv[1][0] * rs * gm[4] + sh[4], xv[1][1] * rs * gm[5] + sh[5], xv[1][2] * rs * gm[6] + sh[6], xv[1][3] * rs * gm[7] + sh[7]);
            w.z = cvt_pk_fp8x4(xv[2][0] * rs * gm[8] + sh[8], xv[2][1] * rs * gm[9] + sh[9], xv[2][2] * rs * gm[10] + sh[10], xv[2][3] * rs * gm[11] + sh[11]);
            w.w = cvt_pk_fp8x4(xv[3][0] * rs * gm[12] + sh[12], xv[3][1] * rs * gm[13] + sh[13], xv[3][2] * rs * gm[14] + sh[14], xv[3][3] * rs * gm[15] + sh[15]);
            *(u32x4*)(H8 + ro) = w;
        }
    }
    __syncthreads();
    if (F.tid < 256) cnt[F.blk * 256 + F.tid] = wcnt[F.tid];
    __syncthreads();
}

DI void phase_slots(const Frame& F) {
    LAS int* part = (LAS int*)F.lds;
    LAS int* tot = part + 1024; LAS int* bef = tot + 32; LAS int* pst = bef + 32; LAS int* base = pst + 32;
    const int* cnt = (const int*)(F.ws + WS_CNT); const int* toke = (const int*)(F.ws + WS_TOKE);
    int* toks = (int*)(F.ws + WS_TOKS); int* rowtok = (int*)(F.ws + WS_ROWTOK); int* tile = (int*)(F.ws + WS_TILE);
    const int nrows = F.G * 8;
    { const int e = F.tid & 31, pt = F.tid >> 5; int sa = 0, sb = 0; const int per = (nrows + 15) / 16;
      const int r0 = pt * per, r1 = ((pt + 1) * per < nrows) ? (pt + 1) * per : nrows;
#pragma unroll 16
      for (int rw = r0; rw < r1; ++rw) { const int c = cnt[rw * 32 + e]; sa += c; sb += (rw < F.blk * 8) ? c : 0; }
      part[pt * 32 + e] = sa; part[512 + pt * 32 + e] = sb; }
    __syncthreads();
    if (F.tid < 32) { int sa = 0, sb = 0; for (int pt = 0; pt < 16; ++pt) { sa += part[pt * 32 + F.tid]; sb += part[512 + pt * 32 + F.tid]; } tot[F.tid] = sa; bef[F.tid] = sb; }
    __syncthreads();
    if (F.tid == 0) { int run = 0; for (int e = 0; e < 32; ++e) { pst[e] = run; run += (tot[e] + 255) / 256 * 256; }
        if (F.blk == 0) { tile[1000] = run / 256; } }
    __syncthreads();
    if (F.tid < 256) { const int w = F.tid >> 5, e = F.tid & 31; int s = pst[e] + bef[e]; for (int w2 = 0; w2 < w; ++w2) s += cnt[(F.blk * 8 + w2) * 32 + e]; base[w * 32 + e] = s; }
    if (F.blk == 0) { for (int i = F.tid; i < 544; i += 512) { int e = 0; for (int q = 0; q < 32; ++q) if (i * 256 >= pst[q] + (tot[q] + 255) / 256 * 256) e = q + 1; tile[i] = e < 31 ? e : 31; } }
    if (F.blk < 32) { const int e = F.blk; const int s0 = pst[e] + tot[e], s1 = pst[e] + (tot[e] + 255) / 256 * 256; for (int s = s0 + F.tid; s < s1; s += 512) rowtok[s] = 0; }
    __syncthreads();
    for (int it = 0;; ++it) {
        const int row0 = (it * F.G + F.blk) * 128; if (row0 >= T) break;
        const int wr0 = row0 + 16 * F.wave;
        const int ev = toke[wr0 * 4 + F.lane];
        for (int t = 0; t < 16; ++t) { const int row = wr0 + t; const int e = __shfl(ev, 4 * t + (F.lane & 3));
            if (F.lane < 4) { const int s = __hip_atomic_fetch_add(base + F.wave * 32 + e, 1, __ATOMIC_RELAXED, __HIP_MEMORY_SCOPE_WORKGROUP);
                toks[row * 4 + F.lane] = s; rowtok[s] = row; } }
    }
    __syncthreads();
}

DI void fp8x4_to_f32(unsigned w, float (&o)[4]) { typedef float f2_ __attribute__((ext_vector_type(2))); const f2_ a = __builtin_amdgcn_cvt_pk_f32_fp8(w, false), b = __builtin_amdgcn_cvt_pk_f32_fp8(w, true); o[0] = a[0]; o[1] = a[1]; o[2] = b[0]; o[3] = b[1]; }
DI void final_row_load(const bf16_t* X1B, const unsigned char* YA, int row, const i32x4 sl, int lane, u32x4 (&ya)[4], u32x4 (&x1)[2]) {
    const int c0 = 16 * lane;
#pragma unroll
    for (int k = 0; k < 4; ++k) ya[k] = *(const u32x4*)(YA + (size_t)sl[k] * 1024 + c0);
    x1[0] = *(const u32x4*)(X1B + (size_t)row * D + c0); x1[1] = *(const u32x4*)(X1B + (size_t)row * D + c0 + 8);
}
DI void final_row_finish(const float* modgt, const float* gfin, float* out, int row, const f32x4 gk, int lane, const u32x4 (&ya)[4], const u32x4 (&x1)[2]) {
    const int c0 = 16 * lane; float ss = 0.f; f32x4 xo[4];
#pragma unroll
    for (int q = 0; q < 4; ++q) {
        f32x4 m4 = (f32x4){0.f, 0.f, 0.f, 0.f};
#pragma unroll
        for (int k = 0; k < 4; ++k) { float y[4]; fp8x4_to_f32(ya[k][q], y); m4[0] += gk[k] * y[0]; m4[1] += gk[k] * y[1]; m4[2] += gk[k] * y[2]; m4[3] += gk[k] * y[3]; }
        const f32x4 gt = *(const f32x4*)(modgt + c0 + 4 * q);
        f32x4 g4; const unsigned ga = x1[q >> 1][2 * (q & 1)], gb = x1[q >> 1][2 * (q & 1) + 1]; g4[0] = bflo(ga); g4[1] = bfhi(ga); g4[2] = bflo(gb); g4[3] = bfhi(gb);
        const f32x4 x2 = g4 + gt * m4; xo[q] = x2; ss += x2[0] * x2[0] + x2[1] * x2[1] + x2[2] * x2[2] + x2[3] * x2[3]; }
    ss = wave_sum(ss); const float rstd = rsqrtf(ss * (1.0f / 1024.0f) + EPS);
#pragma unroll
    for (int q = 0; q < 4; ++q) { const f32x4 gg = *(const f32x4*)(gfin + c0 + 4 * q); *(f32x4*)(out + (size_t)row * D + c0 + 4 * q) = xo[q] * rstd * gg; }
}
DI void phase_final(const Frame& F) {
    const bf16_t* X1B = (const bf16_t*)(F.ws + WS_CAT); const unsigned char* YA = (const unsigned char*)(F.ws + WS_YA); const int* toks = (const int*)(F.ws + WS_TOKS); const float* tokg = (const float*)(F.ws + WS_TOKG);
    const float* mod = (const float*)(F.ws + WS_MOD); const float* gfin = F.in[I_GFIN]; float* out = F.out;
    for (int it = 0;; ++it) {
        const int row0 = (it * F.G + F.blk) * 128 + 16 * F.wave; if (row0 >= T) break;
        const float* modgt = mod + (row0 >> 12) * 6144 + 5120;
        const i32x4 slv = *(const i32x4*)(toks + (size_t)(row0 + (F.lane & 15)) * 4); const f32x4 gkv = *(const f32x4*)(tokg + (size_t)(row0 + (F.lane & 15)) * 4);
#pragma unroll 1
        for (int t = 0; t < 16; t += 4) {
            i32x4 s_[4]; f32x4 g_[4];
#pragma unroll
            for (int r = 0; r < 4; ++r)
#pragma unroll
                for (int k = 0; k < 4; ++k) { s_[r][k] = __shfl(slv[k], t + r); g_[r][k] = __shfl(gkv[k], t + r); }
            u32x4 ya_[4][4], x1_[4][2];
#pragma unroll
            for (int r = 0; r < 4; ++r) final_row_load(X1B, YA, row0 + t + r, s_[r], F.lane, ya_[r], x1_[r]);
#pragma unroll
            for (int r = 0; r < 4; ++r) final_row_finish(modgt, gfin, out, row0 + t + r, g_[r], F.lane, ya_[r], x1_[r]);
        }
    }
}

__global__ void __launch_bounds__(512, 2) fwd_kernel(Args args) {
    extern __shared__ __attribute__((aligned(16))) unsigned char lds_raw[];
    Frame F;
    F.lds = (LAS unsigned char*)lds_raw; F.tid = threadIdx.x; F.lane = F.tid & 63; F.wave = __builtin_amdgcn_readfirstlane(F.tid >> 6);
    F.G = gridDim.x; F.blk = blockIdx.x; F.vcu = (F.G % 8 == 0) ? (F.blk % 8) * (F.G / 8) + F.blk / 8 : F.blk;
#pragma unroll
    for (int i = 0; i < 27; ++i) F.in[i] = args.in[i];
    F.out = args.out; F.ws = args.ws;
    volatile LAS unsigned* MISC = (volatile LAS unsigned*)(F.lds + MISC_OFF);
    if (F.tid < 64) MISC[F.tid] = 0u;
    __syncthreads();
    const int lo = args.ph_lo, hi = args.ph_hi;
    unsigned* barw = (unsigned*)(F.ws + WS_CTL) + CW_BAR;
    XcdBarrier bar; bar.bar = barw; bar.x = 0; bar.st = nullptr;
    if (hi - lo > 1) bar = xcd_barrier_post(barw, MISC + 8);
#ifndef PH_MASK
#define PH_MASK 0xfff
#endif
#define IN(k) (((PH_MASK >> (k)) & 1) && lo <= (k) && (k) < hi)
#define SEAM(k) do { if (IN(k) && IN((k) + 1)) xcd_barrier(bar); } while (0)
    LAS unsigned char* ring = F.lds;

    if (IN(0)) { phase0(F); } SEAM(0);
    if (IN(1)) { phase1(F); } SEAM(1);
    if (IN(2)) {
        pg8::Gemm g{(const bf16_t*)(F.ws + WS_H), (const bf16_t*)(F.ws + WS_WIN), 1024};
        pg8::SchedPlain S{T / 256, 6, F.G, F.vcu}; pg8::EpiBf16Plain E{(bf16_t*)(F.ws + WS_XP), 1536};
        pg8::gemm_phase(ring, g, S, E);
    } SEAM(2);
    if (IN(3)) { phase3(F); } SEAM(3);
    if (IN(4)) { phase4(F); } SEAM(4);
    if (IN(6)) {
        pg8::Gemm g{(const bf16_t*)(F.ws + WS_CAT), (const bf16_t*)(F.ws + WS_WOUT), 1024};
        pg8::SchedPlain S{T / 256, 4, F.G, F.vcu}; pg8::EpiGmix E{(const float*)(F.ws + WS_MOD), (bf16_t*)(F.ws + WS_GMIX)};
        pg8::gemm_phase(ring, g, S, E);
    } SEAM(6);
    if (IN(7)) { phase_router(F); } SEAM(7);
    if (IN(8)) { phase_slots(F); } SEAM(8);
    if (IN(9)) {
        pg8::Gemm g{(const bf16_t*)(F.ws + WS_H), (const bf16_t*)(F.ws + WS_WGU), 512};
        pg8::SchedMoe::setup(F.lds, (const int*)(F.ws + WS_TILE), (const int*)(F.ws + WS_ROWTOK), F.in[I_BGU], 8, F.G, F.vcu, F.tid, false);
        pg8::SchedMoe S{(LAS const int*)(F.lds + UT_OFF), (LAS const unsigned short*)(F.lds + RTL_OFF), 8, F.G, F.vcu, true}; pg8::EpiAct E{(LAS const float*)(F.lds + BL_OFF), (unsigned char*)(F.ws + WS_ACT)};
        pg8::gemm_phase(ring, g, S, E);
    } SEAM(9);
    if (IN(10)) {
        pg8::Gemm g{(const bf16_t*)(F.ws + WS_ACT), (const bf16_t*)(F.ws + WS_WDOWN), 512};
        pg8::SchedMoe::setup(F.lds, (const int*)(F.ws + WS_TILE), nullptr, F.in[I_BD], 4, F.G, F.vcu, F.tid, true);
        pg8::SchedMoe S{(LAS const int*)(F.lds + UT_OFF), (LAS const unsigned short*)(F.lds + RTL_OFF), 4, F.G, F.vcu, false}; pg8::EpiDown E{(LAS const float*)(F.lds + BL_OFF), (unsigned char*)(F.ws + WS_YA)};
        pg8::gemm_phase(ring, g, S, E);
    } SEAM(10);
    if (IN(11)) { phase_final(F); }
#undef IN
#undef SEAM
}

extern "C" void kernel_launch(void* const* d_in, const int* in_sizes, int n_in, void* d_out, int out_size, void* d_ws, size_t ws_size, hipStream_t stream) {
    static int grid = 0;
    if (grid == 0) {
        if (n_in != 27 || out_size != T * D || ws_size < WS_END) { fprintf(stderr, "kernel_launch: unexpected shapes (n_in %d out %d ws %zu)\n", n_in, out_size, ws_size); grid = -1; return; }
        int dev = 0, cus = 0, per_cu = 0;
        if (hipGetDevice(&dev) != hipSuccess || hipDeviceGetAttribute(&cus, hipDeviceAttributeMultiprocessorCount, dev) != hipSuccess) { grid = -1; return; }
        if (hipFuncSetAttribute((const void*)fwd_kernel, hipFuncAttributeMaxDynamicSharedMemorySize, LDS_BYTES) != hipSuccess) { fprintf(stderr, "kernel_launch: hipFuncSetAttribute failed\n"); grid = -1; return; }
        if (hipOccupancyMaxActiveBlocksPerMultiprocessor(&per_cu, (const void*)fwd_kernel, 512, LDS_BYTES) != hipSuccess || per_cu < 1) { fprintf(stderr, "kernel_launch: occupancy query says %d\n", per_cu); }
        (void)hipGetLastError();
        grid = cus;
    }
    if (grid < 0) return;
    (void)hipMemsetAsync((char*)d_ws + WS_CTL, 0, CTL_BYTES, stream);
    Args a{};
    for (int i = 0; i < 27; ++i) a.in[i] = (const float*)d_in[i];
    a.out = (float*)d_out; a.ws = (unsigned char*)d_ws;
#if N_LAUNCH_MODE == 1
    a.ph_lo = 0; a.ph_hi = NPHASE;
    hipLaunchKernelGGL(fwd_kernel, dim3(grid), dim3(512), LDS_BYTES, stream, a);
#else
    for (int p = 0; p < NPHASE; ++p) { a.ph_lo = p; a.ph_hi = p + 1; hipLaunchKernelGGL(fwd_kernel, dim3(grid), dim3(512), LDS_BYTES, stream, a); }
#endif
}
```

```cpp
#include <hip/hip_runtime.h>
#include <stdint.h>
#include <stdio.h>

#define DI __device__ __forceinline__
#define LAS __attribute__((address_space(3)))
typedef unsigned short bf16_t;
typedef short bf16x8 __attribute__((ext_vector_type(8)));
typedef float f32x4 __attribute__((ext_vector_type(4)));
typedef float f32x16 __attribute__((ext_vector_type(16)));
typedef unsigned u32x4 __attribute__((ext_vector_type(4)));
typedef unsigned u32x2 __attribute__((ext_vector_type(2)));
typedef int i32x4 __attribute__((ext_vector_type(4)));
typedef int i32x8 __attribute__((ext_vector_type(8)));

constexpr int D = 1024, NB = 8, SEQ = 4096, T = NB * SEQ, CTXL = 256, TC = NB * CTXL, TT = T + TC;
constexpr int DR = 512, NE = 32;
constexpr int CAP = (T * 4 / 256 + NE) * 256;
constexpr int NCH = 68;
constexpr float EPS = 1e-6f;
#ifndef N_LAUNCH_MODE
#define N_LAUNCH_MODE 1
#endif
constexpr int NPHASE = 12;

constexpr size_t MiB = 1u << 20;
constexpr size_t WS_CTL = 0, CTL_BYTES = 1 * MiB;
constexpr size_t WS_MOD = 1 * MiB;
constexpr size_t WS_RGW = 1 * MiB + 256 * 1024;
constexpr size_t WS_TILE = 1 * MiB + 512 * 1024;
constexpr size_t WS_CNT = 2 * MiB;
constexpr size_t WS_CF = 2 * MiB + 256 * 1024;
constexpr size_t WS_WMF = 2 * MiB + 512 * 1024;
constexpr size_t WS_TOKE = 3 * MiB;
constexpr size_t WS_TOKG = 3 * MiB + 512 * 1024;
constexpr size_t WS_TOKS = 4 * MiB;
constexpr size_t WS_ROWTOK = 4 * MiB + 512 * 1024;
constexpr size_t WS_ROWGATE = 5 * MiB + 256 * 1024;
constexpr size_t WS_SUMP = 6 * MiB;
constexpr size_t WS_SUMH = 8 * MiB + 256 * 1024;
constexpr size_t WS_WIN = 11 * MiB;
constexpr size_t WS_WOUT = 15 * MiB;
constexpr size_t WS_WDOWN = 17 * MiB;
constexpr size_t WS_WGU = 49 * MiB;
constexpr size_t WS_H = 113 * MiB;
constexpr size_t WS_GMIX = 181 * MiB;
constexpr size_t WS_YA = 309 * MiB;
constexpr size_t WS_XP = 581 * MiB;
constexpr size_t WS_ZG = 683 * MiB;
constexpr size_t WS_CAT = 747 * MiB;
constexpr size_t WS_SS = 843 * MiB;
constexpr size_t WS_CAF = 875 * MiB;
constexpr size_t WS_CAB = 907 * MiB;
constexpr size_t WS_ACT = 581 * MiB;
constexpr size_t WS_END = 939 * MiB;
static_assert(WS_ACT + (size_t)CAP * 1024 <= WS_CAT && WS_YA + (size_t)CAP * 2048 <= WS_XP && WS_XP + (size_t)TT * 3072 <= WS_ZG && WS_ROWGATE + CAP * 4 <= WS_SUMP && WS_SUMH + 8 * 2 * 68 * 512 * 4 <= WS_WIN, "ws map");

constexpr int CW_BAR = 4096;
constexpr int LDS_BYTES = 163840;
constexpr int MISC_OFF = 135168;
constexpr int UT_OFF = MISC_OFF + 2048, RTL_OFF = MISC_OFF + 2560, BL_OFF = MISC_OFF + 11264, MAXU = 17;
static_assert(RTL_OFF + MAXU * 512 <= BL_OFF && BL_OFF + MAXU * 1024 <= LDS_BYTES, "LDS map");

DI unsigned cvt_pk_bf16(float lo, float hi) { unsigned r; asm("v_cvt_pk_bf16_f32 %0, %1, %2" : "=v"(r) : "v"(lo), "v"(hi)); return r; }
DI float bflo(unsigned w) { return __uint_as_float(w << 16); }
DI float bfhi(unsigned w) { return __uint_as_float(w & 0xffff0000u); }
DI float bf2f(bf16_t b) { return __uint_as_float(((unsigned)b) << 16); }
DI bf16_t f2bf(float f) { return (bf16_t)(cvt_pk_bf16(f, 0.f) & 0xffffu); }
DI unsigned cvt_pk_fp8x4(float a, float b, float c, float d) { unsigned r = 0; r = __builtin_amdgcn_cvt_pk_fp8_f32(a, b, r, false); r = __builtin_amdgcn_cvt_pk_fp8_f32(c, d, r, true); return r; }
DI float wave_sum(float v) { v += __shfl_xor(v, 32); v += __shfl_xor(v, 16); v += __shfl_xor(v, 8); v += __shfl_xor(v, 4); v += __shfl_xor(v, 2); v += __shfl_xor(v, 1); return v; }
DI float sigmoidf_(float x) { return __builtin_amdgcn_rcpf(1.0f + __expf(-x)); }
DI float gelu_tanh(float x) { const float z = 0.7978845608028654f * (x + 0.044715f * x * x * x); const float e = __expf(2.0f * z); return x * (1.0f - __builtin_amdgcn_rcpf(1.0f + e)); }

#define XB_TMO      128
#define XB_XCNT(j)  (256  + 64 * (j))
#define XB_XSUB(j)  (1280 + 64 * (j))
#define XB_XGEN(j)  (2304 + 64 * (j))
#define XB_TOP      3328
#define XB_TOPGEN   3392
#define XCD_BAR_WORDS 3456
#define XB_SPIN_CAP (1u << 18)
DI unsigned xb_ld(unsigned* p)              { return __hip_atomic_load(p, __ATOMIC_RELAXED, __HIP_MEMORY_SCOPE_AGENT); }
DI unsigned xb_add(unsigned* p, unsigned v) { return __hip_atomic_fetch_add(p, v, __ATOMIC_RELAXED, __HIP_MEMORY_SCOPE_AGENT); }
DI unsigned xb_xcc_id() { return (unsigned)__builtin_amdgcn_s_getreg((3 << 11) | 20) & 0xFu; }
#define XB_SPIN(cond, bar) do { unsigned _sp = 0; while (cond) { __builtin_amdgcn_s_sleep(1); \
    if ((++_sp & 255u) == 0u) { if (xb_ld(&(bar)[XB_TMO])) break; if (_sp > XB_SPIN_CAP) { atomicAdd(&(bar)[XB_TMO], 1u); break; } } } } while (0)
struct XcdBarrier { unsigned* bar; unsigned x; volatile LAS unsigned* st; };
DI XcdBarrier xcd_barrier_post(unsigned* bar, volatile LAS unsigned* st) {
    XcdBarrier b; b.bar = bar; b.x = xb_xcc_id(); b.st = st;
    if (threadIdx.x == 0) (void)xb_add(&bar[XB_XCNT(b.x)], 1u);
    return b;
}
DI void xcd_barrier_complete(unsigned* bar, unsigned x, unsigned& nloc, unsigned& nx) {
    const unsigned G = gridDim.x * gridDim.y * gridDim.z;
    unsigned sum, cnt, mine, sp = 0u;
    for (;;) {
        sum = 0u; cnt = 0u; mine = 0u;
#pragma unroll
        for (unsigned j = 0; j < 16; ++j) { const unsigned c = xb_ld(&bar[XB_XCNT(j)]); sum += c; cnt += (c > 0u) ? 1u : 0u; mine = (j == x) ? c : mine; }
        if (sum == G) break;
        __builtin_amdgcn_s_sleep(1);
        if ((++sp & 255u) == 0u) { if (xb_ld(&bar[XB_TMO])) break; if (sp > XB_SPIN_CAP) { atomicAdd(&bar[XB_TMO], 1u); break; } }
    }
    nloc = mine > 0u ? mine : 1u; nx = cnt > 0u ? cnt : 1u;
}
DI void xcd_barrier(const XcdBarrier& b) {
    asm volatile("s_waitcnt vmcnt(0)" ::: "memory");
    __syncthreads();
    if (threadIdx.x == 0) {
        unsigned* bar = b.bar;
        __builtin_amdgcn_s_waitcnt(0);
        unsigned nloc = b.st[0], nx = b.st[1];
        if (nloc == 0u) { xcd_barrier_complete(bar, b.x, nloc, nx); b.st[0] = nloc; b.st[1] = nx; }
        const unsigned old = xb_add(&bar[XB_XSUB(b.x)], 1u);
        const unsigned gen = old / nloc;
        if (old + 1u == (gen + 1u) * nloc) {
            __builtin_amdgcn_fence(__ATOMIC_RELEASE, "agent");
            asm volatile("s_waitcnt vmcnt(0)" ::: "memory");
            const unsigned og = xb_add(&bar[XB_TOP], 1u);
            const unsigned tg = og / nx;
            if (og + 1u == (tg + 1u) * nx) xb_add(&bar[XB_TOPGEN], 1u);
            else XB_SPIN(xb_ld(&bar[XB_TOPGEN]) == tg, bar);
            __builtin_amdgcn_fence(__ATOMIC_ACQUIRE, "agent");
            xb_add(&bar[XB_XGEN(b.x)], 1u);
            asm volatile("s_waitcnt vmcnt(0)" ::: "memory");
        } else {
            XB_SPIN(xb_ld(&bar[XB_XGEN(b.x)]) == gen, bar);
            __builtin_amdgcn_fence(__ATOMIC_ACQUIRE, "agent");
            asm volatile("s_waitcnt vmcnt(0)" ::: "memory");
        }
    }
    __syncthreads();
}

namespace pg8 {
constexpr int BM = 256, BK = 64, HALF = 128, HTB = HALF * BK * 2, STAGE_BYTES = 8 * HTB;
DI int lds_byte(int r, int c) { const int st = (r >> 4) * 2 + (c >> 5), rr = r & 15, cc = c & 31, ob = rr * 64 + cc * 2; return st * 1024 + (ob ^ (((ob >> 9) & 1) << 5)); }
DI void stage_rc(int b, int& R, int& C) { const int st = b / 1024, sb = b % 1024, swz = sb ^ (((sb >> 9) & 1) << 5); R = (st >> 1) * 16 + swz / 64; C = (st & 1) * 32 + (swz % 64) / 2; }
DI int perm32(int rho) { const int n = rho >> 4, i = rho & 15; return 8 * (i >> 2) + 4 * n + (i & 3); }
struct Unit { int pm, pn, aux, ix; };
struct Gemm { const bf16_t* A; const bf16_t* Bt; int K; };

template <class Epi, class Sched>
DI void gemm_phase(LAS unsigned char* lds, const Gemm g, const Sched& S, const Epi& E) {
    const int tid = threadIdx.x, wid = __builtin_amdgcn_readfirstlane(tid >> 6), lane = tid & 63, wr = wid >> 2, wc = wid & 3, fr = lane & 15, fq = lane >> 4;
    const int K = g.K, nt = K / BK;
    int RA[2], CA[2]; unsigned voffB[2];
#pragma unroll
    for (int i = 0; i < 2; ++i) { int R, C; stage_rc(tid * 16 + i * 8192, R, C); const int Rb = Epi::PERM ? ((R & ~31) + perm32(R & 31)) : R;
        RA[i] = R; CA[i] = C; voffB[i] = (unsigned)(Rb * K + C) * 2u; }
    const unsigned kstep = (unsigned)(BK * 2);
    const size_t hstep = (size_t)HALF * K * 2;
    const unsigned ldsw = (unsigned)wid * 1024u;
    const int aoff = lds_byte(wr * 64 + fr, fq * 8), boff = lds_byte(wc * 32 + fr, fq * 8);
#define PG8_SA(b, h) (((b) * 2 + (h)) * HTB)
#define PG8_SB(b, h) ((4 + (b) * 2 + (h)) * HTB)
#define PG8_STAGE_B(bufoff, gbase) do { _Pragma("unroll") for (int _i = 0; _i < 2; ++_i) \
        __builtin_amdgcn_global_load_lds((const unsigned*)((const char*)(gbase) + voffB[_i]), (LAS unsigned*)(lds + (bufoff) + ldsw + _i * 8192), 16, 0, 0); } while (0)
#define PG8_STAGE_A(bufoff, kb, o, h) do { _Pragma("unroll") for (int _i = 0; _i < 2; ++_i) \
        __builtin_amdgcn_global_load_lds((const unsigned*)((const char*)g.A + (size_t)(kb) + (o)[h][_i]), (LAS unsigned*)(lds + (bufoff) + ldsw + _i * 8192), 16, 0, 0); } while (0)
#define PG8_LDA(dst, b, h) do { if constexpr (Epi::FP8) { _Pragma("unroll") for (int m = 0; m < 4; ++m) { \
            const i32x4 lo_ = *(const LAS i32x4*)(lds + PG8_SA(b, h) + aoff + m * 2048), hi_ = *(const LAS i32x4*)(lds + PG8_SA(b, h) + aoff + m * 2048 + 1024); \
            dst##8[m] = __builtin_shufflevector(lo_, hi_, 0, 1, 2, 3, 4, 5, 6, 7); } } \
        else { _Pragma("unroll") for (int m = 0; m < 4; ++m) _Pragma("unroll") for (int k = 0; k < 2; ++k) dst[m][k] = *(const LAS bf16x8*)(lds + PG8_SA(b, h) + aoff + m * 2048 + k * 1024); } } while (0)
#define PG8_LDB(dst, b, h) do { if constexpr (Epi::FP8) { _Pragma("unroll") for (int n = 0; n < 2; ++n) { \
            const i32x4 lo_ = *(const LAS i32x4*)(lds + PG8_SB(b, h) + boff + n * 2048), hi_ = *(const LAS i32x4*)(lds + PG8_SB(b, h) + boff + n * 2048 + 1024); \
            dst##8[n] = __builtin_shufflevector(lo_, hi_, 0, 1, 2, 3, 4, 5, 6, 7); } } \
        else { _Pragma("unroll") for (int n = 0; n < 2; ++n) _Pragma("unroll") for (int k = 0; k < 2; ++k) dst[n][k] = *(const LAS bf16x8*)(lds + PG8_SB(b, h) + boff + n * 2048 + k * 1024); } } while (0)
#define PG8_MMA(ai, bj, At, Bt) do { __builtin_amdgcn_s_setprio(1); \
        if constexpr (Epi::FP8) { _Pragma("unroll") for (int m = 0; m < 4; ++m) _Pragma("unroll") for (int n = 0; n < 2; ++n) \
            asm volatile("v_mfma_scale_f32_16x16x128_f8f6f4 %0, %1, %2, %0, %3, %4 op_sel_hi:[0,0,0]" : "+v"(acc[ai][bj][m][n]) : "v"(Bt##8[n]), "v"(At##8[m]), "v"(scale_w_), "v"(scale_a_)); } \
        else { _Pragma("unroll") for (int m = 0; m < 4; ++m) _Pragma("unroll") for (int n = 0; n < 2; ++n) _Pragma("unroll") for (int k = 0; k < 2; ++k) \
            acc[ai][bj][m][n] = __builtin_amdgcn_mfma_f32_16x16x32_bf16(Bt[n][k], At[m][k], acc[ai][bj][m][n], 0, 0, 0); } \
        __builtin_amdgcn_s_setprio(0); } while (0)
#define PG8_WAIT_V(n) asm volatile("s_waitcnt vmcnt(" #n ")" ::: "memory")
#define PG8_WAIT_L(n) asm volatile("s_waitcnt lgkmcnt(" #n ")" ::: "memory")
#define PG8_BAR __builtin_amdgcn_s_barrier()
#define PG8_SCHED __builtin_amdgcn_sched_barrier(0)
    Unit cur, nxt; int ui = 0;
    if (!S.next(0, cur)) return;
    f32x4 acc[2][2][4][2];
#pragma unroll
    for (int a = 0; a < 2; ++a)
#pragma unroll
        for (int b = 0; b < 2; ++b)
#pragma unroll
            for (int m = 0; m < 4; ++m)
#pragma unroll
                for (int n = 0; n < 2; ++n) acc[a][b][m][n] = (f32x4){0.f, 0.f, 0.f, 0.f};
    int scale_w_ = Epi::SCALE_W, scale_a_ = 0x7f7f7f7f; asm volatile("" : "+v"(scale_w_), "+v"(scale_a_));
    bf16x8 At[4][2], B0[2][2], B1[2][2]; i32x8 At8[4], B08[2], B18[2];
    unsigned oc[2][2], on[2][2];
    S.a_off(cur, RA, CA, K, oc);
    const char* cB = (const char*)g.Bt + S.b_off(cur, K);
    PG8_STAGE_B(PG8_SB(0, 0), cB); PG8_STAGE_A(PG8_SA(0, 0), 0u, oc, 0); PG8_STAGE_B(PG8_SB(0, 1), cB + hstep); PG8_STAGE_A(PG8_SA(0, 1), 0u, oc, 1);
    if (wr == 1) PG8_BAR;
    PG8_WAIT_V(4); PG8_BAR;
    PG8_STAGE_B(PG8_SB(1, 0), cB + kstep); PG8_STAGE_A(PG8_SA(1, 0), kstep, oc, 0); PG8_STAGE_B(PG8_SB(1, 1), cB + hstep + kstep);
    PG8_WAIT_V(6); PG8_BAR;
    for (;;) {
        const bool has_next = S.next(ui + 1, nxt);
        const char* nB = cB;
        if (has_next) { S.a_off(nxt, RA, CA, K, on); nB = (const char*)g.Bt + S.b_off(nxt, K); }
        else {
#pragma unroll
            for (int h = 0; h < 2; ++h)
#pragma unroll
                for (int i = 0; i < 2; ++i) on[h][i] = oc[h][i];
        }
#pragma unroll 1
        for (int t = 0; t < nt; t += 2) {
            const bool last = (t == nt - 2);
            const unsigned k1 = (unsigned)(t + 1) * kstep;
            const unsigned k2 = last ? 0u : (unsigned)(t + 2) * kstep, k3 = k2 + kstep;
            unsigned o2[2][2];
#pragma unroll
            for (int h = 0; h < 2; ++h)
#pragma unroll
                for (int i = 0; i < 2; ++i) o2[h][i] = last ? on[h][i] : oc[h][i];
            const char* b2 = last ? nB : cB + (size_t)(t + 2) * kstep; const char* b3 = b2 + kstep;
            PG8_LDB(B0, 0, 0); PG8_SCHED; PG8_LDA(At, 0, 0); PG8_STAGE_A(PG8_SA(1, 1), k1, oc, 1);
            PG8_WAIT_L(8); PG8_BAR; PG8_WAIT_L(0); PG8_MMA(0, 0, At, B0); PG8_BAR; PG8_SCHED;
            PG8_LDB(B1, 0, 1); PG8_STAGE_B(PG8_SB(0, 0), b2);
            PG8_BAR; PG8_WAIT_L(0); PG8_MMA(0, 1, At, B1); PG8_BAR;
            PG8_LDA(At, 0, 1); PG8_STAGE_A(PG8_SA(0, 0), k2, o2, 0);
            PG8_BAR; PG8_WAIT_L(0); PG8_MMA(1, 0, At, B0); PG8_BAR; PG8_SCHED;
            PG8_STAGE_B(PG8_SB(0, 1), b2 + hstep);
            PG8_WAIT_V(6); PG8_BAR; PG8_MMA(1, 1, At, B1); PG8_BAR;
            PG8_LDB(B0, 1, 0); PG8_SCHED; PG8_LDA(At, 1, 0); PG8_STAGE_A(PG8_SA(0, 1), k2, o2, 1);
            PG8_WAIT_L(8); PG8_BAR; PG8_WAIT_L(0); PG8_MMA(0, 0, At, B0); PG8_BAR; PG8_SCHED;
            PG8_LDB(B1, 1, 1); PG8_STAGE_B(PG8_SB(1, 0), b3);
            PG8_BAR; PG8_WAIT_L(0); PG8_MMA(0, 1, At, B1); PG8_BAR;
            PG8_LDA(At, 1, 1); PG8_STAGE_A(PG8_SA(1, 0), k3, o2, 0);
            PG8_BAR; PG8_WAIT_L(0); PG8_MMA(1, 0, At, B0); PG8_BAR; PG8_SCHED;
            PG8_STAGE_B(PG8_SB(1, 1), b3 + hstep);
            PG8_WAIT_V(6); PG8_BAR; PG8_MMA(1, 1, At, B1); PG8_BAR;
        }
        if constexpr (Epi::FP8) asm volatile("s_nop 15\n\ts_nop 15" ::: "memory");
        E(acc, cur, wr, wc, fr, fq);
        if (!has_next) break;
#pragma unroll
        for (int a = 0; a < 2; ++a)
#pragma unroll
            for (int b = 0; b < 2; ++b)
#pragma unroll
                for (int m = 0; m < 4; ++m)
#pragma unroll
                    for (int n = 0; n < 2; ++n) acc[a][b][m][n] = (f32x4){0.f, 0.f, 0.f, 0.f};
        cur = nxt; cB = nB; ++ui;
#pragma unroll
        for (int h = 0; h < 2; ++h)
#pragma unroll
            for (int i = 0; i < 2; ++i) oc[h][i] = on[h][i];
    }
    PG8_WAIT_V(0);
    if (wr == 0) PG8_BAR;
    PG8_BAR;
#undef PG8_SA
#undef PG8_SB
#undef PG8_STAGE_A
#undef PG8_STAGE_B
#undef PG8_LDA
#undef PG8_LDB
#undef PG8_MMA
#undef PG8_WAIT_V
#undef PG8_WAIT_L
#undef PG8_BAR
#undef PG8_SCHED
}

struct SchedPlain {
    int nM, nN, G, vcu;
    DI bool next(int i, Unit& u) const { const int L = i * G + vcu; if (L >= nM * nN) return false; u.pm = L / nN; u.pn = L % nN; u.aux = 0; u.ix = i; return true; }
    DI void a_off(const Unit& u, const int (&R)[2], const int (&C)[2], int K, unsigned (&o)[2][2]) const {
#pragma unroll
        for (int h = 0; h < 2; ++h)
#pragma unroll
            for (int i = 0; i < 2; ++i) o[h][i] = (unsigned)((u.pm * 256 + h * 128 + R[i]) * K + C[i]) * 2u; }
    DI size_t b_off(const Unit& u, int K) const { return (size_t)u.pn * 256 * K * 2; }
};
struct SchedMoe {
    LAS const int* ut; LAS const unsigned short* rtl; int nN, G, vcu; bool gather;
    static DI void setup(LAS unsigned char* lds, const int* tile, const int* rowtok, const float* bias, int nN, int G, int vcu, int tid, bool rev) {
        LAS int* ut = (LAS int*)(lds + UT_OFF); LAS unsigned short* rtl = (LAS unsigned short*)(lds + RTL_OFF); LAS float* bl = (LAS float*)(lds + BL_OFF);
        __syncthreads();
        const int nmt = tile[1000]; int nu = 0;
        for (int i = 0; i < MAXU; ++i) { const int L = i * G + vcu; if (L < nmt * nN) nu = i + 1; }
        if (tid < MAXU) { const int L = tid * G + vcu; if (L < nmt * nN) { const int pm = rev ? nmt - 1 - L / nN : L / nN; ut[1 + 2 * tid] = pm; ut[2 + 2 * tid] = tile[pm]; } }
        if (tid == 0) ut[0] = nu;
        for (int i = tid >> 8; i < nu; i += 2) { const int L = i * G + vcu, pm = rev ? nmt - 1 - L / nN : L / nN, pn = L % nN, e = tile[pm], c = tid & 255;
            if (rowtok) rtl[i * 256 + c] = (unsigned short)rowtok[pm * 256 + c];
            bl[i * 256 + c] = nN == 8 ? bias[(size_t)e * 2048 + (c >> 7) * 1024 + 128 * pn + (c & 127)] : bias[(size_t)e * 1024 + 256 * pn + c]; }
        __syncthreads();
    }
    DI bool next(int i, Unit& u) const { if (i >= ut[0]) return false; const int L = i * G + vcu; u.pm = ut[1 + 2 * i]; u.pn = L % nN; u.aux = ut[2 + 2 * i]; u.ix = i; return true; }
    DI void a_off(const Unit& u, const int (&R)[2], const int (&C)[2], int K, unsigned (&o)[2][2]) const {
        if (gather) {
            LAS const unsigned short* rp = rtl + u.ix * 256;
            const int t0 = rp[R[0]], t1 = rp[R[1]], t2 = rp[128 + R[0]], t3 = rp[128 + R[1]];
            o[0][0] = (unsigned)(t0 * K + C[0]) * 2u; o[0][1] = (unsigned)(t1 * K + C[1]) * 2u; o[1][0] = (unsigned)(t2 * K + C[0]) * 2u; o[1][1] = (unsigned)(t3 * K + C[1]) * 2u;
        } else {
#pragma unroll
            for (int h = 0; h < 2; ++h)
#pragma unroll
                for (int i = 0; i < 2; ++i) o[h][i] = (unsigned)((u.pm * 256 + h * 128 + R[i]) * K + C[i]) * 2u;
        }
    }
    DI size_t b_off(const Unit& u, int K) const { return (size_t)(u.aux * nN + u.pn) * 256 * K * 2; }
};

struct EpiBf16Plain {
    static constexpr bool PERM = true, FP8 = false; static constexpr int SCALE_W = 0x7f7f7f7f;
    bf16_t* O; int ldc;
    DI void operator()(const f32x4 (&acc)[2][2][4][2], const Unit& u, int wr, int wc, int fr, int fq) const {
        const int row0 = u.pm * BM + wr * 64 + fr, col0 = u.pn * BM + wc * 32 + 8 * fq;
#pragma unroll
        for (int ai = 0; ai < 2; ++ai)
#pragma unroll
            for (int m = 0; m < 4; ++m) { bf16_t* rowp = O + (size_t)(row0 + ai * HALF + m * 16) * ldc + col0;
#pragma unroll
                for (int bj = 0; bj < 2; ++bj) { const f32x4 v0 = acc[ai][bj][m][0], v1 = acc[ai][bj][m][1];
                    u32x4 w; w.x = cvt_pk_bf16(v0[0], v0[1]); w.y = cvt_pk_bf16(v0[2], v0[3]); w.z = cvt_pk_bf16(v1[0], v1[1]); w.w = cvt_pk_bf16(v1[2], v1[3]);
                    *(u32x4*)(rowp + bj * HALF) = w; } }
    }
};
struct EpiGmix {
    static constexpr bool PERM = true, FP8 = false; static constexpr int SCALE_W = 0x7f7f7f7f;
    const float* mod; bf16_t* O;
    DI void operator()(const f32x4 (&acc)[2][2][4][2], const Unit& u, int wr, int wc, int fr, int fq) const {
        const int row0 = u.pm * BM + wr * 64 + fr, col0 = u.pn * BM + wc * 32 + 8 * fq;
        const int b = (u.pm * BM) >> 12;
        f32x4 gt[2][2];
#pragma unroll
        for (int bj = 0; bj < 2; ++bj)
#pragma unroll
            for (int n = 0; n < 2; ++n) gt[bj][n] = *(const f32x4*)(mod + b * 6144 + 2048 + col0 + bj * HALF + 4 * n);
#pragma unroll
        for (int ai = 0; ai < 2; ++ai)
#pragma unroll
            for (int m = 0; m < 4; ++m) { bf16_t* rowp = O + (size_t)(row0 + ai * HALF + m * 16) * D + col0;
#pragma unroll
                for (int bj = 0; bj < 2; ++bj) { const f32x4 v0 = acc[ai][bj][m][0] * gt[bj][0], v1 = acc[ai][bj][m][1] * gt[bj][1];
                    u32x4 w; w.x = cvt_pk_bf16(v0[0], v0[1]); w.y = cvt_pk_bf16(v0[2], v0[3]); w.z = cvt_pk_bf16(v1[0], v1[1]); w.w = cvt_pk_bf16(v1[2], v1[3]);
                    *(u32x4*)(rowp + bj * HALF) = w; } }
    }
};
typedef float f32x2 __attribute__((ext_vector_type(2)));
struct EpiAct {
    static constexpr bool PERM = true, FP8 = true; static constexpr int SCALE_W = 0x7a7a7a7a;
    LAS const float* bl; unsigned char* O;
    DI void operator()(const f32x4 (&acc)[2][2][4][2], const Unit& u, int wr, int wc, int fr, int fq) const {
        const int row0 = u.pm * BM + wr * 64 + fr, cl = wc * 32 + 8 * fq, colj = u.pn * HALF + cl;
        LAS const float* bp = bl + u.ix * 256 + cl;
        f32x4 bgv[2], buv[2];
#pragma unroll
        for (int n = 0; n < 2; ++n) { bgv[n] = *(LAS const f32x4*)(bp + 4 * n); buv[n] = *(LAS const f32x4*)(bp + 128 + 4 * n); }
#pragma unroll
        for (int ai = 0; ai < 2; ++ai)
#pragma unroll
            for (int m = 0; m < 4; ++m) {
                f32x2 o[4];
#pragma unroll
                for (int n = 0; n < 2; ++n) { const f32x4 gv = acc[ai][0][m][n] + bgv[n], uv = acc[ai][1][m][n] + buv[n];
#pragma unroll
                    for (int j = 0; j < 2; ++j) {
                        f32x2 gt, up; gt.x = fminf(gv[2 * j], 7.0f); gt.y = fminf(gv[2 * j + 1], 7.0f); up.x = __builtin_amdgcn_fmed3f(uv[2 * j], -7.0f, 7.0f); up.y = __builtin_amdgcn_fmed3f(uv[2 * j + 1], -7.0f, 7.0f);
                        const f32x2 z = gt * (-1.702f * 1.44269504089f); f32x2 e; e.x = __builtin_amdgcn_exp2f(z.x); e.y = __builtin_amdgcn_exp2f(z.y);
                        const f32x2 d = e + 1.0f; f32x2 r; r.x = __builtin_amdgcn_rcpf(d.x); r.y = __builtin_amdgcn_rcpf(d.y);
                        o[2 * n + j] = (up + 1.0f) * (gt * r); } }
                u32x2 w; w.x = cvt_pk_fp8x4(o[0].x, o[0].y, o[1].x, o[1].y); w.y = cvt_pk_fp8x4(o[2].x, o[2].y, o[3].x, o[3].y);
                *(u32x2*)(O + (size_t)(row0 + ai * HALF + m * 16) * 1024 + colj) = w; }
    }
};
struct EpiDown {
    static constexpr bool PERM = true, FP8 = true; static constexpr int SCALE_W = 0x7a7a7a7a;
    LAS const float* bl; unsigned char* O;
    DI void operator()(const f32x4 (&acc)[2][2][4][2], const Unit& u, int wr, int wc, int fr, int fq) const {
        const int row0 = u.pm * BM + wr * 64 + fr, cl = wc * 32 + 8 * fq, col0 = u.pn * BM + cl;
        LAS const float* bp = bl + u.ix * 256 + cl;
        f32x4 bv[2][2];
#pragma unroll
        for (int bj = 0; bj < 2; ++bj)
#pragma unroll
            for (int n = 0; n < 2; ++n) bv[bj][n] = *(LAS const f32x4*)(bp + bj * HALF + 4 * n);
#pragma unroll
        for (int ai = 0; ai < 2; ++ai)
#pragma unroll
            for (int m = 0; m < 4; ++m) { unsigned char* rowp = O + (size_t)(row0 + ai * HALF + m * 16) * 1024 + col0;
#pragma unroll
                for (int bj = 0; bj < 2; ++bj) { const f32x4 v0 = acc[ai][bj][m][0] + bv[bj][0], v1 = acc[ai][bj][m][1] + bv[bj][1];
                    u32x2 w; w.x = cvt_pk_fp8x4(v0[0], v0[1], v0[2], v0[3]); w.y = cvt_pk_fp8x4(v1[0], v1[1], v1[2], v1[3]);
                    *(u32x2*)(rowp + bj * HALF) = w; } }
    }
};
}

struct Args { const float* in[27]; float* out; unsigned char* ws; int ph_lo, ph_hi; };
struct Frame {
    LAS unsigned char* lds; int tid, lane, wave, G, blk, vcu;
    const float* in[27]; float* out; unsigned char* ws;
};
enum { I_X = 0, I_C, I_CTX, I_CCTX, I_WMOD, I_BMOD, I_GMIX, I_GFFN, I_WIN, I_WF, I_CONVW, I_CONVB, I_RGWA, I_RGBA, I_RGWX, I_RGBX, I_LAM, I_GOF, I_GOR, I_WOUT, I_WR, I_BR, I_WGU, I_BGU, I_WD, I_BD, I_GFIN };

constexpr int IT_TR = 8 + 24 + 1 + 32;

DI void p0_adaln(const Frame& F, int cb) {
    LAS float* sc = (LAS float*)F.lds; LAS float* red = (LAS float*)(F.lds + 36864);
    const float* c = F.in[I_C]; const float* cctx = F.in[I_CCTX]; const float* wmod = F.in[I_WMOD]; const float* bmod = F.in[I_BMOD];
    float* mod = (float*)(F.ws + WS_MOD);
    for (int i = F.tid; i < 9 * 1024; i += 512) { const int r = i >> 10, k = i & 1023; const float v = r < 8 ? c[r * 1024 + k] : cctx[k]; sc[i] = v / (1.0f + __expf(-v)); }
    __syncthreads();
    f32x4 acc[9];
#pragma unroll
    for (int r = 0; r < 9; ++r) acc[r] = (f32x4){0.f, 0.f, 0.f, 0.f};
    const float* wp = wmod + (size_t)(128 * F.wave) * 6144 + cb * 256 + 4 * F.lane;
    for (int kk = 0; kk < 128; kk += 8) {
        f32x4 wv[8];
#pragma unroll
        for (int j = 0; j < 8; ++j) wv[j] = *(const f32x4*)(wp + (size_t)(kk + j) * 6144);
#pragma unroll
        for (int j = 0; j < 8; ++j)
#pragma unroll
            for (int r = 0; r < 9; ++r) { const float s = sc[r * 1024 + 128 * F.wave + kk + j]; acc[r] += s * wv[j]; }
    }
#pragma unroll
    for (int r = 0; r < 9; ++r) *(LAS f32x4*)(red + (F.wave * 9 + r) * 256 + 4 * F.lane) = acc[r];
    __syncthreads();
    for (int i = F.tid; i < 9 * 256; i += 512) { const int r = i >> 8, cc = i & 255; float s = bmod[cb * 256 + cc];
        for (int w = 0; w < 8; ++w) s += red[(w * 9 + r) * 256 + cc];
        mod[r * 6144 + cb * 256 + cc] = s; }
    __syncthreads();
}

DI void p0_wmf(const Frame& F, int it) {
    const int g = it >> 1, rip = it & 1;
    LAS float* tw = (LAS float*)F.lds;
    LAS float* wfs = tw + 128;
    LAS float* Fm = wfs + 128 * 128;
    const float* wf = F.in[I_WF] + (size_t)g * 128 * 128;
    bf16_t* WMF = (bf16_t*)(F.ws + WS_WMF);
    const float norm = 0.0013810679320049757f;
    __syncthreads();
    if (F.tid < 128) { const float rev = (float)F.tid * (1.0f / 128.0f); tw[F.tid] = rip ? __builtin_amdgcn_sinf(rev) : __builtin_amdgcn_cosf(rev); }
    for (int i = F.tid; i < 128 * 128; i += 512) wfs[i] = wf[i];
    __syncthreads();
    { const int jp = F.tid & 127, j0 = F.tid >> 7; float sacc[32];
#pragma unroll
      for (int i = 0; i < 32; ++i) sacc[i] = 0.f;
#pragma unroll 4
      for (int l = 0; l < 128; ++l) { const float w = wfs[l * 128 + jp];
#pragma unroll
          for (int i = 0; i < 32; ++i) sacc[i] += tw[(l * (j0 + 4 * i)) & 127] * w; }
#pragma unroll
      for (int i = 0; i < 32; ++i) Fm[(j0 + 4 * i) * 128 + jp] = sacc[i] * norm; }
    __syncthreads();
    for (int i = 0; i < 4; ++i) { const int idx = F.tid + 512 * i;
        const int ln = idx & 63, nt = (idx >> 6) & 3, sx = (idx >> 8) & 1, jt = idx >> 9; const int hh = ln >> 5, n = ln & 31;
        float v[8];
#pragma unroll
        for (int jj = 0; jj < 8; ++jj) v[jj] = Fm[(32 * jt + 16 * sx + 8 * (jj >> 2) + 4 * hh + (jj & 3)) * 128 + 32 * nt + n];
        u32x4 w; w.x = cvt_pk_bf16(v[0], v[1]); w.y = cvt_pk_bf16(v[2], v[3]); w.z = cvt_pk_bf16(v[4], v[5]); w.w = cvt_pk_bf16(v[6], v[7]);
        *(u32x4*)(WMF + ((size_t)((((g * 2 + rip) * 4 + jt) * 2 + sx) * 4 + nt) * 64 + ln) * 8) = w; }
    __syncthreads();
}
DI void p0_cf(const Frame& F) {
    bf16_t* CF = (bf16_t*)(F.ws + WS_CF);
    for (int i = 0; i < 4; ++i) { const int idx = F.tid + 512 * i; const int ln = idx & 63, ks = (idx >> 6) & 7, rip = (idx >> 9) & 1, pt = idx >> 10; const int hh = ln >> 5, p = 32 * pt + (ln & 31);
        float v[8];
#pragma unroll
        for (int jj = 0; jj < 8; ++jj) { const int k2 = 16 * ks + 8 * hh + jj, ri = k2 >> 6, c = k2 & 63; const float rev = (float)((c * p) & 63) * (1.0f / 64.0f);
            const float cs = __builtin_amdgcn_cosf(rev), sn = __builtin_amdgcn_sinf(rev); v[jj] = rip == 0 ? (ri == 0 ? cs : sn) : (ri == 0 ? -sn : cs); }
        u32x4 w; w.x = cvt_pk_bf16(v[0], v[1]); w.y = cvt_pk_bf16(v[2], v[3]); w.z = cvt_pk_bf16(v[4], v[5]); w.w = cvt_pk_bf16(v[6], v[7]);
        *(u32x4*)(CF + (size_t)idx * 8) = w; }
}
DI void p0_rgw(const Frame& F, int it) {
    const int type = it >> 4, d = (it >> 3) & 1, h = it & 7;
    const float* src = (type ? F.in[I_RGWX] : F.in[I_RGWA]) + (size_t)(d * 8 + h) * 4096;
    bf16_t* dst = (bf16_t*)(F.ws + WS_RGW) + (size_t)((d * 2 + type) * 8 + h) * 4096;
    for (int i = F.tid; i < 4096; i += 512) { const int j = i >> 6, ii = i & 63; dst[i] = f2bf(src[ii * 64 + j]); }
}
DI void p0_tr_fp8(const float* src, int ldn, int k0, int n0, unsigned char* dst, int dbase, bool gu, int lane) {
    const float* sp = src + (size_t)k0 * ldn + n0 + 4 * lane;
    f32x4 v[32];
#pragma unroll
    for (int i = 0; i < 32; ++i) v[i] = *(const f32x4*)(sp + (size_t)i * ldn);
#pragma unroll
    for (int c = 0; c < 4; ++c) { const int n = n0 + 4 * lane + c; const int jn = n & 1023; const int drow = dbase + (gu ? 256 * (jn >> 7) + 128 * (n >> 10) + (jn & 127) : n);
        unsigned char* dp = dst + (size_t)drow * 1024 + k0;
#pragma unroll
        for (int h = 0; h < 2; ++h) { u32x4 w;
            w.x = cvt_pk_fp8x4(32.f * v[16 * h + 0][c], 32.f * v[16 * h + 1][c], 32.f * v[16 * h + 2][c], 32.f * v[16 * h + 3][c]); w.y = cvt_pk_fp8x4(32.f * v[16 * h + 4][c], 32.f * v[16 * h + 5][c], 32.f * v[16 * h + 6][c], 32.f * v[16 * h + 7][c]);
            w.z = cvt_pk_fp8x4(32.f * v[16 * h + 8][c], 32.f * v[16 * h + 9][c], 32.f * v[16 * h + 10][c], 32.f * v[16 * h + 11][c]); w.w = cvt_pk_fp8x4(32.f * v[16 * h + 12][c], 32.f * v[16 * h + 13][c], 32.f * v[16 * h + 14][c], 32.f * v[16 * h + 15][c]);
            *(u32x4*)(dp + h * 16) = w; } }
}
DI void p0_tr_bf16(const float* src, int ldn, int k0, int n0, bf16_t* dst, int lane) {
    const float* sp = src + (size_t)k0 * ldn + n0 + 4 * lane;
    f32x4 v[32];
#pragma unroll
    for (int i = 0; i < 32; ++i) v[i] = *(const f32x4*)(sp + (size_t)i * ldn);
#pragma unroll
    for (int c = 0; c < 4; ++c) { bf16_t* dp = dst + (size_t)(n0 + 4 * lane + c) * 1024 + k0;
#pragma unroll
        for (int h = 0; h < 4; ++h) { u32x4 w; w.x = cvt_pk_bf16(v[8 * h][c], v[8 * h + 1][c]); w.y = cvt_pk_bf16(v[8 * h + 2][c], v[8 * h + 3][c]); w.z = cvt_pk_bf16(v[8 * h + 4][c], v[8 * h + 5][c]); w.w = cvt_pk_bf16(v[8 * h + 6][c], v[8 * h + 7][c]);
            *(u32x4*)(dp + h * 8) = w; } }
}
constexpr int WT_WIN = 6 * 32, WT_WOUT = 4 * 32, WT_WGU = 32 * 8 * 32, WT_WD = 32 * 4 * 32, WT_END = WT_WIN + WT_WOUT + WT_WGU + WT_WD;
constexpr int CW_Q0 = 512, CW_Q1 = 576;
DI void phase0(const Frame& F) {
    unsigned* ctl = (unsigned*)(F.ws + WS_CTL);
    volatile LAS int* bq = (volatile LAS int*)(F.lds + MISC_OFF + 64);
    for (;;) {
        __syncthreads();
        if (F.tid == 0) bq[0] = (int)__hip_atomic_fetch_add(ctl + CW_Q0, 1u, __ATOMIC_RELAXED, __HIP_MEMORY_SCOPE_AGENT);
        __syncthreads();
        const int q = bq[0]; if (q >= IT_TR) break;
        if (q < 8) p0_wmf(F, q);
        else if (q < 32) p0_adaln(F, q - 8);
        else if (q < 33) p0_cf(F);
        else p0_rgw(F, q - 33);
    }
#pragma unroll 1
    for (int rnd = 0;; ++rnd) {
        if ((rnd & 1) == 0) { __syncthreads(); if (F.tid == 0) bq[0] = (int)__hip_atomic_fetch_add(ctl + CW_Q1, 16u, __ATOMIC_RELAXED, __HIP_MEMORY_SCOPE_AGENT); __syncthreads(); }
        const int wi = bq[0] + 8 * (rnd & 1) + F.wave; if (bq[0] >= WT_END) break;
        if (wi >= WT_END) continue;
        int j = wi;
        if (j < WT_WGU) { const int e = j >> 8, kb = (j >> 3) & 31, nb = j & 7;
            p0_tr_fp8(F.in[I_WGU] + (size_t)e * 1024 * 2048, 2048, kb * 32, nb * 256, (unsigned char*)(F.ws + WS_WGU), e * 2048, true, F.lane); }
        else if ((j -= WT_WGU) < WT_WD) { const int e = j >> 7, kb = (j >> 2) & 31, nb = j & 3;
            p0_tr_fp8(F.in[I_WD] + (size_t)e * 1024 * 1024, 1024, kb * 32, nb * 256, (unsigned char*)(F.ws + WS_WDOWN), e * 1024, false, F.lane); }
        else if ((j -= WT_WD) < WT_WIN) { const int kb = j / 6, nb = j % 6; p0_tr_bf16(F.in[I_WIN], 1536, kb * 32, nb * 256, (bf16_t*)(F.ws + WS_WIN), F.lane); }
        else { j -= WT_WIN; const int kb = j >> 2, nb = j & 3; p0_tr_bf16(F.in[I_WOUT], 1024, kb * 32, nb * 256, (bf16_t*)(F.ws + WS_WOUT), F.lane); }
    }
}

template <int NR> DI void norm_rows(const float* xr, const float* g, const float* modb, bf16_t* hrow, int lane) {
    f32x4 v[NR][4]; float ss[NR];
#pragma unroll
    for (int r = 0; r < NR; ++r)
#pragma unroll
        for (int q = 0; q < 4; ++q) v[r][q] = *(const f32x4*)(xr + (size_t)r * D + 4 * lane + 256 * q);
#pragma unroll
    for (int r = 0; r < NR; ++r) { float a = 0.f;
#pragma unroll
        for (int q = 0; q < 4; ++q) a += v[r][q][0] * v[r][q][0] + v[r][q][1] * v[r][q][1] + v[r][q][2] * v[r][q][2] + v[r][q][3] * v[r][q][3];
        ss[r] = rsqrtf(wave_sum(a) * (1.0f / 1024.0f) + EPS); }
#pragma unroll
    for (int q = 0; q < 4; ++q) { const int k = 4 * lane + 256 * q;
        const f32x4 gg = *(const f32x4*)(g + k), sh = *(const f32x4*)(modb + k), sc = *(const f32x4*)(modb + 1024 + k); const f32x4 gm = gg * (1.0f + sc);
#pragma unroll
        for (int r = 0; r < NR; ++r) { const f32x4 y = v[r][q] * ss[r] * gm + sh;
            u32x2 w; w.x = cvt_pk_bf16(y[0], y[1]); w.y = cvt_pk_bf16(y[2], y[3]);
            *(u32x2*)(hrow + (size_t)r * D + k) = w; } }
}
struct SchedOne { int pm, pn; bool used;
    DI bool next(int i, pg8::Unit& u) const { if (i > 0) return false; u.pm = pm; u.pn = pn; u.aux = 0; u.ix = 0; return true; }
    DI void a_off(const pg8::Unit& u, const int (&R)[2], const int (&C)[2], int K, unsigned (&o)[2][2]) const {
#pragma unroll
        for (int h = 0; h < 2; ++h)
#pragma unroll
            for (int i = 0; i < 2; ++i) o[h][i] = (unsigned)((u.pm * 256 + h * 128 + R[i]) * K + C[i]) * 2u; }
    DI size_t b_off(const pg8::Unit& u, int K) const { return (size_t)u.pn * 256 * K * 2; }
};
DI void phase1(const Frame& F) {
    const float* x = F.in[I_X]; const float* ctx = F.in[I_CTX]; const float* g = F.in[I_GMIX]; const float* mod = (const float*)(F.ws + WS_MOD);
    bf16_t* H = (bf16_t*)(F.ws + WS_H);
    if (F.blk < 16 && F.G > 16) {
        const int mt = F.blk >> 1;
#pragma unroll 1
        for (int i = 0; i < 4; ++i) { const int rr = 256 * mt + 32 * F.wave + 8 * i; norm_rows<8>(ctx + (size_t)rr * D, g, mod + 8 * 6144, H + (size_t)(T + rr) * D, F.lane); }
        asm volatile("s_waitcnt vmcnt(0)" ::: "memory"); __syncthreads();
        pg8::Gemm gg{(const bf16_t*)(F.ws + WS_H), (const bf16_t*)(F.ws + WS_WIN), 1024};
        SchedOne S{T / 256 + mt, 2 + (F.blk & 1), true}; pg8::EpiBf16Plain E{(bf16_t*)(F.ws + WS_XP), 1536};
        pg8::gemm_phase(F.lds, gg, S, E);
    } else {
        const int nb = F.G > 16 ? F.G - 16 : F.G, bb = F.G > 16 ? F.blk - 16 : F.blk;
#pragma unroll 1
        for (int it = 0;; ++it) {
            const int row = ((it * nb + bb) * 8 + F.wave) * 4; if (row >= T) break;
            norm_rows<4>(x + (size_t)row * D, g, mod + (row >> 12) * 6144, H + (size_t)row * D, F.lane);
        }
        if (F.G <= 16) {
            for (int row = F.blk * 8 + F.wave; row < TC; row += F.G * 8) norm_rows<1>(ctx + (size_t)row * D, g, mod + 8 * 6144, H + (size_t)(T + row) * D, F.lane);
        }
    }
}

DI int serp_tok(int b, int P) { const int rr = P >> 6, cc = P & 63; return b * SEQ + (rr << 6) + ((rr & 1) ? 63 - cc : cc); }
DI void rg_unit(const Frame& F, int u) {
    LAS unsigned char* xcl = F.lds;
    const bf16_t* XR = (const bf16_t*)(F.ws + WS_XP) + 512; const bf16_t* RGW = (const bf16_t*)(F.ws + WS_RGW);
    const float* convw = F.in[I_CONVW]; const float* convb = F.in[I_CONVB];
    float* sumP = (float*)(F.ws + WS_SUMP); float* sumH = (float*)(F.ws + WS_SUMH);
    bf16_t* SSb = (bf16_t*)(F.ws + WS_SS); bf16_t* CAF = (bf16_t*)(F.ws + WS_CAF); bf16_t* CAB = (bf16_t*)(F.ws + WS_CAB);
    int tid = F.tid; asm volatile("" : "+v"(tid));
    const int lane = tid & 63, hh = F.wave, hf = lane >> 5;
    {
        const bool lat = u < 512; const int b = lat ? (u >> 6) : ((u - 512) >> 2), r = lat ? (u & 63) : ((u - 512) & 3); const int L = lat ? SEQ : CTXL;
        {
            const int cg = tid & 63; float w[4][8], bs[8];
#pragma unroll
            for (int k = 0; k < 4; ++k) { const f32x4 a = *(const f32x4*)(convw + k * 512 + 8 * cg), c2 = *(const f32x4*)(convw + k * 512 + 8 * cg + 4);
                w[k][0] = a[0]; w[k][1] = a[1]; w[k][2] = a[2]; w[k][3] = a[3]; w[k][4] = c2[0]; w[k][5] = c2[1]; w[k][6] = c2[2]; w[k][7] = c2[3]; }
            { const f32x4 a = *(const f32x4*)(convb + 8 * cg), c2 = *(const f32x4*)(convb + 8 * cg + 4); bs[0] = a[0]; bs[1] = a[1]; bs[2] = a[2]; bs[3] = a[3]; bs[4] = c2[0]; bs[5] = c2[1]; bs[6] = c2[2]; bs[7] = c2[3]; }
#pragma unroll
            for (int i = 0; i < 8; ++i) { const int p = (tid >> 6) + 8 * i; float a[8];
#pragma unroll
                for (int j = 0; j < 8; ++j) a[j] = bs[j];
#pragma unroll
                for (int k = 0; k < 4; ++k) { const int P = 64 * r + p + k - 2;
                    if (P >= 0 && P < L) { const int tk = lat ? serp_tok(b, P) : T + b * CTXL + P; const u32x4 xv = *(const u32x4*)(XR + (size_t)tk * 1536 + 8 * cg);
#pragma unroll
                        for (int j = 0; j < 4; ++j) { a[2 * j] += w[k][2 * j] * bflo(xv[j]); a[2 * j + 1] += w[k][2 * j + 1] * bfhi(xv[j]); } } }
                u32x4 o; o.x = cvt_pk_bf16(a[0], a[1]); o.y = cvt_pk_bf16(a[2], a[3]); o.z = cvt_pk_bf16(a[4], a[5]); o.w = cvt_pk_bf16(a[6], a[7]);
                *(LAS u32x4*)(xcl + p * 1040 + cg * 16) = o; }
        }
        __syncthreads();
        const int cidx = lat ? 4 + r : r; const int tokbase = b * SEQ + 64 * r;
#pragma unroll 1
        for (int nt = 0; nt < 2; ++nt) {
            const int chl = 32 * nt + (lane & 31), ch = 64 * hh + chl;
            unsigned hlp[2][8];
#pragma unroll
            for (int d = 0; d < 2; ++d) {
                f32x16 ar[2], ai[2];
#pragma unroll
                for (int t = 0; t < 2; ++t)
#pragma unroll
                    for (int i = 0; i < 16; ++i) { ar[t][i] = 0.f; ai[t][i] = 0.f; }
                const bf16_t* wr_ = RGW + (size_t)(((d * 2 + 0) * 8 + hh) * 64 + chl) * 64; const bf16_t* wi_ = RGW + (size_t)(((d * 2 + 1) * 8 + hh) * 64 + chl) * 64;
#pragma unroll
                for (int ks = 0; ks < 4; ++ks) {
                    const bf16x8 br = *(const bf16x8*)(wr_ + 16 * ks + 8 * hf), bi = *(const bf16x8*)(wi_ + 16 * ks + 8 * hf);
#pragma unroll
                    for (int t = 0; t < 2; ++t) { const int m = lane & 31; const int pos = 32 * ((m >> 2) & 1) + 16 * t + 4 * (m >> 3) + (m & 3);
                        const bf16x8 a = *(const LAS bf16x8*)(xcl + pos * 1040 + (64 * hh + 16 * ks + 8 * hf) * 2);
                        ar[t] = __builtin_amdgcn_mfma_f32_32x32x16_bf16(a, br, ar[t], 0, 0, 0); ai[t] = __builtin_amdgcn_mfma_f32_32x32x16_bf16(a, bi, ai[t], 0, 0, 0); }
                }
                const float ba = F.in[I_RGBA][d * 512 + ch], bx = F.in[I_RGBX][d * 512 + ch], lam = F.in[I_LAM][d * 512 + ch];
                const float nl = -lam; const float sp8 = 8.0f * (fmaxf(nl, 0.f) + log1pf(expf(-fabsf(nl))));
#pragma unroll
                for (int t = 0; t < 2; ++t)
#pragma unroll
                    for (int i = 0; i < 16; ++i) { const int p = 32 * hf + 16 * t + i;
                        const float rr = sigmoidf_(ar[t][i] + ba), ii = sigmoidf_(ai[t][i] + bx); const float a = __expf(-sp8 * rr);
                        const float xcv = bf2f(*(const LAS bf16_t*)(xcl + p * 1040 + ch * 2));
                        ar[t][i] = a; ai[t][i] = __builtin_amdgcn_sqrtf(fmaxf(1.0f - a * a, 0.f)) * ii * xcv; }
                float hl = 0.f, ca = 1.f;
                if (d == 0) {
#pragma unroll
                    for (int t = 0; t < 2; ++t)
#pragma unroll
                        for (int i = 0; i < 16; ++i) { const float a = ar[t][i]; hl = a * hl + ai[t][i]; ca *= a; ai[t][i] = hl; ar[t][i] = ca; }
                    const float P0 = __shfl(ca, lane & 31), H0 = __shfl(hl, lane & 31);
                    if (hf == 1) {
#pragma unroll
                        for (int t = 0; t < 2; ++t)
#pragma unroll
                            for (int i = 0; i < 16; ++i) { ai[t][i] += ar[t][i] * H0; ar[t][i] *= P0; }
                        sumP[(size_t)((b * 2 + 0) * NCH + cidx) * 512 + ch] = ar[1][15]; sumH[(size_t)((b * 2 + 0) * NCH + cidx) * 512 + ch] = ai[1][15];
                    }
#pragma unroll
                    for (int t = 0; t < 2; ++t)
#pragma unroll
                        for (int i = 0; i < 8; ++i) hlp[t][i] = cvt_pk_bf16(ai[t][2 * i], ai[t][2 * i + 1]);
                    if (lat) {
                        const int p0 = 32 * hf; bf16_t* pc = CAF + (size_t)(tokbase + ((r & 1) ? 63 - p0 : p0)) * 512 + ch; const long stride = (r & 1) ? -512 : 512;
#pragma unroll
                        for (int t = 0; t < 2; ++t)
#pragma unroll
                            for (int i = 0; i < 16; ++i) { *pc = f2bf(ar[t][i]); pc += stride; asm volatile("" : "+v"(pc)); }
                    }
                } else {
#pragma unroll
                    for (int t = 1; t >= 0; --t)
#pragma unroll
                        for (int i = 15; i >= 0; --i) { const float a = ar[t][i]; hl = a * hl + ai[t][i]; ca *= a; ai[t][i] = hl; ar[t][i] = ca; }
                    const float P1 = __shfl(ca, (lane & 31) + 32), H1 = __shfl(hl, (lane & 31) + 32);
                    if (hf == 0) {
#pragma unroll
                        for (int t = 0; t < 2; ++t)
#pragma unroll
                            for (int i = 0; i < 16; ++i) { ai[t][i] += ar[t][i] * H1; ar[t][i] *= P1; }
                        sumP[(size_t)((b * 2 + 1) * NCH + cidx) * 512 + ch] = ar[0][0]; sumH[(size_t)((b * 2 + 1) * NCH + cidx) * 512 + ch] = ai[0][0];
                    }
                    if (lat) {
                        const int p0 = 32 * hf; const size_t o0 = (size_t)(tokbase + ((r & 1) ? 63 - p0 : p0)) * 512 + ch; bf16_t* pc = CAB + o0; bf16_t* ps = SSb + o0; const long stride = (r & 1) ? -512 : 512;
#pragma unroll
                        for (int t = 0; t < 2; ++t)
#pragma unroll
                            for (int i = 0; i < 16; ++i) { *pc = f2bf(ar[t][i]); *ps = f2bf(((i & 1) ? bfhi(hlp[t][i >> 1]) : bflo(hlp[t][i >> 1])) + ai[t][i]); pc += stride; ps += stride; asm volatile("" : "+v"(pc), "+v"(ps)); }
                    }
                }
            }
        }
        __syncthreads();
    }
}

typedef short s16x4 __attribute__((ext_vector_type(4)));
DI unsigned pk_bf16c(float a, float b) { typedef float f2_ __attribute__((ext_vector_type(2))); typedef __bf16 b2_ __attribute__((ext_vector_type(2))); const b2_ r = __builtin_convertvector((f2_){a, b}, b2_); return __builtin_bit_cast(unsigned, r); }
DI unsigned img_off(int row, int ch) { return 256u * row + 16u * (ch ^ (((row & 3) << 2) | ((row >> 2) & 3))); }
DI unsigned tr_addr(int lane, int cc, int t) { const int h = lane >> 5, blk = (lane >> 4) & 1, q4 = (lane & 15) >> 2, p = lane & 3; return img_off(8 * h + 4 * t + q4, 4 * cc + 2 * blk + (p >> 1)) + 8u * (p & 1); }

constexpr int FFTA_OFF = 81920;
DI void fftR_table(const Frame& F) {
#pragma unroll 1
    for (int i = 0; i < 2; ++i) { const int idx = F.tid + 512 * i; const int ln = idx & 63, ks = (idx >> 6) & 3, mt = idx >> 8; const int h = ln >> 5, m = ln & 31;
        float v[8];
#pragma unroll
        for (int jj = 0; jj < 8; ++jj) { const int r = 16 * ks + 8 * h + jj, q = 32 * (mt & 1) + m; const float rev = (float)((r * q) & 63) * (1.0f / 64.0f); v[jj] = mt < 2 ? __builtin_amdgcn_cosf(rev) : -__builtin_amdgcn_sinf(rev); }
        u32x4 w; w.x = pk_bf16c(v[0], v[1]); w.y = pk_bf16c(v[2], v[3]); w.z = pk_bf16c(v[4], v[5]); w.w = pk_bf16c(v[6], v[7]);
        *(LAS u32x4*)(F.lds + FFTA_OFF + idx * 16) = w; }
}
DI void fftR_unit(const Frame& F, int u) {
    int lane = F.lane; asm volatile("" : "+v"(lane));
    const int h = lane >> 5, m = lane & 31;
    const bf16_t* XP = (const bf16_t*)(F.ws + WS_XP); bf16_t* ZG = (bf16_t*)(F.ws + WS_ZG);
    const unsigned ldsb = (unsigned)(__SIZE_TYPE__)F.lds;
    {
        const int b = u >> 6, c = u & 63;
        __syncthreads();
#pragma unroll
        for (int i = 0; i < 8; ++i) { const int idx = F.tid + 512 * i; const int r = idx >> 6, ch8 = idx & 63;
            const u32x4 v = *(const u32x4*)(XP + (size_t)(b * SEQ + 64 * r + c) * 1536 + 8 * ch8);
            *(LAS u32x4*)(F.lds + (ch8 >> 4) * 16384 + img_off(r, ch8 & 15)) = v; }
        __syncthreads();
#pragma unroll 1
        for (int nn = 0; nn < 2; ++nn) {
            const int nt = F.wave * 2 + nn, slab = nt >> 2, cc = nt & 3;
            const unsigned a0 = ldsb + slab * 16384 + tr_addr(lane, cc, 0), a1 = ldsb + slab * 16384 + tr_addr(lane, cc, 1);
            s16x4 lo[4], hi[4];
            asm volatile("ds_read_b64_tr_b16 %0, %8\n\tds_read_b64_tr_b16 %1, %9\n\tds_read_b64_tr_b16 %2, %8 offset:4096\n\tds_read_b64_tr_b16 %3, %9 offset:4096\n\t"
                         "ds_read_b64_tr_b16 %4, %8 offset:8192\n\tds_read_b64_tr_b16 %5, %9 offset:8192\n\tds_read_b64_tr_b16 %6, %8 offset:12288\n\tds_read_b64_tr_b16 %7, %9 offset:12288\n\ts_waitcnt lgkmcnt(0)"
                         : "=&v"(lo[0]), "=&v"(hi[0]), "=&v"(lo[1]), "=&v"(hi[1]), "=&v"(lo[2]), "=&v"(hi[2]), "=&v"(lo[3]), "=&v"(hi[3]) : "v"(a0), "v"(a1) : "memory");
            f32x16 acc[4];
#pragma unroll
            for (int mt = 0; mt < 4; ++mt)
#pragma unroll
                for (int i = 0; i < 16; ++i) acc[mt][i] = 0.f;
#pragma unroll
            for (int ks = 0; ks < 4; ++ks) { const bf16x8 Bf = __builtin_shufflevector(lo[ks], hi[ks], 0, 1, 2, 3, 4, 5, 6, 7);
#pragma unroll
                for (int mt = 0; mt < 4; ++mt) { const bf16x8 Af = *(const LAS bf16x8*)(F.lds + FFTA_OFF + ((mt * 4 + ks) * 64 + lane) * 16); acc[mt] = __builtin_amdgcn_mfma_f32_32x32x16_bf16(Af, Bf, acc[mt], 0, 0, 0); } }
            const int ch = 32 * nt + m;
#pragma unroll
            for (int qh = 0; qh < 2; ++qh) {
                bf16_t* pz = ZG + ((size_t)((b * 64 + 32 * qh + 4 * h) * 2) * 64 + c) * 512 + ch;
#pragma unroll
                for (int i = 0; i < 16; ++i) { const int q = 32 * qh + (i & 3) + 8 * (i >> 2) + 4 * h;
                    const float rev = (float)((c * q) & 4095) * (1.0f / 4096.0f); const float cw = __builtin_amdgcn_cosf(rev), sw = __builtin_amdgcn_sinf(rev);
                    const float yr = acc[qh][i], yi = acc[2 + qh][i];
                    pz[0] = (bf16_t)(pk_bf16c(yr * cw + yi * sw, 0.f) & 0xffffu); pz[64 * 512] = (bf16_t)(pk_bf16c(yi * cw - yr * sw, 0.f) & 0xffffu);
                    pz += ((i & 3) == 3 ? 5 : 1) * (2 * 64 * 512); asm volatile("" : "+v"(pz)); }
            }
        }
    }
}
constexpr int CW_Q3 = 640;
DI void phase3(const Frame& F) {
    unsigned* ctl = (unsigned*)(F.ws + WS_CTL);
    volatile LAS int* bq = (volatile LAS int*)(F.lds + MISC_OFF + 64);
    fftR_table(F);
    int cur = F.blk;
    while (cur < 544 + 512) {
        int nxt = 0; if (F.tid == 0) nxt = F.G + (int)__hip_atomic_fetch_add(ctl + CW_Q3, 1u, __ATOMIC_RELAXED, __HIP_MEMORY_SCOPE_AGENT);
        if (cur < 544) rg_unit(F, cur); else fftR_unit(F, cur - 544);
        __syncthreads(); if (F.tid == 0) bq[0] = nxt; __syncthreads(); cur = bq[0];
    }
    __syncthreads();
}

constexpr int FRED_OFF = 131072;
DI void fftC_unit(const Frame& F, int u) {
    int lane = F.lane; asm volatile("" : "+v"(lane));
    const int h = lane >> 5, m = lane & 31, g = F.wave >> 1, pt = F.wave & 1;
    const unsigned ldsb = (unsigned)(__SIZE_TYPE__)F.lds + g * 32768;
    unsigned ta[4][2];
#pragma unroll
    for (int jt = 0; jt < 4; ++jt) { ta[jt][0] = ldsb + tr_addr(lane, jt, 0); ta[jt][1] = ldsb + tr_addr(lane, jt, 1); }
    const bf16_t* ZG = (const bf16_t*)(F.ws + WS_ZG); const bf16_t* CF = (const bf16_t*)(F.ws + WS_CF); const bf16_t* WMF = (const bf16_t*)(F.ws + WS_WMF); bf16_t* CAT = (bf16_t*)(F.ws + WS_CAT);
    LAS float* fred = (LAS float*)(F.lds + FRED_OFF);
    {
        const int b = u >> 6, q = u & 63;
        __syncthreads();
        const bf16_t* zsrc = ZG + (size_t)(b * 64 + q) * 2 * 64 * 512;
#pragma unroll
        for (int i = 0; i < 16; ++i) { const int idx = F.tid + 512 * i; const int k2 = idx >> 6, ch8 = idx & 63;
            const u32x4 v = *(const u32x4*)(zsrc + (size_t)k2 * 512 + 8 * ch8);
            *(LAS u32x4*)(F.lds + (ch8 >> 4) * 32768 + img_off(k2, ch8 & 15)) = v; }
        __syncthreads();
        f32x16 out[4];
#pragma unroll
        for (int n = 0; n < 4; ++n)
#pragma unroll
            for (int i = 0; i < 16; ++i) out[n][i] = 0.f;
#pragma unroll 1
        for (int rj = 0; rj < 4; ++rj) {
            const int rip = rj >> 1, jp = rj & 1;
            f32x16 xt[2];
#pragma unroll
            for (int jt = 0; jt < 2; ++jt)
#pragma unroll
                for (int i = 0; i < 16; ++i) xt[jt][i] = 0.f;
            const unsigned t00 = ta[0][0], t01 = ta[0][1], t10 = ta[1][0], t11 = ta[1][1], t20 = ta[2][0], t21 = ta[2][1], t30 = ta[3][0], t31 = ta[3][1];
            const unsigned a0 = jp ? t20 : t00, a1 = jp ? t21 : t01, a2 = jp ? t30 : t10, a3 = jp ? t31 : t11;
#pragma unroll 2
            for (int ks = 0; ks < 8; ++ks) {
                const bf16x8 Bc = *(const bf16x8*)(CF + ((size_t)((pt * 2 + rip) * 8 + ks) * 64 + lane) * 8);
                s16x4 lo[2], hi[2]; const unsigned ko = 4096u * ks;
                asm volatile("ds_read_b64_tr_b16 %0, %4\n\tds_read_b64_tr_b16 %1, %5\n\tds_read_b64_tr_b16 %2, %6\n\tds_read_b64_tr_b16 %3, %7\n\ts_waitcnt lgkmcnt(0)"
                             : "=&v"(lo[0]), "=&v"(hi[0]), "=&v"(lo[1]), "=&v"(hi[1]) : "v"(a0 + ko), "v"(a1 + ko), "v"(a2 + ko), "v"(a3 + ko) : "memory");
#pragma unroll
                for (int jt = 0; jt < 2; ++jt) { const bf16x8 Af = __builtin_shufflevector(lo[jt], hi[jt], 0, 1, 2, 3, 4, 5, 6, 7); xt[jt] = __builtin_amdgcn_mfma_f32_32x32x16_bf16(Af, Bc, xt[jt], 0, 0, 0); }
            }
#pragma unroll
            for (int jt = 0; jt < 2; ++jt)
#pragma unroll
                for (int sx = 0; sx < 2; ++sx) {
                    u32x4 w; w.x = pk_bf16c(xt[jt][8 * sx + 0], xt[jt][8 * sx + 1]); w.y = pk_bf16c(xt[jt][8 * sx + 2], xt[jt][8 * sx + 3]); w.z = pk_bf16c(xt[jt][8 * sx + 4], xt[jt][8 * sx + 5]); w.w = pk_bf16c(xt[jt][8 * sx + 6], xt[jt][8 * sx + 7]);
                    const bf16x8 Af = __builtin_bit_cast(bf16x8, w);
                    const bf16_t* wp = WMF + ((size_t)((((g * 2 + rip) * 4 + 2 * jp + jt) * 2 + sx) * 4) * 64 + lane) * 8;
#pragma unroll
                    for (int n = 0; n < 4; ++n) { const bf16x8 Bw = *(const bf16x8*)(wp + (size_t)n * 64 * 8); out[n] = __builtin_amdgcn_mfma_f32_32x32x16_bf16(Af, Bw, out[n], 0, 0, 0); }
                    asm volatile("" ::: "memory");
                }
        }
#pragma unroll
        for (int i = 0; i < 16; ++i) { float a = out[0][i] * out[0][i] + out[1][i] * out[1][i] + out[2][i] * out[2][i] + out[3][i] * out[3][i];
            a += __shfl_xor(a, 1); a += __shfl_xor(a, 2); a += __shfl_xor(a, 4); a += __shfl_xor(a, 8); a += __shfl_xor(a, 16);
            if (m == 0) fred[g * 64 + 32 * pt + (i & 3) + 8 * (i >> 2) + 4 * h] = a;
            asm volatile("" ::: "memory"); }
        __syncthreads();
        float gsc[4];
#pragma unroll
        for (int n = 0; n < 4; ++n) gsc[n] = F.in[I_GOF][128 * g + 32 * n + m];
        bf16_t* pf = CAT + ((size_t)(b * SEQ + 64 * (32 * pt + 4 * h) + q)) * 1024 + 128 * g + m;
#pragma unroll
        for (int i = 0; i < 16; ++i) { const int p = 32 * pt + (i & 3) + 8 * (i >> 2) + 4 * h;
            const float tot = (fred[p] + fred[64 + p]) + (fred[128 + p] + fred[192 + p]); const float rs = rsqrtf(tot * (1.0f / 512.0f) + EPS);
#pragma unroll
            for (int n = 0; n < 4; ++n) pf[32 * n] = (bf16_t)(pk_bf16c(out[n][i] * rs * gsc[n], 0.f) & 0xffffu);
            pf += ((i & 3) == 3 ? 5 : 1) * (64 * 1024); asm volatile("" : "+v"(pf) :: "memory"); }
    }
}

DI void catrg_unit(const Frame& F, int u) {
    LAS float* cinf = (LAS float*)F.lds; LAS float* cinb = cinf + 4 * 512;
    const float* sumP = (const float*)(F.ws + WS_SUMP); const float* sumH = (const float*)(F.ws + WS_SUMH);
    const bf16_t* SSb = (const bf16_t*)(F.ws + WS_SS); const bf16_t* CAF = (const bf16_t*)(F.ws + WS_CAF); const bf16_t* CAB = (const bf16_t*)(F.ws + WS_CAB);
    const bf16_t* GR = (const bf16_t*)(F.ws + WS_XP) + 1024; bf16_t* CAT = (bf16_t*)(F.ws + WS_CAT);
    const float* gor = F.in[I_GOR];
    {
        const int b = u >> 4, r0 = (u & 15) * 4;
        __syncthreads();
        { const int t = F.tid; float hfw = 0.f, hbw = 0.f;
          const float* pf = sumP + (size_t)((b * 2 + 0) * NCH) * 512 + t; const float* qf = sumH + (size_t)((b * 2 + 0) * NCH) * 512 + t;
#pragma unroll 8
          for (int c = 0; c < 4 + r0; ++c) hfw = pf[c * 512] * hfw + qf[c * 512];
          cinf[t] = hfw;
#pragma unroll
          for (int k = 1; k < 4; ++k) { hfw = pf[(3 + r0 + k) * 512] * hfw + qf[(3 + r0 + k) * 512]; cinf[k * 512 + t] = hfw; }
          const float* pb = sumP + (size_t)((b * 2 + 1) * NCH) * 512 + t; const float* qb = sumH + (size_t)((b * 2 + 1) * NCH) * 512 + t;
          for (int c = 3; c >= 0; --c) hbw = pb[c * 512] * hbw + qb[c * 512];
#pragma unroll 8
          for (int c = NCH - 1; c > 4 + r0 + 3; --c) hbw = pb[c * 512] * hbw + qb[c * 512];
          cinb[3 * 512 + t] = hbw;
#pragma unroll
          for (int k = 2; k >= 0; --k) { hbw = pb[(4 + r0 + k + 1) * 512] * hbw + qb[(4 + r0 + k + 1) * 512]; cinb[k * 512 + t] = hbw; }
        }
        __syncthreads();
        float gr_[8];
#pragma unroll
        for (int j = 0; j < 8; ++j) gr_[j] = gor[8 * F.lane + j];
#pragma unroll 1
        for (int k = 0; k < 4; ++k) {
            float cf[8], cb[8];
#pragma unroll
            for (int j = 0; j < 8; ++j) { cf[j] = cinf[k * 512 + 8 * F.lane + j]; cb[j] = cinb[k * 512 + 8 * F.lane + j]; }
#pragma unroll 2
            for (int i = 0; i < 8; ++i) {
                const int tk = b * SEQ + 64 * (r0 + k) + F.wave * 8 + i;
                const u32x4 s4 = *(const u32x4*)(SSb + (size_t)tk * 512 + 8 * F.lane), a4 = *(const u32x4*)(CAF + (size_t)tk * 512 + 8 * F.lane), b4 = *(const u32x4*)(CAB + (size_t)tk * 512 + 8 * F.lane);
                const u32x4 g4 = *(const u32x4*)(GR + (size_t)tk * 1536 + 8 * F.lane);
                float rg[8]; float sr = 0.f;
#pragma unroll
                for (int j = 0; j < 4; ++j) {
                    const float y0 = bflo(s4[j]) + bflo(a4[j]) * cf[2 * j] + bflo(b4[j]) * cb[2 * j], y1 = bfhi(s4[j]) + bfhi(a4[j]) * cf[2 * j + 1] + bfhi(b4[j]) * cb[2 * j + 1];
                    rg[2 * j] = y0 * gelu_tanh(bflo(g4[j])); rg[2 * j + 1] = y1 * gelu_tanh(bfhi(g4[j]));
                    sr += rg[2 * j] * rg[2 * j] + rg[2 * j + 1] * rg[2 * j + 1]; }
                sr = wave_sum(sr);
                const float rr = rsqrtf(sr * (1.0f / 512.0f) + EPS);
                u32x4 orr;
                orr.x = cvt_pk_bf16(rg[0] * rr * gr_[0], rg[1] * rr * gr_[1]); orr.y = cvt_pk_bf16(rg[2] * rr * gr_[2], rg[3] * rr * gr_[3]); orr.z = cvt_pk_bf16(rg[4] * rr * gr_[4], rg[5] * rr * gr_[5]); orr.w = cvt_pk_bf16(rg[6] * rr * gr_[6], rg[7] * rr * gr_[7]);
                *(u32x4*)(CAT + (size_t)tk * 1024 + 512 + 8 * F.lane) = orr;
            }
        }
    }
}
constexpr int CW_Q4 = 768;
DI void phase4(const Frame& F) {
    unsigned* ctl = (unsigned*)(F.ws + WS_CTL);
    volatile LAS int* bq = (volatile LAS int*)(F.lds + MISC_OFF + 64);
    int cur = F.blk;
    while (cur < 512 + 128) {
        int nxt = 0; if (F.tid == 0) nxt = F.G + (int)__hip_atomic_fetch_add(ctl + CW_Q4, 1u, __ATOMIC_RELAXED, __HIP_MEMORY_SCOPE_AGENT);
        if (cur < 128) catrg_unit(F, cur); else fftC_unit(F, cur - 128);
        __syncthreads(); if (F.tid == 0) bq[0] = nxt; __syncthreads(); cur = bq[0];
    }
    __syncthreads();
}

DI void phase_router(const Frame& F) {
    LAS unsigned char* WTh = F.lds; LAS unsigned char* WTl = F.lds + 65536;
    LAS float* cbl = (LAS float*)(F.lds + 131072);
    LAS int* wcnt = (LAS int*)(F.lds + MISC_OFF + 1024);
    const float* wrt = F.in[I_WR]; const float* brt = F.in[I_BR]; const float* g = F.in[I_GFFN]; const float* mod = (const float*)(F.ws + WS_MOD);
    const float* X = F.in[I_X]; const bf16_t* GM = (const bf16_t*)(F.ws + WS_GMIX); unsigned char* H8 = (unsigned char*)(F.ws + WS_H); bf16_t* X1B = (bf16_t*)(F.ws + WS_CAT);
    int* toke = (int*)(F.ws + WS_TOKE); float* tokg = (float*)(F.ws + WS_TOKG); int* cnt = (int*)(F.ws + WS_CNT);
    if (F.tid < 256) wcnt[F.tid] = 0;
    int bcur = -1;
    for (int it = 0;; ++it) {
        const int row0 = (it * F.G + F.blk) * 128; if (row0 >= T) break;
        const int b = row0 >> 12;
        const float* shp = mod + b * 6144 + 3072; const float* scp = mod + b * 6144 + 4096;
        if (b != bcur) {
            bcur = b; __syncthreads();
#pragma unroll 1
            for (int i0 = 0; i0 < 64; i0 += 16) {
                float wv[16], gv[16];
#pragma unroll
                for (int i = 0; i < 16; ++i) { const int idx = F.tid + 512 * (i0 + i); const int k = idx >> 5; wv[i] = wrt[idx]; gv[i] = g[k] * (1.0f + scp[k]); }
#pragma unroll
                for (int i = 0; i < 16; ++i) { const int idx = F.tid + 512 * (i0 + i); const int e = idx & 31, k = idx >> 5;
                    const float v = gv[i] * wv[i]; const unsigned hi = cvt_pk_bf16(v, 0.f) & 0xffffu; const float lo = v - __uint_as_float(hi << 16);
                    const int kk = k & 31, chn = 4 * (k >> 5) + ((kk & 15) >> 2), jj = (kk & 3) + 4 * (kk >> 4);
                    const int off = e * 2048 + ((chn ^ (e & 15)) << 4) + jj * 2;
                    *(LAS bf16_t*)(WTh + off) = (bf16_t)hi; *(LAS bf16_t*)(WTl + off) = f2bf(lo); }
            }
            { float sacc[4] = {0.f, 0.f, 0.f, 0.f};
#pragma unroll
              for (int i = 0; i < 16; ++i) { const int k = F.lane + 64 * i; const float sv = shp[k]; const f32x4 w4 = *(const f32x4*)(wrt + k * 32 + 4 * F.wave);
                  sacc[0] += sv * w4[0]; sacc[1] += sv * w4[1]; sacc[2] += sv * w4[2]; sacc[3] += sv * w4[3]; }
#pragma unroll
              for (int q = 0; q < 4; ++q) { const float tsum = wave_sum(sacc[q]); if (F.lane == 0) cbl[4 * F.wave + q] = tsum + brt[4 * F.wave + q]; } }
            __syncthreads();
        }
        const int tl = F.lane & 15, kg = F.lane >> 4; const int tok = row0 + 16 * F.wave + tl;
        f32x4 acc0 = (f32x4){0.f, 0.f, 0.f, 0.f}, acc1 = acc0; float ssq = 0.f;
        const float* xp = X + (size_t)tok * D + 4 * kg; const bf16_t* gp = GM + (size_t)tok * D + 4 * kg;
#pragma unroll 8
        for (int ks = 0; ks < 32; ++ks) {
            f32x4 xa = *(const f32x4*)(xp + 32 * ks), xb = *(const f32x4*)(xp + 32 * ks + 16);
            const u32x2 ga = *(const u32x2*)(gp + 32 * ks), gb = *(const u32x2*)(gp + 32 * ks + 16);
            xa[0] += bflo(ga.x); xa[1] += bfhi(ga.x); xa[2] += bflo(ga.y); xa[3] += bfhi(ga.y); xb[0] += bflo(gb.x); xb[1] += bfhi(gb.x); xb[2] += bflo(gb.y); xb[3] += bfhi(gb.y);
            ssq += xa[0] * xa[0] + xa[1] * xa[1] + xa[2] * xa[2] + xa[3] * xa[3] + xb[0] * xb[0] + xb[1] * xb[1] + xb[2] * xb[2] + xb[3] * xb[3];
            u32x4 hv, lv;
            hv.x = cvt_pk_bf16(xa[0], xa[1]); hv.y = cvt_pk_bf16(xa[2], xa[3]); hv.z = cvt_pk_bf16(xb[0], xb[1]); hv.w = cvt_pk_bf16(xb[2], xb[3]);
            lv.x = cvt_pk_bf16(xa[0] - bflo(hv.x), xa[1] - bfhi(hv.x)); lv.y = cvt_pk_bf16(xa[2] - bflo(hv.y), xa[3] - bfhi(hv.y));
            lv.z = cvt_pk_bf16(xb[0] - bflo(hv.z), xb[1] - bfhi(hv.z)); lv.w = cvt_pk_bf16(xb[2] - bflo(hv.w), xb[3] - bfhi(hv.w));
            { bf16_t* xo_ = X1B + (size_t)tok * D + 4 * kg + 32 * ks; u32x2 s0_, s1_; s0_.x = hv.x; s0_.y = hv.y; s1_.x = hv.z; s1_.y = hv.w; *(u32x2*)xo_ = s0_; *(u32x2*)(xo_ + 16) = s1_; }
            const bf16x8 Bh = __builtin_bit_cast(bf16x8, hv), Bl = __builtin_bit_cast(bf16x8, lv);
            const int ch = ((4 * ks + kg) ^ tl) << 4;
            const bf16x8 A0h = *(const LAS bf16x8*)(WTh + tl * 2048 + ch), A0l = *(const LAS bf16x8*)(WTl + tl * 2048 + ch);
            const bf16x8 A1h = *(const LAS bf16x8*)(WTh + (16 + tl) * 2048 + ch), A1l = *(const LAS bf16x8*)(WTl + (16 + tl) * 2048 + ch);
            acc0 = __builtin_amdgcn_mfma_f32_16x16x32_bf16(A0h, Bh, acc0, 0, 0, 0); acc0 = __builtin_amdgcn_mfma_f32_16x16x32_bf16(A0h, Bl, acc0, 0, 0, 0); acc0 = __builtin_amdgcn_mfma_f32_16x16x32_bf16(A0l, Bh, acc0, 0, 0, 0);
            acc1 = __builtin_amdgcn_mfma_f32_16x16x32_bf16(A1h, Bh, acc1, 0, 0, 0); acc1 = __builtin_amdgcn_mfma_f32_16x16x32_bf16(A1h, Bl, acc1, 0, 0, 0); acc1 = __builtin_amdgcn_mfma_f32_16x16x32_bf16(A1l, Bh, acc1, 0, 0, 0);
        }
        ssq += __shfl_xor(ssq, 16); ssq += __shfl_xor(ssq, 32);
        const float rstd = rsqrtf(ssq * (1.0f / 1024.0f) + EPS);
        float lg[8];
#pragma unroll
        for (int i = 0; i < 4; ++i) { lg[i] = rstd * acc0[i] + cbl[4 * kg + i]; lg[4 + i] = rstd * acc1[i] + cbl[16 + 4 * kg + i]; }
        int sel[4]; float val[4];
#pragma unroll
        for (int p = 0; p < 4; ++p) {
            float bv = lg[0]; int bi = 4 * kg;
#pragma unroll
            for (int i = 1; i < 8; ++i) { const int ei = (i < 4 ? 0 : 12) + 4 * kg + i; if (lg[i] > bv) { bv = lg[i]; bi = ei; } }
#pragma unroll
            for (int o = 16; o <= 32; o <<= 1) { const float ov = __shfl_xor(bv, o); const int oi = __shfl_xor(bi, o); if (ov > bv || (ov == bv && oi < bi)) { bv = ov; bi = oi; } }
            sel[p] = bi; val[p] = bv;
#pragma unroll
            for (int i = 0; i < 8; ++i) { const int ei = (i < 4 ? 0 : 12) + 4 * kg + i; if (ei == bi) lg[i] = -3.0e38f; }
        }
        const float e1 = __expf(val[1] - val[0]), e2 = __expf(val[2] - val[0]), e3 = __expf(val[3] - val[0]); const float inv = 1.0f / (1.0f + e1 + e2 + e3);
        if (kg == 0) {
            *(i32x4*)(toke + (size_t)tok * 4) = (i32x4){sel[0], sel[1], sel[2], sel[3]}; *(f32x4*)(tokg + (size_t)tok * 4) = (f32x4){inv, e1 * inv, e2 * inv, e3 * inv};
#pragma unroll
            for (int p = 0; p < 4; ++p) __hip_atomic_fetch_add(wcnt + F.wave * 32 + sel[p], 1, __ATOMIC_RELAXED, __HIP_MEMORY_SCOPE_WORKGROUP);
        }
        asm volatile("s_waitcnt vmcnt(0)" ::: "memory");
        float gm[16], sh[16];
#pragma unroll
        for (int q = 0; q < 4; ++q) { const f32x4 gg = *(const f32x4*)(g + 16 * F.lane + 4 * q), sc = *(const f32x4*)(scp + 16 * F.lane + 4 * q), s4 = *(const f32x4*)(shp + 16 * F.lane + 4 * q);
#pragma unroll
            for (int jx = 0; jx < 4; ++jx) { gm[4 * q + jx] = gg[jx] * (1.0f + sc[jx]); sh[4 * q + jx] = s4[jx]; } }
#pragma unroll 4
        for (int t = 0; t < 16; ++t) {
            const float rs = __shfl(rstd, t); const size_t ro = (size_t)(row0 + 16 * F.wave + t) * D + 16 * F.lane;
            f32x4 xv[4];
            { const u32x4 g0 = *(const u32x4*)(X1B + ro), g1 = *(const u32x4*)(X1B + ro + 8);
              xv[0][0] = bflo(g0.x); xv[0][1] = bfhi(g0.x); xv[0][2] = bflo(g0.y); xv[0][3] = bfhi(g0.y); xv[1][0] = bflo(g0.z); xv[1][1] = bfhi(g0.z); xv[1][2] = bflo(g0.w); xv[1][3] = bfhi(g0.w);
              xv[2][0] = bflo(g1.x); xv[2][1] = bfhi(g1.x); xv[2][2] = bflo(g1.y); xv[2][3] = bfhi(g1.y); xv[3][0] = bflo(g1.z); xv[3][1] = bfhi(g1.z); xv[3][2] = bflo(g1.w); xv[3][3] = bfhi(g1.w); }
            u32x4 w;
            w.x = cvt_pk_fp8x4(xv[0][0] * rs * gm[0] + sh[0], xv[0][1] * rs * gm[1] + sh[1], xv[0][2] * rs * gm[2] + sh[2], xv[0][3] * rs * gm[3] + sh[3]);
            w.y = cvt_pk_fp8x4(xv[1][0] * rs * gm[4] + sh[4], xv[1][1] * rs * gm[5] + sh[5], xv[1][2] * rs * gm[6] + sh[6], xv[1][3] * rs * gm[7] + sh[7]);
            w.z = cvt_pk_fp8x4(xv[2][0] * rs * gm[8] + sh[8], xv[2][1] * rs * gm[9] + sh[9], xv[2][2] * rs * gm[10] + sh[10], xv[2][3] * rs * gm[11] + sh[11]);
            w.w = cvt_pk_fp8x4(xv[3][0] * rs * gm[12] + sh[12], xv[3][1] * rs * gm[13] + sh[13], xv[3][2] * rs * gm[14] + sh[14], xv[3][3] * rs * gm[15] + sh[15]);
            *(u32x4*)(H8 + ro) = w;
        }
    }
    __syncthreads();
    if (F.tid < 256) cnt[F.blk * 256 + F.tid] = wcnt[F.tid];
    __syncthreads();
}

DI void phase_slots(const Frame& F) {
    LAS int* part = (LAS int*)F.lds;
    LAS int* tot = part + 1024; LAS int* bef = tot + 32; LAS int* pst = bef + 32; LAS int* base = pst + 32;
    const int* cnt = (const int*)(F.ws + WS_CNT); const int* toke = (const int*)(F.ws + WS_TOKE);
    int* toks = (int*)(F.ws + WS_TOKS); int* rowtok = (int*)(F.ws + WS_ROWTOK); int* tile = (int*)(F.ws + WS_TILE);
    const int nrows = F.G * 8;
    { const int e = F.tid & 31, pt = F.tid >> 5; int sa = 0, sb = 0; const int per = (nrows + 15) / 16;
      const int r0 = pt * per, r1 = ((pt + 1) * per < nrows) ? (pt + 1) * per : nrows;
#pragma unroll 16
      for (int rw = r0; rw < r1; ++rw) { const int c = cnt[rw * 32 + e]; sa += c; sb += (rw < F.blk * 8) ? c : 0; }
      part[pt * 32 + e] = sa; part[512 + pt * 32 + e] = sb; }
    __syncthreads();
    if (F.tid < 32) { int sa = 0, sb = 0; for (int pt = 0; pt < 16; ++pt) { sa += part[pt * 32 + F.tid]; sb += part[512 + pt * 32 + F.tid]; } tot[F.tid] = sa; bef[F.tid] = sb; }
    __syncthreads();
    if (F.tid == 0) { int run = 0; for (int e = 0; e < 32; ++e) { pst[e] = run; run += (tot[e] + 255) / 256 * 256; }
        if (F.blk == 0) { tile[1000] = run / 256; } }
    __syncthreads();
    if (F.tid < 256) { const int w = F.tid >> 5, e = F.tid & 31; int s = pst[e] + bef[e]; for (int w2 = 0; w2 < w; ++w2) s += cnt[(F.blk * 8 + w2) * 32 + e]; base[w * 32 + e] = s; }
    if (F.blk == 0) { for (int i = F.tid; i < 544; i += 512) { int e = 0; for (int q = 0; q < 32; ++q) if (i * 256 >= pst[q] + (tot[q] + 255) / 256 * 256) e = q + 1; tile[i] = e < 31 ? e : 31; } }
    if (F.blk < 32) { const int e = F.blk; const int s0 = pst[e] + tot[e], s1 = pst[e] + (tot[e] + 255) / 256 * 256; for (int s = s0 + F.tid; s < s1; s += 512) rowtok[s] = 0; }
    __syncthreads();
    for (int it = 0;; ++it) {
        const int row0 = (it * F.G + F.blk) * 128; if (row0 >= T) break;
        const int wr0 = row0 + 16 * F.wave;
        const int ev = toke[wr0 * 4 + F.lane];
        for (int t = 0; t < 16; ++t) { const int row = wr0 + t; const int e = __shfl(ev, 4 * t + (F.lane & 3));
            if (F.lane < 4) { const int s = __hip_atomic_fetch_add(base + F.wave * 32 + e, 1, __ATOMIC_RELAXED, __HIP_MEMORY_SCOPE_WORKGROUP);
                toks[row * 4 + F.lane] = s; rowtok[s] = row; } }
    }
    __syncthreads();
}

DI void fp8x4_to_f32(unsigned w, float (&o)[4]) { typedef float f2_ __attribute__((ext_vector_type(2))); const f2_ a = __builtin_amdgcn_cvt_pk_f32_fp8(w, false), b = __builtin_amdgcn_cvt_pk_f32_fp8(w, true); o[0] = a[0]; o[1] = a[1]; o[2] = b[0]; o[3] = b[1]; }
DI void final_row_load(const bf16_t* X1B, const unsigned char* YA, int row, const i32x4 sl, int lane, u32x4 (&ya)[4], u32x4 (&x1)[2]) {
    const int c0 = 16 * lane;
#pragma unroll
    for (int k = 0; k < 4; ++k) ya[k] = *(const u32x4*)(YA + (size_t)sl[k] * 1024 + c0);
    x1[0] = *(const u32x4*)(X1B + (size_t)row * D + c0); x1[1] = *(const u32x4*)(X1B + (size_t)row * D + c0 + 8);
}
DI void final_row_finish(const float* modgt, const float* gfin, float* out, int row, const f32x4 gk, int lane, const u32x4 (&ya)[4], const u32x4 (&x1)[2]) {
    const int c0 = 16 * lane; float ss = 0.f; f32x4 xo[4];
#pragma unroll
    for (int q = 0; q < 4; ++q) {
        f32x4 m4 = (f32x4){0.f, 0.f, 0.f, 0.f};
#pragma unroll
        for (int k = 0; k < 4; ++k) { float y[4]; fp8x4_to_f32(ya[k][q], y); m4[0] += gk[k] * y[0]; m4[1] += gk[k] * y[1]; m4[2] += gk[k] * y[2]; m4[3] += gk[k] * y[3]; }
        const f32x4 gt = *(const f32x4*)(modgt + c0 + 4 * q);
        f32x4 g4; const unsigned ga = x1[q >> 1][2 * (q & 1)], gb = x1[q >> 1][2 * (q & 1) + 1]; g4[0] = bflo(ga); g4[1] = bfhi(ga); g4[2] = bflo(gb); g4[3] = bfhi(gb);
        const f32x4 x2 = g4 + gt * m4; xo[q] = x2; ss += x2[0] * x2[0] + x2[1] * x2[1] + x2[2] * x2[2] + x2[3] * x2[3]; }
    ss = wave_sum(ss); const float rstd = rsqrtf(ss * (1.0f / 1024.0f) + EPS);
#pragma unroll
    for (int q = 0; q < 4; ++q) { const f32x4 gg = *(const f32x4*)(gfin + c0 + 4 * q); *(f32x4*)(out + (size_t)row * D + c0 + 4 * q) = xo[q] * rstd * gg; }
}
DI void phase_final(const Frame& F) {
    const bf16_t* X1B = (const bf16_t*)(F.ws + WS_CAT); const unsigned char* YA = (const unsigned char*)(F.ws + WS_YA); const int* toks = (const int*)(F.ws + WS_TOKS); const float* tokg = (const float*)(F.ws + WS_TOKG);
    const float* mod = (const float*)(F.ws + WS_MOD); const float* gfin = F.in[I_GFIN]; float* out = F.out;
    for (int it = 0;; ++it) {
        const int row0 = (it * F.G + F.blk) * 128 + 16 * F.wave; if (row0 >= T) break;
        const float* modgt = mod + (row0 >> 12) * 6144 + 5120;
        const i32x4 slv = *(const i32x4*)(toks + (size_t)(row0 + (F.lane & 15)) * 4); const f32x4 gkv = *(const f32x4*)(tokg + (size_t)(row0 + (F.lane & 15)) * 4);
#pragma unroll 1
        for (int t = 0; t < 16; t += 4) {
            i32x4 s_[4]; f32x4 g_[4];
#pragma unroll
            for (int r = 0; r < 4; ++r)
#pragma unroll
                for (int k = 0; k < 4; ++k) { s_[r][k] = __shfl(slv[k], t + r); g_[r][k] = __shfl(gkv[k], t + r); }
            u32x4 ya_[4][4], x1_[4][2];
#pragma unroll
            for (int r = 0; r < 4; ++r) final_row_load(X1B, YA, row0 + t + r, s_[r], F.lane, ya_[r], x1_[r]);
#pragma unroll
            for (int r = 0; r < 4; ++r) final_row_finish(modgt, gfin, out, row0 + t + r, g_[r], F.lane, ya_[r], x1_[r]);
        }
    }
}

__global__ void __launch_bounds__(512, 2) fwd_kernel(Args args) {
    extern __shared__ __attribute__((aligned(16))) unsigned char lds_raw[];
    Frame F;
    F.lds = (LAS unsigned char*)lds_raw; F.tid = threadIdx.x; F.lane = F.tid & 63; F.wave = __builtin_amdgcn_readfirstlane(F.tid >> 6);
    F.G = gridDim.x; F.blk = blockIdx.x; F.vcu = (F.G % 8 == 0) ? (F.blk % 8) * (F.G / 8) + F.blk / 8 : F.blk;
#pragma unroll
    for (int i = 0; i < 27; ++i) F.in[i] = args.in[i];
    F.out = args.out; F.ws = args.ws;
    volatile LAS unsigned* MISC = (volatile LAS unsigned*)(F.lds + MISC_OFF);
    if (F.tid < 64) MISC[F.tid] = 0u;
    __syncthreads();
    const int lo = args.ph_lo, hi = args.ph_hi;
    unsigned* barw = (unsigned*)(F.ws + WS_CTL) + CW_BAR;
    XcdBarrier bar; bar.bar = barw; bar.x = 0; bar.st = nullptr;
    if (hi - lo > 1) bar = xcd_barrier_post(barw, MISC + 8);
#ifndef PH_MASK
#define PH_MASK 0xfff
#endif
#define IN(k) (((PH_MASK >> (k)) & 1) && lo <= (k) && (k) < hi)
#define SEAM(k) do { if (IN(k) && IN((k) + 1)) xcd_barrier(bar); } while (0)
    LAS unsigned char* ring = F.lds;

    if (IN(0)) { phase0(F); } SEAM(0);
    if (IN(1)) { phase1(F); } SEAM(1);
    if (IN(2)) {
        pg8::Gemm g{(const bf16_t*)(F.ws + WS_H), (const bf16_t*)(F.ws + WS_WIN), 1024};
        pg8::SchedPlain S{T / 256, 6, F.G, F.vcu}; pg8::EpiBf16Plain E{(bf16_t*)(F.ws + WS_XP), 1536};
        pg8::gemm_phase(ring, g, S, E);
    } SEAM(2);
    if (IN(3)) { phase3(F); } SEAM(3);
    if (IN(4)) { phase4(F); } SEAM(4);
    if (IN(6)) {
        pg8::Gemm g{(const bf16_t*)(F.ws + WS_CAT), (const bf16_t*)(F.ws + WS_WOUT), 1024};
        pg8::SchedPlain S{T / 256, 4, F.G, F.vcu}; pg8::EpiGmix E{(const float*)(F.ws + WS_MOD), (bf16_t*)(F.ws + WS_GMIX)};
        pg8::gemm_phase(ring, g, S, E);
    } SEAM(6);
    if (IN(7)) { phase_router(F); } SEAM(7);
    if (IN(8)) { phase_slots(F); } SEAM(8);
    if (IN(9)) {
        pg8::Gemm g{(const bf16_t*)(F.ws + WS_H), (const bf16_t*)(F.ws + WS_WGU), 512};
        pg8::SchedMoe::setup(F.lds, (const int*)(F.ws + WS_TILE), (const int*)(F.ws + WS_ROWTOK), F.in[I_BGU], 8, F.G, F.vcu, F.tid, false);
        pg8::SchedMoe S{(LAS const int*)(F.lds + UT_OFF), (LAS const unsigned short*)(F.lds + RTL_OFF), 8, F.G, F.vcu, true}; pg8::EpiAct E{(LAS const float*)(F.lds + BL_OFF), (unsigned char*)(F.ws + WS_ACT)};
        pg8::gemm_phase(ring, g, S, E);
    } SEAM(9);
    if (IN(10)) {
        pg8::Gemm g{(const bf16_t*)(F.ws + WS_ACT), (const bf16_t*)(F.ws + WS_WDOWN), 512};
        pg8::SchedMoe::setup(F.lds, (const int*)(F.ws + WS_TILE), nullptr, F.in[I_BD], 4, F.G, F.vcu, F.tid, true);
        pg8::SchedMoe S{(LAS const int*)(F.lds + UT_OFF), (LAS const unsigned short*)(F.lds + RTL_OFF), 4, F.G, F.vcu, false}; pg8::EpiDown E{(LAS const float*)(F.lds + BL_OFF), (unsigned char*)(F.ws + WS_YA)};
        pg8::gemm_phase(ring, g, S, E);
    } SEAM(10);
    if (IN(11)) { phase_final(F); }
#undef IN
#undef SEAM
}

extern "C" void kernel_launch(void* const* d_in, const int* in_sizes, int n_in, void* d_out, int out_size, void* d_ws, size_t ws_size, hipStream_t stream) {
    static int grid = 0;
    if (grid == 0) {
        if (n_in != 27 || out_size != T * D || ws_size < WS_END) { fprintf(stderr, "kernel_launch: unexpected shapes (n_in %d out %d ws %zu)\n", n_in, out_size, ws_size); grid = -1; return; }
        int dev = 0, cus = 0, per_cu = 0;
        if (hipGetDevice(&dev) != hipSuccess || hipDeviceGetAttribute(&cus, hipDeviceAttributeMultiprocessorCount, dev) != hipSuccess) { grid = -1; return; }
        if (hipFuncSetAttribute((const void*)fwd_kernel, hipFuncAttributeMaxDynamicSharedMemorySize, LDS_BYTES) != hipSuccess) { fprintf(stderr, "kernel_launch: hipFuncSetAttribute failed\n"); grid = -1; return; }
        if (hipOccupancyMaxActiveBlocksPerMultiprocessor(&per_cu, (const void*)fwd_kernel, 512, LDS_BYTES) != hipSuccess || per_cu < 1) { fprintf(stderr, "kernel_launch: occupancy query says %d\n", per_cu); }
        (void)hipGetLastError();
        grid = cus;
    }
    if (grid < 0) return;
    (void)hipMemsetAsync((char*)d_ws + WS_CTL, 0, CTL_BYTES, stream);
    Args a{};
    for (int i = 0; i < 27; ++i) a.in[i] = (const float*)d_in[i];
    a.out = (float*)d_out; a.ws = (unsigned char*)d_ws;
#if N_LAUNCH_MODE == 1
    a.ph_lo = 0; a.ph_hi = NPHASE;
    hipLaunchKernelGGL(fwd_kernel, dim3(grid), dim3(512), LDS_BYTES, stream, a);
#else
    for (int p = 0; p < NPHASE; ++p) { a.ph_lo = p; a.ph_hi = p + 1; hipLaunchKernelGGL(fwd_kernel, dim3(grid), dim3(512), LDS_BYTES, stream, a); }
#endif
}
```

```cpp
#include <hip/hip_runtime.h>
#include <stdint.h>
#include <stdio.h>

#define DI __device__ __forceinline__
#define LAS __attribute__((address_space(3)))
typedef unsigned short bf16_t;
typedef short bf16x8 __attribute__((ext_vector_type(8)));
typedef float f32x4 __attribute__((ext_vector_type(4)));
typedef float f32x16 __attribute__((ext_vector_type(16)));
typedef unsigned u32x4 __attribute__((ext_vector_type(4)));
typedef unsigned u32x2 __attribute__((ext_vector_type(2)));
typedef int i32x4 __attribute__((ext_vector_type(4)));
typedef int i32x8 __attribute__((ext_vector_type(8)));

constexpr int D = 1024, NB = 8, SEQ = 4096, T = NB * SEQ, CTXL = 256, TC = NB * CTXL, TT = T + TC;
constexpr int DR = 512, NE = 32;
constexpr int CAP = (T * 4 / 256 + NE) * 256;
constexpr int NCH = 68;
constexpr float EPS = 1e-6f;
#ifndef N_LAUNCH_MODE
#define N_LAUNCH_MODE 1
#endif
constexpr int NPHASE = 12;

constexpr size_t MiB = 1u << 20;
constexpr size_t WS_CTL = 0, CTL_BYTES = 1 * MiB;
constexpr size_t WS_MOD = 1 * MiB;
constexpr size_t WS_RGW = 1 * MiB + 256 * 1024;
constexpr size_t WS_TILE = 1 * MiB + 512 * 1024;
constexpr size_t WS_CNT = 2 * MiB;
constexpr size_t WS_CF = 2 * MiB + 256 * 1024;
constexpr size_t WS_WMF = 2 * MiB + 512 * 1024;
constexpr size_t WS_TOKE = 3 * MiB;
constexpr size_t WS_TOKG = 3 * MiB + 512 * 1024;
constexpr size_t WS_TOKS = 4 * MiB;
constexpr size_t WS_ROWTOK = 4 * MiB + 512 * 1024;
constexpr size_t WS_ROWGATE = 5 * MiB + 256 * 1024;
constexpr size_t WS_SUMP = 6 * MiB;
constexpr size_t WS_SUMH = 8 * MiB + 256 * 1024;
constexpr size_t WS_WIN = 11 * MiB;
constexpr size_t WS_WOUT = 15 * MiB;
constexpr size_t WS_WDOWN = 17 * MiB;
constexpr size_t WS_WGU = 49 * MiB;
constexpr size_t WS_H = 113 * MiB;
constexpr size_t WS_GMIX = 181 * MiB;
constexpr size_t WS_YA = 309 * MiB;
constexpr size_t WS_XP = 581 * MiB;
constexpr size_t WS_ZG = 683 * MiB;
constexpr size_t WS_CAT = 747 * MiB;
constexpr size_t WS_SS = 843 * MiB;
constexpr size_t WS_CAF = 875 * MiB;
constexpr size_t WS_CAB = 907 * MiB;
constexpr size_t WS_ACT = 581 * MiB;
constexpr size_t WS_END = 939 * MiB;
static_assert(WS_ACT + (size_t)CAP * 1024 <= WS_CAT && WS_YA + (size_t)CAP * 2048 <= WS_XP && WS_XP + (size_t)TT * 3072 <= WS_ZG && WS_ROWGATE + CAP * 4 <= WS_SUMP && WS_SUMH + 8 * 2 * 68 * 512 * 4 <= WS_WIN, "ws map");

constexpr int CW_BAR = 4096;
constexpr int LDS_BYTES = 163840;
constexpr int MISC_OFF = 135168;
constexpr int UT_OFF = MISC_OFF + 2048, RTL_OFF = MISC_OFF + 2560, BL_OFF = MISC_OFF + 11264, MAXU = 17;
static_assert(RTL_OFF + MAXU * 512 <= BL_OFF && BL_OFF + MAXU * 1024 <= LDS_BYTES, "LDS map");

DI unsigned cvt_pk_bf16(float lo, float hi) { unsigned r; asm("v_cvt_pk_bf16_f32 %0, %1, %2" : "=v"(r) : "v"(lo), "v"(hi)); return r; }
DI float bflo(unsigned w) { return __uint_as_float(w << 16); }
DI float bfhi(unsigned w) { return __uint_as_float(w & 0xffff0000u); }
DI float bf2f(bf16_t b) { return __uint_as_float(((unsigned)b) << 16); }
DI bf16_t f2bf(float f) { return (bf16_t)(cvt_pk_bf16(f, 0.f) & 0xffffu); }
DI unsigned cvt_pk_fp8x4(float a, float b, float c, float d) { unsigned r = 0; r = __builtin_amdgcn_cvt_pk_fp8_f32(a, b, r, false); r = __builtin_amdgcn_cvt_pk_fp8_f32(c, d, r, true); return r; }
DI float wave_sum(float v) { v += __shfl_xor(v, 32); v += __shfl_xor(v, 16); v += __shfl_xor(v, 8); v += __shfl_xor(v, 4); v += __shfl_xor(v, 2); v += __shfl_xor(v, 1); return v; }
DI float sigmoidf_(float x) { return __builtin_amdgcn_rcpf(1.0f + __expf(-x)); }
DI float gelu_tanh(float x) { const float z = 0.7978845608028654f * (x + 0.044715f * x * x * x); const float e = __expf(2.0f * z); return x * (1.0f - __builtin_amdgcn_rcpf(1.0f + e)); }

#define XB_TMO      128
#define XB_XCNT(j)  (256  + 64 * (j))
#define XB_XSUB(j)  (1280 + 64 * (j))
#define XB_XGEN(j)  (2304 + 64 * (j))
#define XB_TOP      3328
#define XB_TOPGEN   3392
#define XCD_BAR_WORDS 3456
#define XB_SPIN_CAP (1u << 18)
DI unsigned xb_ld(unsigned* p)              { return __hip_atomic_load(p, __ATOMIC_RELAXED, __HIP_MEMORY_SCOPE_AGENT); }
DI unsigned xb_add(unsigned* p, unsigned v) { return __hip_atomic_fetch_add(p, v, __ATOMIC_RELAXED, __HIP_MEMORY_SCOPE_AGENT); }
DI unsigned xb_xcc_id() { return (unsigned)__builtin_amdgcn_s_getreg((3 << 11) | 20) & 0xFu; }
#define XB_SPIN(cond, bar) do { unsigned _sp = 0; while (cond) { __builtin_amdgcn_s_sleep(1); \
    if ((++_sp & 255u) == 0u) { if (xb_ld(&(bar)[XB_TMO])) break; if (_sp > XB_SPIN_CAP) { atomicAdd(&(bar)[XB_TMO], 1u); break; } } } } while (0)
struct XcdBarrier { unsigned* bar; unsigned x; volatile LAS unsigned* st; };
DI XcdBarrier xcd_barrier_post(unsigned* bar, volatile LAS unsigned* st) {
    XcdBarrier b; b.bar = bar; b.x = xb_xcc_id(); b.st = st;
    if (threadIdx.x == 0) (void)xb_add(&bar[XB_XCNT(b.x)], 1u);
    return b;
}
DI void xcd_barrier_complete(unsigned* bar, unsigned x, unsigned& nloc, unsigned& nx) {
    const unsigned G = gridDim.x * gridDim.y * gridDim.z;
    unsigned sum, cnt, mine, sp = 0u;
    for (;;) {
        sum = 0u; cnt = 0u; mine = 0u;
#pragma unroll
        for (unsigned j = 0; j < 16; ++j) { const unsigned c = xb_ld(&bar[XB_XCNT(j)]); sum += c; cnt += (c > 0u) ? 1u : 0u; mine = (j == x) ? c : mine; }
        if (sum == G) break;
        __builtin_amdgcn_s_sleep(1);
        if ((++sp & 255u) == 0u) { if (xb_ld(&bar[XB_TMO])) break; if (sp > XB_SPIN_CAP) { atomicAdd(&bar[XB_TMO], 1u); break; } }
    }
    nloc = mine > 0u ? mine : 1u; nx = cnt > 0u ? cnt : 1u;
}
DI void xcd_barrier(const XcdBarrier& b) {
    asm volatile("s_waitcnt vmcnt(0)" ::: "memory");
    __syncthreads();
    if (threadIdx.x == 0) {
        unsigned* bar = b.bar;
        __builtin_amdgcn_s_waitcnt(0);
        unsigned nloc = b.st[0], nx = b.st[1];
        if (nloc == 0u) { xcd_barrier_complete(bar, b.x, nloc, nx); b.st[0] = nloc; b.st[1] = nx; }
        const unsigned old = xb_add(&bar[XB_XSUB(b.x)], 1u);
        const unsigned gen = old / nloc;
        if (old + 1u == (gen + 1u) * nloc) {
            __builtin_amdgcn_fence(__ATOMIC_RELEASE, "agent");
            asm volatile("s_waitcnt vmcnt(0)" ::: "memory");
            const unsigned og = xb_add(&bar[XB_TOP], 1u);
            const unsigned tg = og / nx;
            if (og + 1u == (tg + 1u) * nx) xb_add(&bar[XB_TOPGEN], 1u);
            else XB_SPIN(xb_ld(&bar[XB_TOPGEN]) == tg, bar);
            __builtin_amdgcn_fence(__ATOMIC_ACQUIRE, "agent");
            xb_add(&bar[XB_XGEN(b.x)], 1u);
            asm volatile("s_waitcnt vmcnt(0)" ::: "memory");
        } else {
            XB_SPIN(xb_ld(&bar[XB_XGEN(b.x)]) == gen, bar);
            __builtin_amdgcn_fence(__ATOMIC_ACQUIRE, "agent");
            asm volatile("s_waitcnt vmcnt(0)" ::: "memory");
        }
    }
    __syncthreads();
}

namespace pg8 {
constexpr int BM = 256, BK = 64, HALF = 128, HTB = HALF * BK * 2, STAGE_BYTES = 8 * HTB;
DI int lds_byte(int r, int c) { const int st = (r >> 4) * 2 + (c >> 5), rr = r & 15, cc = c & 31, ob = rr * 64 + cc * 2; return st * 1024 + (ob ^ (((ob >> 9) & 1) << 5)); }
DI void stage_rc(int b, int& R, int& C) { const int st = b / 1024, sb = b % 1024, swz = sb ^ (((sb >> 9) & 1) << 5); R = (st >> 1) * 16 + swz / 64; C = (st & 1) * 32 + (swz % 64) / 2; }
DI int perm32(int rho) { const int n = rho >> 4, i = rho & 15; return 8 * (i >> 2) + 4 * n + (i & 3); }
struct Unit { int pm, pn, aux, ix; };
struct Gemm { const bf16_t* A; const bf16_t* Bt; int K; };

template <class Epi, class Sched>
DI void gemm_phase(LAS unsigned char* lds, const Gemm g, const Sched& S, const Epi& E) {
    const int tid = threadIdx.x, wid = __builtin_amdgcn_readfirstlane(tid >> 6), lane = tid & 63, wr = wid >> 2, wc = wid & 3, fr = lane & 15, fq = lane >> 4;
    const int K = g.K, nt = K / BK;
    int RA[2], CA[2]; unsigned voffB[2];
#pragma unroll
    for (int i = 0; i < 2; ++i) { int R, C; stage_rc(tid * 16 + i * 8192, R, C); const int Rb = Epi::PERM ? ((R & ~31) + perm32(R & 31)) : R;
        RA[i] = R; CA[i] = C; voffB[i] = (unsigned)(Rb * K + C) * 2u; }
    const unsigned kstep = (unsigned)(BK * 2);
    const size_t hstep = (size_t)HALF * K * 2;
    const unsigned ldsw = (unsigned)wid * 1024u;
    const int aoff = lds_byte(wr * 64 + fr, fq * 8), boff = lds_byte(wc * 32 + fr, fq * 8);
#define PG8_SA(b, h) (((b) * 2 + (h)) * HTB)
#define PG8_SB(b, h) ((4 + (b) * 2 + (h)) * HTB)
#define PG8_STAGE_B(bufoff, gbase) do { _Pragma("unroll") for (int _i = 0; _i < 2; ++_i) \
        __builtin_amdgcn_global_load_lds((const unsigned*)((const char*)(gbase) + voffB[_i]), (LAS unsigned*)(lds + (bufoff) + ldsw + _i * 8192), 16, 0, 0); } while (0)
#define PG8_STAGE_A(bufoff, kb, o, h) do { _Pragma("unroll") for (int _i = 0; _i < 2; ++_i) \
        __builtin_amdgcn_global_load_lds((const unsigned*)((const char*)g.A + (size_t)(kb) + (o)[h][_i]), (LAS unsigned*)(lds + (bufoff) + ldsw + _i * 8192), 16, 0, 0); } while (0)
#define PG8_LDA(dst, b, h) do { if constexpr (Epi::FP8) { _Pragma("unroll") for (int m = 0; m < 4; ++m) { \
            const i32x4 lo_ = *(const LAS i32x4*)(lds + PG8_SA(b, h) + aoff + m * 2048), hi_ = *(const LAS i32x4*)(lds + PG8_SA(b, h) + aoff + m * 2048 + 1024); \
            dst##8[m] = __builtin_shufflevector(lo_, hi_, 0, 1, 2, 3, 4, 5, 6, 7); } } \
        else { _Pragma("unroll") for (int m = 0; m < 4; ++m) _Pragma("unroll") for (int k = 0; k < 2; ++k) dst[m][k] = *(const LAS bf16x8*)(lds + PG8_SA(b, h) + aoff + m * 2048 + k * 1024); } } while (0)
#define PG8_LDB(dst, b, h) do { if constexpr (Epi::FP8) { _Pragma("unroll") for (int n = 0; n < 2; ++n) { \
            const i32x4 lo_ = *(const LAS i32x4*)(lds + PG8_SB(b, h) + boff + n * 2048), hi_ = *(const LAS i32x4*)(lds + PG8_SB(b, h) + boff + n * 2048 + 1024); \
            dst##8[n] = __builtin_shufflevector(lo_, hi_, 0, 1, 2, 3, 4, 5, 6, 7); } } \
        else { _Pragma("unroll") for (int n = 0; n < 2; ++n) _Pragma("unroll") for (int k = 0; k < 2; ++k) dst[n][k] = *(const LAS bf16x8*)(lds + PG8_SB(b, h) + boff + n * 2048 + k * 1024); } } while (0)
#define PG8_MMA(ai, bj, At, Bt) do { __builtin_amdgcn_s_setprio(1); \
        if constexpr (Epi::FP8) { _Pragma("unroll") for (int m = 0; m < 4; ++m) _Pragma("unroll") for (int n = 0; n < 2; ++n) \
            asm volatile("v_mfma_scale_f32_16x16x128_f8f6f4 %0, %1, %2, %0, %3, %4 op_sel_hi:[0,0,0]" : "+v"(acc[ai][bj][m][n]) : "v"(Bt##8[n]), "v"(At##8[m]), "v"(scale_w_), "v"(scale_a_)); } \
        else { _Pragma("unroll") for (int m = 0; m < 4; ++m) _Pragma("unroll") for (int n = 0; n < 2; ++n) _Pragma("unroll") for (int k = 0; k < 2; ++k) \
            acc[ai][bj][m][n] = __builtin_amdgcn_mfma_f32_16x16x32_bf16(Bt[n][k], At[m][k], acc[ai][bj][m][n], 0, 0, 0); } \
        __builtin_amdgcn_s_setprio(0); } while (0)
#define PG8_WAIT_V(n) asm volatile("s_waitcnt vmcnt(" #n ")" ::: "memory")
#define PG8_WAIT_L(n) asm volatile("s_waitcnt lgkmcnt(" #n ")" ::: "memory")
#define PG8_BAR __builtin_amdgcn_s_barrier()
#define PG8_SCHED __builtin_amdgcn_sched_barrier(0)
    Unit cur, nxt; int ui = 0;
    if (!S.next(0, cur)) return;
    f32x4 acc[2][2][4][2];
#pragma unroll
    for (int a = 0; a < 2; ++a)
#pragma unroll
        for (int b = 0; b < 2; ++b)
#pragma unroll
            for (int m = 0; m < 4; ++m)
#pragma unroll
                for (int n = 0; n < 2; ++n) acc[a][b][m][n] = (f32x4){0.f, 0.f, 0.f, 0.f};
    int scale_w_ = Epi::SCALE_W, scale_a_ = 0x7f7f7f7f; asm volatile("" : "+v"(scale_w_), "+v"(scale_a_));
    bf16x8 At[4][2], B0[2][2], B1[2][2]; i32x8 At8[4], B08[2], B18[2];
    unsigned oc[2][2], on[2][2];
    S.a_off(cur, RA, CA, K, oc);
    const char* cB = (const char*)g.Bt + S.b_off(cur, K);
    PG8_STAGE_B(PG8_SB(0, 0), cB); PG8_STAGE_A(PG8_SA(0, 0), 0u, oc, 0); PG8_STAGE_B(PG8_SB(0, 1), cB + hstep); PG8_STAGE_A(PG8_SA(0, 1), 0u, oc, 1);
    if (wr == 1) PG8_BAR;
    PG8_WAIT_V(4); PG8_BAR;
    PG8_STAGE_B(PG8_SB(1, 0), cB + kstep); PG8_STAGE_A(PG8_SA(1, 0), kstep, oc, 0); PG8_STAGE_B(PG8_SB(1, 1), cB + hstep + kstep);
    PG8_WAIT_V(6); PG8_BAR;
    for (;;) {
        const bool has_next = S.next(ui + 1, nxt);
        const char* nB = cB;
        if (has_next) { S.a_off(nxt, RA, CA, K, on); nB = (const char*)g.Bt + S.b_off(nxt, K); }
        else {
#pragma unroll
            for (int h = 0; h < 2; ++h)
#pragma unroll
                for (int i = 0; i < 2; ++i) on[h][i] = oc[h][i];
        }
#pragma unroll 1
        for (int t = 0; t < nt; t += 2) {
            const bool last = (t == nt - 2);
            const unsigned k1 = (unsigned)(t + 1) * kstep;
            const unsigned k2 = last ? 0u : (unsigned)(t + 2) * kstep, k3 = k2 + kstep;
            unsigned o2[2][2];
#pragma unroll
            for (int h = 0; h < 2; ++h)
#pragma unroll
                for (int i = 0; i < 2; ++i) o2[h][i] = last ? on[h][i] : oc[h][i];
            const char* b2 = last ? nB : cB + (size_t)(t + 2) * kstep; const char* b3 = b2 + kstep;
            PG8_LDB(B0, 0, 0); PG8_SCHED; PG8_LDA(At, 0, 0); PG8_STAGE_A(PG8_SA(1, 1), k1, oc, 1);
            PG8_WAIT_L(8); PG8_BAR; PG8_WAIT_L(0); PG8_MMA(0, 0, At, B0); PG8_BAR; PG8_SCHED;
            PG8_LDB(B1, 0, 1); PG8_STAGE_B(PG8_SB(0, 0), b2);
            PG8_BAR; PG8_WAIT_L(0); PG8_MMA(0, 1, At, B1); PG8_BAR;
            PG8_LDA(At, 0, 1); PG8_STAGE_A(PG8_SA(0, 0), k2, o2, 0);
            PG8_BAR; PG8_WAIT_L(0); PG8_MMA(1, 0, At, B0); PG8_BAR; PG8_SCHED;
            PG8_STAGE_B(PG8_SB(0, 1), b2 + hstep);
            PG8_WAIT_V(6); PG8_BAR; PG8_MMA(1, 1, At, B1); PG8_BAR;
            PG8_LDB(B0, 1, 0); PG8_SCHED; PG8_LDA(At, 1, 0); PG8_STAGE_A(PG8_SA(0, 1), k2, o2, 1);
            PG8_WAIT_L(8); PG8_BAR; PG8_WAIT_L(0); PG8_MMA(0, 0, At, B0); PG8_BAR; PG8_SCHED;
            PG8_LDB(B1, 1, 1); PG8_STAGE_B(PG8_SB(1, 0), b3);
            PG8_BAR; PG8_WAIT_L(0); PG8_MMA(0, 1, At, B1); PG8_BAR;
            PG8_LDA(At, 1, 1); PG8_STAGE_A(PG8_SA(1, 0), k3, o2, 0);
            PG8_BAR; PG8_WAIT_L(0); PG8_MMA(1, 0, At, B0); PG8_BAR; PG8_SCHED;
            PG8_STAGE_B(PG8_SB(1, 1), b3 + hstep);
            PG8_WAIT_V(6); PG8_BAR; PG8_MMA(1, 1, At, B1); PG8_BAR;
        }
        if constexpr (Epi::FP8) asm volatile("s_nop 15\n\ts_nop 15" ::: "memory");
        E(acc, cur, wr, wc, fr, fq);
        if (!has_next) break;
#pragma unroll
        for (int a = 0; a < 2; ++a)
#pragma unroll
            for (int b = 0; b < 2; ++b)
#pragma unroll
                for (int m = 0; m < 4; ++m)
#pragma unroll
                    for (int n = 0; n < 2; ++n) acc[a][b][m][n] = (f32x4){0.f, 0.f, 0.f, 0.f};
        cur = nxt; cB = nB; ++ui;
#pragma unroll
        for (int h = 0; h < 2; ++h)
#pragma unroll
            for (int i = 0; i < 2; ++i) oc[h][i] = on[h][i];
    }
    PG8_WAIT_V(0);
    if (wr == 0) PG8_BAR;
    PG8_BAR;
#undef PG8_SA
#undef PG8_SB
#undef PG8_STAGE_A
#undef PG8_STAGE_B
#undef PG8_LDA
#undef PG8_LDB
#undef PG8_MMA
#undef PG8_WAIT_V
#undef PG8_WAIT_L
#undef PG8_BAR
#undef PG8_SCHED
}

struct SchedPlain {
    int nM, nN, G, vcu;
    DI bool next(int i, Unit& u) const { const int L = i * G + vcu; if (L >= nM * nN) return false; u.pm = L / nN; u.pn = L % nN; u.aux = 0; u.ix = i; return true; }
    DI void a_off(const Unit& u, const int (&R)[2], const int (&C)[2], int K, unsigned (&o)[2][2]) const {
#pragma unroll
        for (int h = 0; h < 2; ++h)
#pragma unroll
            for (int i = 0; i < 2; ++i) o[h][i] = (unsigned)((u.pm * 256 + h * 128 + R[i]) * K + C[i]) * 2u; }
    DI size_t b_off(const Unit& u, int K) const { return (size_t)u.pn * 256 * K * 2; }
};
struct SchedMoe {
    LAS const int* ut; LAS const unsigned short* rtl; int nN, G, vcu; bool gather;
    static DI void setup(LAS unsigned char* lds, const int* tile, const int* rowtok, const float* bias, int nN, int G, int vcu, int tid, bool rev) {
        LAS int* ut = (LAS int*)(lds + UT_OFF); LAS unsigned short* rtl = (LAS unsigned short*)(lds + RTL_OFF); LAS float* bl = (LAS float*)(lds + BL_OFF);
        __syncthreads();
        const int nmt = tile[1000]; int nu = 0;
        for (int i = 0; i < MAXU; ++i) { const int L = i * G + vcu; if (L < nmt * nN) nu = i + 1; }
        if (tid < MAXU) { const int L = tid * G + vcu; if (L < nmt * nN) { const int pm = rev ? nmt - 1 - L / nN : L / nN; ut[1 + 2 * tid] = pm; ut[2 + 2 * tid] = tile[pm]; } }
        if (tid == 0) ut[0] = nu;
        for (int i = tid >> 8; i < nu; i += 2) { const int L = i * G + vcu, pm = rev ? nmt - 1 - L / nN : L / nN, pn = L % nN, e = tile[pm], c = tid & 255;
            if (rowtok) rtl[i * 256 + c] = (unsigned short)rowtok[pm * 256 + c];
            bl[i * 256 + c] = nN == 8 ? bias[(size_t)e * 2048 + (c >> 7) * 1024 + 128 * pn + (c & 127)] : bias[(size_t)e * 1024 + 256 * pn + c]; }
        __syncthreads();
    }
    DI bool next(int i, Unit& u) const { if (i >= ut[0]) return false; const int L = i * G + vcu; u.pm = ut[1 + 2 * i]; u.pn = L % nN; u.aux = ut[2 + 2 * i]; u.ix = i; return true; }
    DI void a_off(const Unit& u, const int (&R)[2], const int (&C)[2], int K, unsigned (&o)[2][2]) const {
        if (gather) {
            LAS const unsigned short* rp = rtl + u.ix * 256;
            const int t0 = rp[R[0]], t1 = rp[R[1]], t2 = rp[128 + R[0]], t3 = rp[128 + R[1]];
            o[0][0] = (unsigned)(t0 * K + C[0]) * 2u; o[0][1] = (unsigned)(t1 * K + C[1]) * 2u; o[1][0] = (unsigned)(t2 * K + C[0]) * 2u; o[1][1] = (unsigned)(t3 * K + C[1]) * 2u;
        } else {
#pragma unroll
            for (int h = 0; h < 2; ++h)
#pragma unroll
                for (int i = 0; i < 2; ++i) o[h][i] = (unsigned)((u.pm * 256 + h * 128 + R[i]) * K + C[i]) * 2u;
        }
    }
    DI size_t b_off(const Unit& u, int K) const { return (size_t)(u.aux * nN + u.pn) * 256 * K * 2; }
};

struct EpiBf16Plain {
    static constexpr bool PERM = true, FP8 = false; static constexpr int SCALE_W = 0x7f7f7f7f;
    bf16_t* O; int ldc;
    DI void operator()(const f32x4 (&acc)[2][2][4][2], const Unit& u, int wr, int wc, int fr, int fq) const {
        const int row0 = u.pm * BM + wr * 64 + fr, col0 = u.pn * BM + wc * 32 + 8 * fq;
#pragma unroll
        for (int ai = 0; ai < 2; ++ai)
#pragma unroll
            for (int m = 0; m < 4; ++m) { bf16_t* rowp = O + (size_t)(row0 + ai * HALF + m * 16) * ldc + col0;
#pragma unroll
                for (int bj = 0; bj < 2; ++bj) { const f32x4 v0 = acc[ai][bj][m][0], v1 = acc[ai][bj][m][1];
                    u32x4 w; w.x = cvt_pk_bf16(v0[0], v0[1]); w.y = cvt_pk_bf16(v0[2], v0[3]); w.z = cvt_pk_bf16(v1[0], v1[1]); w.w = cvt_pk_bf16(v1[2], v1[3]);
                    *(u32x4*)(rowp + bj * HALF) = w; } }
    }
};
struct EpiGmix {
    static constexpr bool PERM = true, FP8 = false; static constexpr int SCALE_W = 0x7f7f7f7f;
    const float* mod; bf16_t* O;
    DI void operator()(const f32x4 (&acc)[2][2][4][2], const Unit& u, int wr, int wc, int fr, int fq) const {
        const int row0 = u.pm * BM + wr * 64 + fr, col0 = u.pn * BM + wc * 32 + 8 * fq;
        const int b = (u.pm * BM) >> 12;
        f32x4 gt[2][2];
#pragma unroll
        for (int bj = 0; bj < 2; ++bj)
#pragma unroll
            for (int n = 0; n < 2; ++n) gt[bj][n] = *(const f32x4*)(mod + b * 6144 + 2048 + col0 + bj * HALF + 4 * n);
#pragma unroll
        for (int ai = 0; ai < 2; ++ai)
#pragma unroll
            for (int m = 0; m < 4; ++m) { bf16_t* rowp = O + (size_t)(row0 + ai * HALF + m * 16) * D + col0;
#pragma unroll
                for (int bj = 0; bj < 2; ++bj) { const f32x4 v0 = acc[ai][bj][m][0] * gt[bj][0], v1 = acc[ai][bj][m][1] * gt[bj][1];
                    u32x4 w; w.x = cvt_pk_bf16(v0[0], v0[1]); w.y = cvt_pk_bf16(v0[2], v0[3]); w.z = cvt_pk_bf16(v1[0], v1[1]); w.w = cvt_pk_bf16(v1[2], v1[3]);
                    *(u32x4*)(rowp + bj * HALF) = w; } }
    }
};
typedef float f32x2 __attribute__((ext_vector_type(2)));
struct EpiAct {
    static constexpr bool PERM = true, FP8 = true; static constexpr int SCALE_W = 0x7a7a7a7a;
    LAS const float* bl; unsigned char* O;
    DI void operator()(const f32x4 (&acc)[2][2][4][2], const Unit& u, int wr, int wc, int fr, int fq) const {
        const int row0 = u.pm * BM + wr * 64 + fr, cl = wc * 32 + 8 * fq, colj = u.pn * HALF + cl;
        LAS const float* bp = bl + u.ix * 256 + cl;
        f32x4 bgv[2], buv[2];
#pragma unroll
        for (int n = 0; n < 2; ++n) { bgv[n] = *(LAS const f32x4*)(bp + 4 * n); buv[n] = *(LAS const f32x4*)(bp + 128 + 4 * n); }
#pragma unroll
        for (int ai = 0; ai < 2; ++ai)
#pragma unroll
            for (int m = 0; m < 4; ++m) {
                f32x2 o[4];
#pragma unroll
                for (int n = 0; n < 2; ++n) { const f32x4 gv = acc[ai][0][m][n] + bgv[n], uv = acc[ai][1][m][n] + buv[n];
#pragma unroll
                    for (int j = 0; j < 2; ++j) {
                        f32x2 gt, up; gt.x = fminf(gv[2 * j], 7.0f); gt.y = fminf(gv[2 * j + 1], 7.0f); up.x = __builtin_amdgcn_fmed3f(uv[2 * j], -7.0f, 7.0f); up.y = __builtin_amdgcn_fmed3f(uv[2 * j + 1], -7.0f, 7.0f);
                        const f32x2 z = gt * (-1.702f * 1.44269504089f); f32x2 e; e.x = __builtin_amdgcn_exp2f(z.x); e.y = __builtin_amdgcn_exp2f(z.y);
                        const f32x2 d = e + 1.0f; f32x2 r; r.x = __builtin_amdgcn_rcpf(d.x); r.y = __builtin_amdgcn_rcpf(d.y);
                        o[2 * n + j] = (up + 1.0f) * (gt * r); } }
                u32x2 w; w.x = cvt_pk_fp8x4(o[0].x, o[0].y, o[1].x, o[1].y); w.y = cvt_pk_fp8x4(o[2].x, o[2].y, o[3].x, o[3].y);
                *(u32x2*)(O + (size_t)(row0 + ai * HALF + m * 16) * 1024 + colj) = w; }
    }
};
struct EpiDown {
    static constexpr bool PERM = true, FP8 = true; static constexpr int SCALE_W = 0x7a7a7a7a;
    LAS const float* bl; unsigned char* O;
    DI void operator()(const f32x4 (&acc)[2][2][4][2], const Unit& u, int wr, int wc, int fr, int fq) const {
        const int row0 = u.pm * BM + wr * 64 + fr, cl = wc * 32 + 8 * fq, col0 = u.pn * BM + cl;
        LAS const float* bp = bl + u.ix * 256 + cl;
        f32x4 bv[2][2];
#pragma unroll
        for (int bj = 0; bj < 2; ++bj)
#pragma unroll
            for (int n = 0; n < 2; ++n) bv[bj][n] = *(LAS const f32x4*)(bp + bj * HALF + 4 * n);
#pragma unroll
        for (int ai = 0; ai < 2; ++ai)
#pragma unroll
            for (int m = 0; m < 4; ++m) { unsigned char* rowp = O + (size_t)(row0 + ai * HALF + m * 16) * 1024 + col0;
#pragma unroll
                for (int bj = 0; bj < 2; ++bj) { const f32x4 v0 = acc[ai][bj][m][0] + bv[bj][0], v1 = acc[ai][bj][m][1] + bv[bj][1];
                    u32x2 w; w.x = cvt_pk_fp8x4(v0[0], v0[1], v0[2], v0[3]); w.y = cvt_pk_fp8x4(v1[0], v1[1], v1[2], v1[3]);
                    *(u32x2*)(rowp + bj * HALF) = w; } }
    }
};
}

struct Args { const float* in[27]; float* out; unsigned char* ws; int ph_lo, ph_hi; };
struct Frame {
    LAS unsigned char* lds; int tid, lane, wave, G, blk, vcu;
    const float* in[27]; float* out; unsigned char* ws;
};
enum { I_X = 0, I_C, I_CTX, I_CCTX, I_WMOD, I_BMOD, I_GMIX, I_GFFN, I_WIN, I_WF, I_CONVW, I_CONVB, I_RGWA, I_RGBA, I_RGWX, I_RGBX, I_LAM, I_GOF, I_GOR, I_WOUT, I_WR, I_BR, I_WGU, I_BGU, I_WD, I_BD, I_GFIN };

constexpr int IT_TR = 8 + 24 + 1 + 32;

DI void p0_adaln(const Frame& F, int cb) {
    LAS float* sc = (LAS float*)F.lds; LAS float* red = (LAS float*)(F.lds + 36864);
    const float* c = F.in[I_C]; const float* cctx = F.in[I_CCTX]; const float* wmod = F.in[I_WMOD]; const float* bmod = F.in[I_BMOD];
    float* mod = (float*)(F.ws + WS_MOD);
    for (int i = F.tid; i < 9 * 1024; i += 512) { const int r = i >> 10, k = i & 1023; const float v = r < 8 ? c[r * 1024 + k] : cctx[k]; sc[i] = v / (1.0f + __expf(-v)); }
    __syncthreads();
    f32x4 acc[9];
#pragma unroll
    for (int r = 0; r < 9; ++r) acc[r] = (f32x4){0.f, 0.f, 0.f, 0.f};
    const float* wp = wmod + (size_t)(128 * F.wave) * 6144 + cb * 256 + 4 * F.lane;
    for (int kk = 0; kk < 128; kk += 8) {
        f32x4 wv[8];
#pragma unroll
        for (int j = 0; j < 8; ++j) wv[j] = *(const f32x4*)(wp + (size_t)(kk + j) * 6144);
#pragma unroll
        for (int j = 0; j < 8; ++j)
#pragma unroll
            for (int r = 0; r < 9; ++r) { const float s = sc[r * 1024 + 128 * F.wave + kk + j]; acc[r] += s * wv[j]; }
    }
#pragma unroll
    for (int r = 0; r < 9; ++r) *(LAS f32x4*)(red + (F.wave * 9 + r) * 256 + 4 * F.lane) = acc[r];
    __syncthreads();
    for (int i = F.tid; i < 9 * 256; i += 512) { const int r = i >> 8, cc = i & 255; float s = bmod[cb * 256 + cc];
        for (int w = 0; w < 8; ++w) s += red[(w * 9 + r) * 256 + cc];
        mod[r * 6144 + cb * 256 + cc] = s; }
    __syncthreads();
}

DI void p0_wmf(const Frame& F, int it) {
    const int g = it >> 1, rip = it & 1;
    LAS float* tw = (LAS float*)F.lds;
    LAS float* wfs = tw + 128;
    LAS float* Fm = wfs + 128 * 128;
    const float* wf = F.in[I_WF] + (size_t)g * 128 * 128;
    bf16_t* WMF = (bf16_t*)(F.ws + WS_WMF);
    const float norm = 0.0013810679320049757f;
    __syncthreads();
    if (F.tid < 128) { const float rev = (float)F.tid * (1.0f / 128.0f); tw[F.tid] = rip ? __builtin_amdgcn_sinf(rev) : __builtin_amdgcn_cosf(rev); }
    for (int i = F.tid; i < 128 * 128; i += 512) wfs[i] = wf[i];
    __syncthreads();
    { const int jp = F.tid & 127, j0 = F.tid >> 7; float sacc[32];
#pragma unroll
      for (int i = 0; i < 32; ++i) sacc[i] = 0.f;
#pragma unroll 4
      for (int l = 0; l < 128; ++l) { const float w = wfs[l * 128 + jp];
#pragma unroll
          for (int i = 0; i < 32; ++i) sacc[i] += tw[(l * (j0 + 4 * i)) & 127] * w; }
#pragma unroll
      for (int i = 0; i < 32; ++i) Fm[(j0 + 4 * i) * 128 + jp] = sacc[i] * norm; }
    __syncthreads();
    for (int i = 0; i < 4; ++i) { const int idx = F.tid + 512 * i;
        const int ln = idx & 63, nt = (idx >> 6) & 3, sx = (idx >> 8) & 1, jt = idx >> 9; const int hh = ln >> 5, n = ln & 31;
        float v[8];
#pragma unroll
        for (int jj = 0; jj < 8; ++jj) v[jj] = Fm[(32 * jt + 16 * sx + 8 * (jj >> 2) + 4 * hh + (jj & 3)) * 128 + 32 * nt + n];
        u32x4 w; w.x = cvt_pk_bf16(v[0], v[1]); w.y = cvt_pk_bf16(v[2], v[3]); w.z = cvt_pk_bf16(v[4], v[5]); w.w = cvt_pk_bf16(v[6], v[7]);
        *(u32x4*)(WMF + ((size_t)((((g * 2 + rip) * 4 + jt) * 2 + sx) * 4 + nt) * 64 + ln) * 8) = w; }
    __syncthreads();
}
DI void p0_cf(const Frame& F) {
    bf16_t* CF = (bf16_t*)(F.ws + WS_CF);
    for (int i = 0; i < 4; ++i) { const int idx = F.tid + 512 * i; const int ln = idx & 63, ks = (idx >> 6) & 7, rip = (idx >> 9) & 1, pt = idx >> 10; const int hh = ln >> 5, p = 32 * pt + (ln & 31);
        float v[8];
#pragma unroll
        for (int jj = 0; jj < 8; ++jj) { const int k2 = 16 * ks + 8 * hh + jj, ri = k2 >> 6, c = k2 & 63; const float rev = (float)((c * p) & 63) * (1.0f / 64.0f);
            const float cs = __builtin_amdgcn_cosf(rev), sn = __builtin_amdgcn_sinf(rev); v[jj] = rip == 0 ? (ri == 0 ? cs : sn) : (ri == 0 ? -sn : cs); }
        u32x4 w; w.x = cvt_pk_bf16(v[0], v[1]); w.y = cvt_pk_bf16(v[2], v[3]); w.z = cvt_pk_bf16(v[4], v[5]); w.w = cvt_pk_bf16(v[6], v[7]);
        *(u32x4*)(CF + (size_t)idx * 8) = w; }
}
DI void p0_rgw(const Frame& F, int it) {
    const int type = it >> 4, d = (it >> 3) & 1, h = it & 7;
    const float* src = (type ? F.in[I_RGWX] : F.in[I_RGWA]) + (size_t)(d * 8 + h) * 4096;
    bf16_t* dst = (bf16_t*)(F.ws + WS_RGW) + (size_t)((d * 2 + type) * 8 + h) * 4096;
    for (int i = F.tid; i < 4096; i += 512) { const int j = i >> 6, ii = i & 63; dst[i] = f2bf(src[ii * 64 + j]); }
}
DI void p0_tr_fp8(const float* src, int ldn, int k0, int n0, unsigned char* dst, int dbase, bool gu, int lane) {
    const float* sp = src + (size_t)k0 * ldn + n0 + 4 * lane;
    f32x4 v[32];
#pragma unroll
    for (int i = 0; i < 32; ++i) v[i] = *(const f32x4*)(sp + (size_t)i * ldn);
#pragma unroll
    for (int c = 0; c < 4; ++c) { const int n = n0 + 4 * lane + c; const int jn = n & 1023; const int drow = dbase + (gu ? 256 * (jn >> 7) + 128 * (n >> 10) + (jn & 127) : n);
        unsigned char* dp = dst + (size_t)drow * 1024 + k0;
#pragma unroll
        for (int h = 0; h < 2; ++h) { u32x4 w;
            w.x = cvt_pk_fp8x4(32.f * v[16 * h + 0][c], 32.f * v[16 * h + 1][c], 32.f * v[16 * h + 2][c], 32.f * v[16 * h + 3][c]); w.y = cvt_pk_fp8x4(32.f * v[16 * h + 4][c], 32.f * v[16 * h + 5][c], 32.f * v[16 * h + 6][c], 32.f * v[16 * h + 7][c]);
            w.z = cvt_pk_fp8x4(32.f * v[16 * h + 8][c], 32.f * v[16 * h + 9][c], 32.f * v[16 * h + 10][c], 32.f * v[16 * h + 11][c]); w.w = cvt_pk_fp8x4(32.f * v[16 * h + 12][c], 32.f * v[16 * h + 13][c], 32.f * v[16 * h + 14][c], 32.f * v[16 * h + 15][c]);
            *(u32x4*)(dp + h * 16) = w; } }
}
DI void p0_tr_bf16(const float* src, int ldn, int k0, int n0, bf16_t* dst, int lane) {
    const float* sp = src + (size_t)k0 * ldn + n0 + 4 * lane;
    f32x4 v[32];
#pragma unroll
    for (int i = 0; i < 32; ++i) v[i] = *(const f32x4*)(sp + (size_t)i * ldn);
#pragma unroll
    for (int c = 0; c < 4; ++c) { bf16_t* dp = dst + (size_t)(n0 + 4 * lane + c) * 1024 + k0;
#pragma unroll
        for (int h = 0; h < 4; ++h) { u32x4 w; w.x = cvt_pk_bf16(v[8 * h][c], v[8 * h + 1][c]); w.y = cvt_pk_bf16(v[8 * h + 2][c], v[8 * h + 3][c]); w.z = cvt_pk_bf16(v[8 * h + 4][c], v[8 * h + 5][c]); w.w = cvt_pk_bf16(v[8 * h + 6][c], v[8 * h + 7][c]);
            *(u32x4*)(dp + h * 8) = w; } }
}
constexpr int WT_WIN = 6 * 32, WT_WOUT = 4 * 32, WT_WGU = 32 * 8 * 32, WT_WD = 32 * 4 * 32, WT_END = WT_WIN + WT_WOUT + WT_WGU + WT_WD;
constexpr int CW_Q0 = 512, CW_Q1 = 576;
DI void phase0(const Frame& F) {
    unsigned* ctl = (unsigned*)(F.ws + WS_CTL);
    volatile LAS int* bq = (volatile LAS int*)(F.lds + MISC_OFF + 64);
    for (;;) {
        __syncthreads();
        if (F.tid == 0) bq[0] = (int)__hip_atomic_fetch_add(ctl + CW_Q0, 1u, __ATOMIC_RELAXED, __HIP_MEMORY_SCOPE_AGENT);
        __syncthreads();
        const int q = bq[0]; if (q >= IT_TR) break;
        if (q < 8) p0_wmf(F, q);
        else if (q < 32) p0_adaln(F, q - 8);
        else if (q < 33) p0_cf(F);
        else p0_rgw(F, q - 33);
    }
#pragma unroll 1
    for (int rnd = 0;; ++rnd) {
        if ((rnd & 1) == 0) { __syncthreads(); if (F.tid == 0) bq[0] = (int)__hip_atomic_fetch_add(ctl + CW_Q1, 16u, __ATOMIC_RELAXED, __HIP_MEMORY_SCOPE_AGENT); __syncthreads(); }
        const int wi = bq[0] + 8 * (rnd & 1) + F.wave; if (bq[0] >= WT_END) break;
        if (wi >= WT_END) continue;
        int j = wi;
        if (j < WT_WGU) { const int e = j >> 8, kb = (j >> 3) & 31, nb = j & 7;
            p0_tr_fp8(F.in[I_WGU] + (size_t)e * 1024 * 2048, 2048, kb * 32, nb * 256, (unsigned char*)(F.ws + WS_WGU), e * 2048, true, F.lane); }
        else if ((j -= WT_WGU) < WT_WD) { const int e = j >> 7, kb = (j >> 2) & 31, nb = j & 3;
            p0_tr_fp8(F.in[I_WD] + (size_t)e * 1024 * 1024, 1024, kb * 32, nb * 256, (unsigned char*)(F.ws + WS_WDOWN), e * 1024, false, F.lane); }
        else if ((j -= WT_WD) < WT_WIN) { const int kb = j / 6, nb = j % 6; p0_tr_bf16(F.in[I_WIN], 1536, kb * 32, nb * 256, (bf16_t*)(F.ws + WS_WIN), F.lane); }
        else { j -= WT_WIN; const int kb = j >> 2, nb = j & 3; p0_tr_bf16(F.in[I_WOUT], 1024, kb * 32, nb * 256, (bf16_t*)(F.ws + WS_WOUT), F.lane); }
    }
}

template <int NR> DI void norm_rows(const float* xr, const float* g, const float* modb, bf16_t* hrow, int lane) {
    f32x4 v[NR][4]; float ss[NR];
#pragma unroll
    for (int r = 0; r < NR; ++r)
#pragma unroll
        for (int q = 0; q < 4; ++q) v[r][q] = *(const f32x4*)(xr + (size_t)r * D + 4 * lane + 256 * q);
#pragma unroll
    for (int r = 0; r < NR; ++r) { float a = 0.f;
#pragma unroll
        for (int q = 0; q < 4; ++q) a += v[r][q][0] * v[r][q][0] + v[r][q][1] * v[r][q][1] + v[r][q][2] * v[r][q][2] + v[r][q][3] * v[r][q][3];
        ss[r] = rsqrtf(wave_sum(a) * (1.0f / 1024.0f) + EPS); }
#pragma unroll
    for (int q = 0; q < 4; ++q) { const int k = 4 * lane + 256 * q;
        const f32x4 gg = *(const f32x4*)(g + k), sh = *(const f32x4*)(modb + k), sc = *(const f32x4*)(modb + 1024 + k); const f32x4 gm = gg * (1.0f + sc);
#pragma unroll
        for (int r = 0; r < NR; ++r) { const f32x4 y = v[r][q] * ss[r] * gm + sh;
            u32x2 w; w.x = cvt_pk_bf16(y[0], y[1]); w.y = cvt_pk_bf16(y[2], y[3]);
            *(u32x2*)(hrow + (size_t)r * D + k) = w; } }
}
struct SchedOne { int pm, pn; bool used;
    DI bool next(int i, pg8::Unit& u) const { if (i > 0) return false; u.pm = pm; u.pn = pn; u.aux = 0; u.ix = 0; return true; }
    DI void a_off(const pg8::Unit& u, const int (&R)[2], const int (&C)[2], int K, unsigned (&o)[2][2]) const {
#pragma unroll
        for (int h = 0; h < 2; ++h)
#pragma unroll
            for (int i = 0; i < 2; ++i) o[h][i] = (unsigned)((u.pm * 256 + h * 128 + R[i]) * K + C[i]) * 2u; }
    DI size_t b_off(const pg8::Unit& u, int K) const { return (size_t)u.pn * 256 * K * 2; }
};
DI void phase1(const Frame& F) {
    const float* x = F.in[I_X]; const float* ctx = F.in[I_CTX]; const float* g = F.in[I_GMIX]; const float* mod = (const float*)(F.ws + WS_MOD);
    bf16_t* H = (bf16_t*)(F.ws + WS_H);
    if (F.blk < 16 && F.G > 16) {
        const int mt = F.blk >> 1;
#pragma unroll 1
        for (int i = 0; i < 4; ++i) { const int rr = 256 * mt + 32 * F.wave + 8 * i; norm_rows<8>(ctx + (size_t)rr * D, g, mod + 8 * 6144, H + (size_t)(T + rr) * D, F.lane); }
        asm volatile("s_waitcnt vmcnt(0)" ::: "memory"); __syncthreads();
        pg8::Gemm gg{(const bf16_t*)(F.ws + WS_H), (const bf16_t*)(F.ws + WS_WIN), 1024};
        SchedOne S{T / 256 + mt, 2 + (F.blk & 1), true}; pg8::EpiBf16Plain E{(bf16_t*)(F.ws + WS_XP), 1536};
        pg8::gemm_phase(F.lds, gg, S, E);
    } else {
        const int nb = F.G > 16 ? F.G - 16 : F.G, bb = F.G > 16 ? F.blk - 16 : F.blk;
#pragma unroll 1
        for (int it = 0;; ++it) {
            const int row = ((it * nb + bb) * 8 + F.wave) * 4; if (row >= T) break;
            norm_rows<4>(x + (size_t)row * D, g, mod + (row >> 12) * 6144, H + (size_t)row * D, F.lane);
        }
        if (F.G <= 16) {
            for (int row = F.blk * 8 + F.wave; row < TC; row += F.G * 8) norm_rows<1>(ctx + (size_t)row * D, g, mod + 8 * 6144, H + (size_t)(T + row) * D, F.lane);
        }
    }
}

DI int serp_tok(int b, int P) { const int rr = P >> 6, cc = P & 63; return b * SEQ + (rr << 6) + ((rr & 1) ? 63 - cc : cc); }
DI void rg_unit(const Frame& F, int u) {
    LAS unsigned char* xcl = F.lds;
    const bf16_t* XR = (const bf16_t*)(F.ws + WS_XP) + 512; const bf16_t* RGW = (const bf16_t*)(F.ws + WS_RGW);
    const float* convw = F.in[I_CONVW]; const float* convb = F.in[I_CONVB];
    float* sumP = (float*)(F.ws + WS_SUMP); float* sumH = (float*)(F.ws + WS_SUMH);
    bf16_t* SSb = (bf16_t*)(F.ws + WS_SS); bf16_t* CAF = (bf16_t*)(F.ws + WS_CAF); bf16_t* CAB = (bf16_t*)(F.ws + WS_CAB);
    int tid = F.tid; asm volatile("" : "+v"(tid));
    const int lane = tid & 63, hh = F.wave, hf = lane >> 5;
    {
        const bool lat = u < 512; const int b = lat ? (u >> 6) : ((u - 512) >> 2), r = lat ? (u & 63) : ((u - 512) & 3); const int L = lat ? SEQ : CTXL;
        {
            const int cg = tid & 63; float w[4][8], bs[8];
#pragma unroll
            for (int k = 0; k < 4; ++k) { const f32x4 a = *(const f32x4*)(convw + k * 512 + 8 * cg), c2 = *(const f32x4*)(convw + k * 512 + 8 * cg + 4);
                w[k][0] = a[0]; w[k][1] = a[1]; w[k][2] = a[2]; w[k][3] = a[3]; w[k][4] = c2[0]; w[k][5] = c2[1]; w[k][6] = c2[2]; w[k][7] = c2[3]; }
            { const f32x4 a = *(const f32x4*)(convb + 8 * cg), c2 = *(const f32x4*)(convb + 8 * cg + 4); bs[0] = a[0]; bs[1] = a[1]; bs[2] = a[2]; bs[3] = a[3]; bs[4] = c2[0]; bs[5] = c2[1]; bs[6] = c2[2]; bs[7] = c2[3]; }
#pragma unroll
            for (int i = 0; i < 8; ++i) { const int p = (tid >> 6) + 8 * i; float a[8];
#pragma unroll
                for (int j = 0; j < 8; ++j) a[j] = bs[j];
#pragma unroll
                for (int k = 0; k < 4; ++k) { const int P = 64 * r + p + k - 2;
                    if (P >= 0 && P < L) { const int tk = lat ? serp_tok(b, P) : T + b * CTXL + P; const u32x4 xv = *(const u32x4*)(XR + (size_t)tk * 1536 + 8 * cg);
#pragma unroll
                        for (int j = 0; j < 4; ++j) { a[2 * j] += w[k][2 * j] * bflo(xv[j]); a[2 * j + 1] += w[k][2 * j + 1] * bfhi(xv[j]); } } }
                u32x4 o; o.x = cvt_pk_bf16(a[0], a[1]); o.y = cvt_pk_bf16(a[2], a[3]); o.z = cvt_pk_bf16(a[4], a[5]); o.w = cvt_pk_bf16(a[6], a[7]);
                *(LAS u32x4*)(xcl + p * 1040 + cg * 16) = o; }
        }
        __syncthreads();
        const int cidx = lat ? 4 + r : r; const int tokbase = b * SEQ + 64 * r;
#pragma unroll 1
        for (int nt = 0; nt < 2; ++nt) {
            const int chl = 32 * nt + (lane & 31), ch = 64 * hh + chl;
            unsigned hlp[2][8];
#pragma unroll
            for (int d = 0; d < 2; ++d) {
                f32x16 ar[2], ai[2];
#pragma unroll
                for (int t = 0; t < 2; ++t)
#pragma unroll
                    for (int i = 0; i < 16; ++i) { ar[t][i] = 0.f; ai[t][i] = 0.f; }
                const bf16_t* wr_ = RGW + (size_t)(((d * 2 + 0) * 8 + hh) * 64 + chl) * 64; const bf16_t* wi_ = RGW + (size_t)(((d * 2 + 1) * 8 + hh) * 64 + chl) * 64;
                bf16x8 brv[4], biv[4];
#pragma unroll
                for (int ks = 0; ks < 4; ++ks) { brv[ks] = *(const bf16x8*)(wr_ + 16 * ks + 8 * hf); biv[ks] = *(const bf16x8*)(wi_ + 16 * ks + 8 * hf); }
#pragma unroll
                for (int ks = 0; ks < 4; ++ks) {
                    const bf16x8 br = brv[ks], bi = biv[ks];
#pragma unroll
                    for (int t = 0; t < 2; ++t) { const int m = lane & 31; const int pos = 32 * ((m >> 2) & 1) + 16 * t + 4 * (m >> 3) + (m & 3);
                        const bf16x8 a = *(const LAS bf16x8*)(xcl + pos * 1040 + (64 * hh + 16 * ks + 8 * hf) * 2);
                        ar[t] = __builtin_amdgcn_mfma_f32_32x32x16_bf16(a, br, ar[t], 0, 0, 0); ai[t] = __builtin_amdgcn_mfma_f32_32x32x16_bf16(a, bi, ai[t], 0, 0, 0); }
                }
                const float ba = F.in[I_RGBA][d * 512 + ch], bx = F.in[I_RGBX][d * 512 + ch], lam = F.in[I_LAM][d * 512 + ch];
                const float nl = -lam; const float sp8 = 8.0f * (fmaxf(nl, 0.f) + log1pf(expf(-fabsf(nl))));
#pragma unroll
                for (int t = 0; t < 2; ++t)
#pragma unroll
                    for (int i = 0; i < 16; ++i) { const int p = 32 * hf + 16 * t + i;
                        const float rr = sigmoidf_(ar[t][i] + ba), ii = sigmoidf_(ai[t][i] + bx); const float a = __expf(-sp8 * rr);
                        const float xcv = bf2f(*(const LAS bf16_t*)(xcl + p * 1040 + ch * 2));
                        ar[t][i] = a; ai[t][i] = __builtin_amdgcn_sqrtf(fmaxf(1.0f - a * a, 0.f)) * ii * xcv; }
                float hl = 0.f, ca = 1.f;
                if (d == 0) {
#pragma unroll
                    for (int t = 0; t < 2; ++t)
#pragma unroll
                        for (int i = 0; i < 16; ++i) { const float a = ar[t][i]; hl = a * hl + ai[t][i]; ca *= a; ai[t][i] = hl; ar[t][i] = ca; }
                    const float P0 = __shfl(ca, lane & 31), H0 = __shfl(hl, lane & 31);
                    if (hf == 1) {
#pragma unroll
                        for (int t = 0; t < 2; ++t)
#pragma unroll
                            for (int i = 0; i < 16; ++i) { ai[t][i] += ar[t][i] * H0; ar[t][i] *= P0; }
                        sumP[(size_t)((b * 2 + 0) * NCH + cidx) * 512 + ch] = ar[1][15]; sumH[(size_t)((b * 2 + 0) * NCH + cidx) * 512 + ch] = ai[1][15];
                    }
#pragma unroll
                    for (int t = 0; t < 2; ++t)
#pragma unroll
                        for (int i = 0; i < 8; ++i) hlp[t][i] = cvt_pk_bf16(ai[t][2 * i], ai[t][2 * i + 1]);
                    if (lat) {
                        const int p0 = 32 * hf; bf16_t* pc = CAF + (size_t)(tokbase + ((r & 1) ? 63 - p0 : p0)) * 512 + ch; const long stride = (r & 1) ? -512 : 512;
#pragma unroll
                        for (int t = 0; t < 2; ++t)
#pragma unroll
                            for (int i = 0; i < 16; ++i) { *pc = f2bf(ar[t][i]); pc += stride; asm volatile("" : "+v"(pc)); }
                    }
                } else {
#pragma unroll
                    for (int t = 1; t >= 0; --t)
#pragma unroll
                        for (int i = 15; i >= 0; --i) { const float a = ar[t][i]; hl = a * hl + ai[t][i]; ca *= a; ai[t][i] = hl; ar[t][i] = ca; }
                    const float P1 = __shfl(ca, (lane & 31) + 32), H1 = __shfl(hl, (lane & 31) + 32);
                    if (hf == 0) {
#pragma unroll
                        for (int t = 0; t < 2; ++t)
#pragma unroll
                            for (int i = 0; i < 16; ++i) { ai[t][i] += ar[t][i] * H1; ar[t][i] *= P1; }
                        sumP[(size_t)((b * 2 + 1) * NCH + cidx) * 512 + ch] = ar[0][0]; sumH[(size_t)((b * 2 + 1) * NCH + cidx) * 512 + ch] = ai[0][0];
                    }
                    if (lat) {
                        const int p0 = 32 * hf; const size_t o0 = (size_t)(tokbase + ((r & 1) ? 63 - p0 : p0)) * 512 + ch; bf16_t* pc = CAB + o0; bf16_t* ps = SSb + o0; const long stride = (r & 1) ? -512 : 512;
#pragma unroll
                        for (int t = 0; t < 2; ++t)
#pragma unroll
                            for (int i = 0; i < 16; ++i) { *pc = f2bf(ar[t][i]); *ps = f2bf(((i & 1) ? bfhi(hlp[t][i >> 1]) : bflo(hlp[t][i >> 1])) + ai[t][i]); pc += stride; ps += stride; asm volatile("" : "+v"(pc), "+v"(ps)); }
                    }
                }
            }
        }
        __syncthreads();
    }
}

typedef short s16x4 __attribute__((ext_vector_type(4)));
DI unsigned pk_bf16c(float a, float b) { typedef float f2_ __attribute__((ext_vector_type(2))); typedef __bf16 b2_ __attribute__((ext_vector_type(2))); const b2_ r = __builtin_convertvector((f2_){a, b}, b2_); return __builtin_bit_cast(unsigned, r); }
DI unsigned img_off(int row, int ch) { return 256u * row + 16u * (ch ^ (((row & 3) << 2) | ((row >> 2) & 3))); }
DI unsigned tr_addr(int lane, int cc, int t) { const int h = lane >> 5, blk = (lane >> 4) & 1, q4 = (lane & 15) >> 2, p = lane & 3; return img_off(8 * h + 4 * t + q4, 4 * cc + 2 * blk + (p >> 1)) + 8u * (p & 1); }

constexpr int FFTA_OFF = 81920;
DI void fftR_table(const Frame& F) {
#pragma unroll 1
    for (int i = 0; i < 2; ++i) { const int idx = F.tid + 512 * i; const int ln = idx & 63, ks = (idx >> 6) & 3, mt = idx >> 8; const int h = ln >> 5, m = ln & 31;
        float v[8];
#pragma unroll
        for (int jj = 0; jj < 8; ++jj) { const int r = 16 * ks + 8 * h + jj, q = 32 * (mt & 1) + m; const float rev = (float)((r * q) & 63) * (1.0f / 64.0f); v[jj] = mt < 2 ? __builtin_amdgcn_cosf(rev) : -__builtin_amdgcn_sinf(rev); }
        u32x4 w; w.x = pk_bf16c(v[0], v[1]); w.y = pk_bf16c(v[2], v[3]); w.z = pk_bf16c(v[4], v[5]); w.w = pk_bf16c(v[6], v[7]);
        *(LAS u32x4*)(F.lds + FFTA_OFF + idx * 16) = w; }
}
DI void fftR_unit(const Frame& F, int u) {
    int lane = F.lane; asm volatile("" : "+v"(lane));
    const int h = lane >> 5, m = lane & 31;
    const bf16_t* XP = (const bf16_t*)(F.ws + WS_XP); bf16_t* ZG = (bf16_t*)(F.ws + WS_ZG);
    const unsigned ldsb = (unsigned)(__SIZE_TYPE__)F.lds;
    {
        const int b = u >> 6, c = u & 63;
        __syncthreads();
#pragma unroll
        for (int i = 0; i < 8; ++i) { const int idx = F.tid + 512 * i; const int r = idx >> 6, ch8 = idx & 63;
            const u32x4 v = *(const u32x4*)(XP + (size_t)(b * SEQ + 64 * r + c) * 1536 + 8 * ch8);
            *(LAS u32x4*)(F.lds + (ch8 >> 4) * 16384 + img_off(r, ch8 & 15)) = v; }
        __syncthreads();
#pragma unroll 1
        for (int nn = 0; nn < 2; ++nn) {
            const int nt = F.wave * 2 + nn, slab = nt >> 2, cc = nt & 3;
            const unsigned a0 = ldsb + slab * 16384 + tr_addr(lane, cc, 0), a1 = ldsb + slab * 16384 + tr_addr(lane, cc, 1);
            s16x4 lo[4], hi[4];
            asm volatile("ds_read_b64_tr_b16 %0, %8\n\tds_read_b64_tr_b16 %1, %9\n\tds_read_b64_tr_b16 %2, %8 offset:4096\n\tds_read_b64_tr_b16 %3, %9 offset:4096\n\t"
                         "ds_read_b64_tr_b16 %4, %8 offset:8192\n\tds_read_b64_tr_b16 %5, %9 offset:8192\n\tds_read_b64_tr_b16 %6, %8 offset:12288\n\tds_read_b64_tr_b16 %7, %9 offset:12288\n\ts_waitcnt lgkmcnt(0)"
                         : "=&v"(lo[0]), "=&v"(hi[0]), "=&v"(lo[1]), "=&v"(hi[1]), "=&v"(lo[2]), "=&v"(hi[2]), "=&v"(lo[3]), "=&v"(hi[3]) : "v"(a0), "v"(a1) : "memory");
            f32x16 acc[4];
#pragma unroll
            for (int mt = 0; mt < 4; ++mt)
#pragma unroll
                for (int i = 0; i < 16; ++i) acc[mt][i] = 0.f;
#pragma unroll
            for (int ks = 0; ks < 4; ++ks) { const bf16x8 Bf = __builtin_shufflevector(lo[ks], hi[ks], 0, 1, 2, 3, 4, 5, 6, 7);
#pragma unroll
                for (int mt = 0; mt < 4; ++mt) { const bf16x8 Af = *(const LAS bf16x8*)(F.lds + FFTA_OFF + ((mt * 4 + ks) * 64 + lane) * 16); acc[mt] = __builtin_amdgcn_mfma_f32_32x32x16_bf16(Af, Bf, acc[mt], 0, 0, 0); } }
            const int ch = 32 * nt + m;
#pragma unroll
            for (int qh = 0; qh < 2; ++qh) {
                bf16_t* pz = ZG + ((size_t)((b * 64 + 32 * qh + 4 * h) * 2) * 64 + c) * 512 + ch;
#pragma unroll
                for (int i = 0; i < 16; ++i) { const int q = 32 * qh + (i & 3) + 8 * (i >> 2) + 4 * h;
                    const float rev = (float)((c * q) & 4095) * (1.0f / 4096.0f); const float cw = __builtin_amdgcn_cosf(rev), sw = __builtin_amdgcn_sinf(rev);
                    const float yr = acc[qh][i], yi = acc[2 + qh][i];
                    pz[0] = (bf16_t)(pk_bf16c(yr * cw + yi * sw, 0.f) & 0xffffu); pz[64 * 512] = (bf16_t)(pk_bf16c(yi * cw - yr * sw, 0.f) & 0xffffu);
                    pz += ((i & 3) == 3 ? 5 : 1) * (2 * 64 * 512); asm volatile("" : "+v"(pz)); }
            }
        }
    }
}
constexpr int CW_Q3 = 640;
DI void phase3(const Frame& F) {
    unsigned* ctl = (unsigned*)(F.ws + WS_CTL);
    volatile LAS int* bq = (volatile LAS int*)(F.lds + MISC_OFF + 64);
    fftR_table(F);
    int cur = F.blk;
    while (cur < 544 + 512) {
        int nxt = 0; if (F.tid == 0) nxt = F.G + (int)__hip_atomic_fetch_add(ctl + CW_Q3, 1u, __ATOMIC_RELAXED, __HIP_MEMORY_SCOPE_AGENT);
        if (cur < 544) rg_unit(F, cur); else fftR_unit(F, cur - 544);
        __syncthreads(); if (F.tid == 0) bq[0] = nxt; __syncthreads(); cur = bq[0];
    }
    __syncthreads();
}

constexpr int FRED_OFF = 131072;
DI void fftC_unit(const Frame& F, int u) {
    int lane = F.lane; asm volatile("" : "+v"(lane));
    const int h = lane >> 5, m = lane & 31, g = F.wave >> 1, pt = F.wave & 1;
    const unsigned ldsb = (unsigned)(__SIZE_TYPE__)F.lds + g * 32768;
    unsigned ta[4][2];
#pragma unroll
    for (int jt = 0; jt < 4; ++jt) { ta[jt][0] = ldsb + tr_addr(lane, jt, 0); ta[jt][1] = ldsb + tr_addr(lane, jt, 1); }
    const bf16_t* ZG = (const bf16_t*)(F.ws + WS_ZG); const bf16_t* CF = (const bf16_t*)(F.ws + WS_CF); const bf16_t* WMF = (const bf16_t*)(F.ws + WS_WMF); bf16_t* CAT = (bf16_t*)(F.ws + WS_CAT);
    LAS float* fred = (LAS float*)(F.lds + FRED_OFF);
    {
        const int b = u >> 6, q = u & 63;
        __syncthreads();
        const bf16_t* zsrc = ZG + (size_t)(b * 64 + q) * 2 * 64 * 512;
#pragma unroll
        for (int i = 0; i < 16; ++i) { const int idx = F.tid + 512 * i; const int k2 = idx >> 6, ch8 = idx & 63;
            const u32x4 v = *(const u32x4*)(zsrc + (size_t)k2 * 512 + 8 * ch8);
            *(LAS u32x4*)(F.lds + (ch8 >> 4) * 32768 + img_off(k2, ch8 & 15)) = v; }
        __syncthreads();
        f32x16 out[4];
#pragma unroll
        for (int n = 0; n < 4; ++n)
#pragma unroll
            for (int i = 0; i < 16; ++i) out[n][i] = 0.f;
#pragma unroll 1
        for (int rj = 0; rj < 4; ++rj) {
            const int rip = rj >> 1, jp = rj & 1;
            f32x16 xt[2];
#pragma unroll
            for (int jt = 0; jt < 2; ++jt)
#pragma unroll
                for (int i = 0; i < 16; ++i) xt[jt][i] = 0.f;
            const unsigned t00 = ta[0][0], t01 = ta[0][1], t10 = ta[1][0], t11 = ta[1][1], t20 = ta[2][0], t21 = ta[2][1], t30 = ta[3][0], t31 = ta[3][1];
            const unsigned a0 = jp ? t20 : t00, a1 = jp ? t21 : t01, a2 = jp ? t30 : t10, a3 = jp ? t31 : t11;
            bf16x8 Bcv[8];
#pragma unroll
            for (int ks = 0; ks < 8; ++ks) Bcv[ks] = *(const bf16x8*)(CF + ((size_t)((pt * 2 + rip) * 8 + ks) * 64 + lane) * 8);
#pragma unroll
            for (int ks = 0; ks < 8; ++ks) {
                const bf16x8 Bc = Bcv[ks];
                s16x4 lo[2], hi[2]; const unsigned ko = 4096u * ks;
                asm volatile("ds_read_b64_tr_b16 %0, %4\n\tds_read_b64_tr_b16 %1, %5\n\tds_read_b64_tr_b16 %2, %6\n\tds_read_b64_tr_b16 %3, %7\n\ts_waitcnt lgkmcnt(0)"
                             : "=&v"(lo[0]), "=&v"(hi[0]), "=&v"(lo[1]), "=&v"(hi[1]) : "v"(a0 + ko), "v"(a1 + ko), "v"(a2 + ko), "v"(a3 + ko) : "memory");
#pragma unroll
                for (int jt = 0; jt < 2; ++jt) { const bf16x8 Af = __builtin_shufflevector(lo[jt], hi[jt], 0, 1, 2, 3, 4, 5, 6, 7); xt[jt] = __builtin_amdgcn_mfma_f32_32x32x16_bf16(Af, Bc, xt[jt], 0, 0, 0); }
            }
#pragma unroll
            for (int jt = 0; jt < 2; ++jt) {
                bf16x8 Bwv[2][4];
#pragma unroll
                for (int sx = 0; sx < 2; ++sx)
#pragma unroll
                    for (int n = 0; n < 4; ++n) Bwv[sx][n] = *(const bf16x8*)(WMF + ((size_t)(((((g * 2 + rip) * 4 + 2 * jp + jt) * 2 + sx) * 4 + n) * 64) + lane) * 8);
#pragma unroll
                for (int sx = 0; sx < 2; ++sx) {
                    u32x4 w; w.x = pk_bf16c(xt[jt][8 * sx + 0], xt[jt][8 * sx + 1]); w.y = pk_bf16c(xt[jt][8 * sx + 2], xt[jt][8 * sx + 3]); w.z = pk_bf16c(xt[jt][8 * sx + 4], xt[jt][8 * sx + 5]); w.w = pk_bf16c(xt[jt][8 * sx + 6], xt[jt][8 * sx + 7]);
                    const bf16x8 Af = __builtin_bit_cast(bf16x8, w);
#pragma unroll
                    for (int n = 0; n < 4; ++n) out[n] = __builtin_amdgcn_mfma_f32_32x32x16_bf16(Af, Bwv[sx][n], out[n], 0, 0, 0);
                }
                asm volatile("" ::: "memory");
            }
        }
#pragma unroll
        for (int i = 0; i < 16; ++i) { float a = out[0][i] * out[0][i] + out[1][i] * out[1][i] + out[2][i] * out[2][i] + out[3][i] * out[3][i];
            a += __shfl_xor(a, 1); a += __shfl_xor(a, 2); a += __shfl_xor(a, 4); a += __shfl_xor(a, 8); a += __shfl_xor(a, 16);
            if (m == 0) fred[g * 64 + 32 * pt + (i & 3) + 8 * (i >> 2) + 4 * h] = a;
            asm volatile("" ::: "memory"); }
        __syncthreads();
        float gsc[4];
#pragma unroll
        for (int n = 0; n < 4; ++n) gsc[n] = F.in[I_GOF][128 * g + 32 * n + m];
        bf16_t* pf = CAT + ((size_t)(b * SEQ + 64 * (32 * pt + 4 * h) + q)) * 1024 + 128 * g + m;
#pragma unroll
        for (int i = 0; i < 16; ++i) { const int p = 32 * pt + (i & 3) + 8 * (i >> 2) + 4 * h;
            const float tot = (fred[p] + fred[64 + p]) + (fred[128 + p] + fred[192 + p]); const float rs = rsqrtf(tot * (1.0f / 512.0f) + EPS);
#pragma unroll
            for (int n = 0; n < 4; ++n) pf[32 * n] = (bf16_t)(pk_bf16c(out[n][i] * rs * gsc[n], 0.f) & 0xffffu);
            pf += ((i & 3) == 3 ? 5 : 1) * (64 * 1024); asm volatile("" : "+v"(pf) :: "memory"); }
    }
}

DI void catrg_unit(const Frame& F, int u) {
    LAS float* cinf = (LAS float*)F.lds; LAS float* cinb = cinf + 4 * 512;
    const float* sumP = (const float*)(F.ws + WS_SUMP); const float* sumH = (const float*)(F.ws + WS_SUMH);
    const bf16_t* SSb = (const bf16_t*)(F.ws + WS_SS); const bf16_t* CAF = (const bf16_t*)(F.ws + WS_CAF); const bf16_t* CAB = (const bf16_t*)(F.ws + WS_CAB);
    const bf16_t* GR = (const bf16_t*)(F.ws + WS_XP) + 1024; bf16_t* CAT = (bf16_t*)(F.ws + WS_CAT);
    const float* gor = F.in[I_GOR];
    {
        const int b = u >> 4, r0 = (u & 15) * 4;
        __syncthreads();
        { const int t = F.tid; float hfw = 0.f, hbw = 0.f;
          const float* pf = sumP + (size_t)((b * 2 + 0) * NCH) * 512 + t; const float* qf = sumH + (size_t)((b * 2 + 0) * NCH) * 512 + t;
#pragma unroll 8
          for (int c = 0; c < 4 + r0; ++c) hfw = pf[c * 512] * hfw + qf[c * 512];
          cinf[t] = hfw;
#pragma unroll
          for (int k = 1; k < 4; ++k) { hfw = pf[(3 + r0 + k) * 512] * hfw + qf[(3 + r0 + k) * 512]; cinf[k * 512 + t] = hfw; }
          const float* pb = sumP + (size_t)((b * 2 + 1) * NCH) * 512 + t; const float* qb = sumH + (size_t)((b * 2 + 1) * NCH) * 512 + t;
          for (int c = 3; c >= 0; --c) hbw = pb[c * 512] * hbw + qb[c * 512];
#pragma unroll 8
          for (int c = NCH - 1; c > 4 + r0 + 3; --c) hbw = pb[c * 512] * hbw + qb[c * 512];
          cinb[3 * 512 + t] = hbw;
#pragma unroll
          for (int k = 2; k >= 0; --k) { hbw = pb[(4 + r0 + k + 1) * 512] * hbw + qb[(4 + r0 + k + 1) * 512]; cinb[k * 512 + t] = hbw; }
        }
        __syncthreads();
        float gr_[8];
#pragma unroll
        for (int j = 0; j < 8; ++j) gr_[j] = gor[8 * F.lane + j];
#pragma unroll 1
        for (int k = 0; k < 4; ++k) {
            float cf[8], cb[8];
#pragma unroll
            for (int j = 0; j < 8; ++j) { cf[j] = cinf[k * 512 + 8 * F.lane + j]; cb[j] = cinb[k * 512 + 8 * F.lane + j]; }
#pragma unroll 2
            for (int i = 0; i < 8; ++i) {
                const int tk = b * SEQ + 64 * (r0 + k) + F.wave * 8 + i;
                const u32x4 s4 = *(const u32x4*)(SSb + (size_t)tk * 512 + 8 * F.lane), a4 = *(const u32x4*)(CAF + (size_t)tk * 512 + 8 * F.lane), b4 = *(const u32x4*)(CAB + (size_t)tk * 512 + 8 * F.lane);
                const u32x4 g4 = *(const u32x4*)(GR + (size_t)tk * 1536 + 8 * F.lane);
                float rg[8]; float sr = 0.f;
#pragma unroll
                for (int j = 0; j < 4; ++j) {
                    const float y0 = bflo(s4[j]) + bflo(a4[j]) * cf[2 * j] + bflo(b4[j]) * cb[2 * j], y1 = bfhi(s4[j]) + bfhi(a4[j]) * cf[2 * j + 1] + bfhi(b4[j]) * cb[2 * j + 1];
                    rg[2 * j] = y0 * gelu_tanh(bflo(g4[j])); rg[2 * j + 1] = y1 * gelu_tanh(bfhi(g4[j]));
                    sr += rg[2 * j] * rg[2 * j] + rg[2 * j + 1] * rg[2 * j + 1]; }
                sr = wave_sum(sr);
                const float rr = rsqrtf(sr * (1.0f / 512.0f) + EPS);
                u32x4 orr;
                orr.x = cvt_pk_bf16(rg[0] * rr * gr_[0], rg[1] * rr * gr_[1]); orr.y = cvt_pk_bf16(rg[2] * rr * gr_[2], rg[3] * rr * gr_[3]); orr.z = cvt_pk_bf16(rg[4] * rr * gr_[4], rg[5] * rr * gr_[5]); orr.w = cvt_pk_bf16(rg[6] * rr * gr_[6], rg[7] * rr * gr_[7]);
                *(u32x4*)(CAT + (size_t)tk * 1024 + 512 + 8 * F.lane) = orr;
            }
        }
    }
}
constexpr int CW_Q4 = 768;
DI void phase4(const Frame& F) {
    unsigned* ctl = (unsigned*)(F.ws + WS_CTL);
    volatile LAS int* bq = (volatile LAS int*)(F.lds + MISC_OFF + 64);
    int cur = F.blk;
    while (cur < 512 + 128) {
        int nxt = 0; if (F.tid == 0) nxt = F.G + (int)__hip_atomic_fetch_add(ctl + CW_Q4, 1u, __ATOMIC_RELAXED, __HIP_MEMORY_SCOPE_AGENT);
        if (cur < 128) catrg_unit(F, cur); else fftC_unit(F, cur - 128);
        __syncthreads(); if (F.tid == 0) bq[0] = nxt; __syncthreads(); cur = bq[0];
    }
    __syncthreads();
}

DI void phase_router(const Frame& F) {
    LAS unsigned char* WTh = F.lds; LAS unsigned char* WTl = F.lds + 65536;
    LAS float* cbl = (LAS float*)(F.lds + 131072);
    LAS int* wcnt = (LAS int*)(F.lds + MISC_OFF + 1024);
    const float* wrt = F.in[I_WR]; const float* brt = F.in[I_BR]; const float* g = F.in[I_GFFN]; const float* mod = (const float*)(F.ws + WS_MOD);
    const float* X = F.in[I_X]; const bf16_t* GM = (const bf16_t*)(F.ws + WS_GMIX); unsigned char* H8 = (unsigned char*)(F.ws + WS_H); bf16_t* X1B = (bf16_t*)(F.ws + WS_CAT);
    int* toke = (int*)(F.ws + WS_TOKE); float* tokg = (float*)(F.ws + WS_TOKG); int* cnt = (int*)(F.ws + WS_CNT);
    if (F.tid < 256) wcnt[F.tid] = 0;
    int bcur = -1;
    for (int it = 0;; ++it) {
        const int row0 = (it * F.G + F.blk) * 128; if (row0 >= T) break;
        const int b = row0 >> 12;
        const float* shp = mod + b * 6144 + 3072; const float* scp = mod + b * 6144 + 4096;
        if (b != bcur) {
            bcur = b; __syncthreads();
#pragma unroll 1
            for (int i0 = 0; i0 < 64; i0 += 16) {
                float wv[16], gv[16];
#pragma unroll
                for (int i = 0; i < 16; ++i) { const int idx = F.tid + 512 * (i0 + i); const int k = idx >> 5; wv[i] = wrt[idx]; gv[i] = g[k] * (1.0f + scp[k]); }
#pragma unroll
                for (int i = 0; i < 16; ++i) { const int idx = F.tid + 512 * (i0 + i); const int e = idx & 31, k = idx >> 5;
                    const float v = gv[i] * wv[i]; const unsigned hi = cvt_pk_bf16(v, 0.f) & 0xffffu; const float lo = v - __uint_as_float(hi << 16);
                    const int kk = k & 31, chn = 4 * (k >> 5) + ((kk & 15) >> 2), jj = (kk & 3) + 4 * (kk >> 4);
                    const int off = e * 2048 + ((chn ^ (e & 15)) << 4) + jj * 2;
                    *(LAS bf16_t*)(WTh + off) = (bf16_t)hi; *(LAS bf16_t*)(WTl + off) = f2bf(lo); }
            }
            { float sacc[4] = {0.f, 0.f, 0.f, 0.f};
#pragma unroll
              for (int i = 0; i < 16; ++i) { const int k = F.lane + 64 * i; const float sv = shp[k]; const f32x4 w4 = *(const f32x4*)(wrt + k * 32 + 4 * F.wave);
                  sacc[0] += sv * w4[0]; sacc[1] += sv * w4[1]; sacc[2] += sv * w4[2]; sacc[3] += sv * w4[3]; }
#pragma unroll
              for (int q = 0; q < 4; ++q) { const float tsum = wave_sum(sacc[q]); if (F.lane == 0) cbl[4 * F.wave + q] = tsum + brt[4 * F.wave + q]; } }
            __syncthreads();
        }
        const int tl = F.lane & 15, kg = F.lane >> 4; const int tok = row0 + 16 * F.wave + tl;
        f32x4 acc0 = (f32x4){0.f, 0.f, 0.f, 0.f}, acc1 = acc0; float ssq = 0.f;
        const float* xp = X + (size_t)tok * D + 4 * kg; const bf16_t* gp = GM + (size_t)tok * D + 4 * kg;
#pragma unroll 8
        for (int ks = 0; ks < 32; ++ks) {
            f32x4 xa = *(const f32x4*)(xp + 32 * ks), xb = *(const f32x4*)(xp + 32 * ks + 16);
            const u32x2 ga = *(const u32x2*)(gp + 32 * ks), gb = *(const u32x2*)(gp + 32 * ks + 16);
            xa[0] += bflo(ga.x); xa[1] += bfhi(ga.x); xa[2] += bflo(ga.y); xa[3] += bfhi(ga.y); xb[0] += bflo(gb.x); xb[1] += bfhi(gb.x); xb[2] += bflo(gb.y); xb[3] += bfhi(gb.y);
            ssq += xa[0] * xa[0] + xa[1] * xa[1] + xa[2] * xa[2] + xa[3] * xa[3] + xb[0] * xb[0] + xb[1] * xb[1] + xb[2] * xb[2] + xb[3] * xb[3];
            u32x4 hv, lv;
            hv.x = cvt_pk_bf16(xa[0], xa[1]); hv.y = cvt_pk_bf16(xa[2], xa[3]); hv.z = cvt_pk_bf16(xb[0], xb[1]); hv.w = cvt_pk_bf16(xb[2], xb[3]);
            lv.x = cvt_pk_bf16(xa[0] - bflo(hv.x), xa[1] - bfhi(hv.x)); lv.y = cvt_pk_bf16(xa[2] - bflo(hv.y), xa[3] - bfhi(hv.y));
            lv.z = cvt_pk_bf16(xb[0] - bflo(hv.z), xb[1] - bfhi(hv.z)); lv.w = cvt_pk_bf16(xb[2] - bflo(hv.w), xb[3] - bfhi(hv.w));
            { bf16_t* xo_ = X1B + (size_t)tok * D + 4 * kg + 32 * ks; u32x2 s0_, s1_; s0_.x = hv.x; s0_.y = hv.y; s1_.x = hv.z; s1_.y = hv.w; *(u32x2*)xo_ = s0_; *(u32x2*)(xo_ + 16) = s1_; }
            const bf16x8 Bh = __builtin_bit_cast(bf16x8, hv), Bl = __builtin_bit_cast(bf16x8, lv);
            const int ch = ((4 * ks + kg) ^ tl) << 4;
            const bf16x8 A0h = *(const LAS bf16x8*)(WTh + tl * 2048 + ch), A0l = *(const LAS bf16x8*)(WTl + tl * 2048 + ch);
            const bf16x8 A1h = *(const LAS bf16x8*)(WTh + (16 + tl) * 2048 + ch), A1l = *(const LAS bf16x8*)(WTl + (16 + tl) * 2048 + ch);
            acc0 = __builtin_amdgcn_mfma_f32_16x16x32_bf16(A0h, Bh, acc0, 0, 0, 0); acc0 = __builtin_amdgcn_mfma_f32_16x16x32_bf16(A0h, Bl, acc0, 0, 0, 0); acc0 = __builtin_amdgcn_mfma_f32_16x16x32_bf16(A0l, Bh, acc0, 0, 0, 0);
            acc1 = __builtin_amdgcn_mfma_f32_16x16x32_bf16(A1h, Bh, acc1, 0, 0, 0); acc1 = __builtin_amdgcn_mfma_f32_16x16x32_bf16(A1h, Bl, acc1, 0, 0, 0); acc1 = __builtin_amdgcn_mfma_f32_16x16x32_bf16(A1l, Bh, acc1, 0, 0, 0);
        }
        ssq += __shfl_xor(ssq, 16); ssq += __shfl_xor(ssq, 32);
        const float rstd = rsqrtf(ssq * (1.0f / 1024.0f) + EPS);
        float lg[8];
#pragma unroll
        for (int i = 0; i < 4; ++i) { lg[i] = rstd * acc0[i] + cbl[4 * kg + i]; lg[4 + i] = rstd * acc1[i] + cbl[16 + 4 * kg + i]; }
        int sel[4]; float val[4];
#pragma unroll
        for (int p = 0; p < 4; ++p) {
            float bv = lg[0]; int bi = 4 * kg;
#pragma unroll
            for (int i = 1; i < 8; ++i) { const int ei = (i < 4 ? 0 : 12) + 4 * kg + i; if (lg[i] > bv) { bv = lg[i]; bi = ei; } }
#pragma unroll
            for (int o = 16; o <= 32; o <<= 1) { const float ov = __shfl_xor(bv, o); const int oi = __shfl_xor(bi, o); if (ov > bv || (ov == bv && oi < bi)) { bv = ov; bi = oi; } }
            sel[p] = bi; val[p] = bv;
#pragma unroll
            for (int i = 0; i < 8; ++i) { const int ei = (i < 4 ? 0 : 12) + 4 * kg + i; if (ei == bi) lg[i] = -3.0e38f; }
        }
        const float e1 = __expf(val[1] - val[0]), e2 = __expf(val[2] - val[0]), e3 = __expf(val[3] - val[0]); const float inv = 1.0f / (1.0f + e1 + e2 + e3);
        if (kg == 0) {
            *(i32x4*)(toke + (size_t)tok * 4) = (i32x4){sel[0], sel[1], sel[2], sel[3]}; *(f32x4*)(tokg + (size_t)tok * 4) = (f32x4){inv, e1 * inv, e2 * inv, e3 * inv};
#pragma unroll
            for (int p = 0; p < 4; ++p) __hip_atomic_fetch_add(wcnt + F.wave * 32 + sel[p], 1, __ATOMIC_RELAXED, __HIP_MEMORY_SCOPE_WORKGROUP);
        }
        asm volatile("s_waitcnt vmcnt(0)" ::: "memory");
        float gm[16], sh[16];
#pragma unroll
        for (int q = 0; q < 4; ++q) { const f32x4 gg = *(const f32x4*)(g + 16 * F.lane + 4 * q), sc = *(const f32x4*)(scp + 16 * F.lane + 4 * q), s4 = *(const f32x4*)(shp + 16 * F.lane + 4 * q);
#pragma unroll
            for (int jx = 0; jx < 4; ++jx) { gm[4 * q + jx] = gg[jx] * (1.0f + sc[jx]); sh[4 * q + jx] = s4[jx]; } }
#pragma unroll 4
        for (int t = 0; t < 16; ++t) {
            const float rs = __shfl(rstd, t); const size_t ro = (size_t)(row0 + 16 * F.wave + t) * D + 16 * F.lane;
            f32x4 xv[4];
            { const u32x4 g0 = *(const u32x4*)(X1B + ro), g1 = *(const u32x4*)(X1B + ro + 8);
              xv[0][0] = bflo(g0.x); xv[0][1] = bfhi(g0.x); xv[0][2] = bflo(g0.y); xv[0][3] = bfhi(g0.y); xv[1][0] = bflo(g0.z); xv[1][1] = bfhi(g0.z); xv[1][2] = bflo(g0.w); xv[1][3] = bfhi(g0.w);
              xv[2][0] = bflo(g1.x); xv[2][1] = bfhi(g1.x); xv[2][2] = bflo(g1.y); xv[2][3] = bfhi(g1.y); xv[3][0] = bflo(g1.z); xv[3][1] = bfhi(g1.z); xv[3][2] = bflo(g1.w); xv[3][3] = bfhi(g1.w); }
            u32x4 w;
            w.x = cvt_pk_fp8x4(xv[0][0] * rs * gm[0] + sh[0], xv[0][1] * rs * gm[1] + sh[1], xv[0][2] * rs * gm[2] + sh[2], xv[0][3] * rs * gm[3] + sh[3]);
            w.y = cvt_pk_fp8x4(xv[1][0] * rs * gm[4] + sh[4], xv[1][1] * rs * gm[5] + sh[5], xv[1][2] * rs * gm[6] + sh[6], xv[1][3] * rs * gm[7] + sh[7]);
            w.z = cvt_pk_fp8x4(xv[2][0] * rs * gm[8] + sh[8], xv[2][1] * rs * gm[9] + sh[9], xv[2][2] * rs * gm[10] + sh[10], xv[2][3] * rs * gm[11] + sh[11]);
            w.w = cvt_pk_fp8x4(xv[3][0] * rs * gm[12] + sh[12], xv[3][1] * rs * gm[13] + sh[13], xv[3][2] * rs * gm[14] + sh[14], xv[3][3] * rs * gm[15] + sh[15]);
            *(u32x4*)(H8 + ro) = w;
        }
    }
    __syncthreads();
    if (F.tid < 256) cnt[F.blk * 256 + F.tid] = wcnt[F.tid];
    __syncthreads();
}

DI void phase_slots(const Frame& F) {
    LAS int* part = (LAS int*)F.lds;
    LAS int* tot = part + 1024; LAS int* bef = tot + 32; LAS int* pst = bef + 32; LAS int* base = pst + 32;
    const int* cnt = (const int*)(F.ws + WS_CNT); const int* toke = (const int*)(F.ws + WS_TOKE);
    int* toks = (int*)(F.ws + WS_TOKS); int* rowtok = (int*)(F.ws + WS_ROWTOK); int* tile = (int*)(F.ws + WS_TILE);
    const int nrows = F.G * 8;
    { const int e = F.tid & 31, pt = F.tid >> 5; int sa = 0, sb = 0; const int per = (nrows + 15) / 16;
      const int r0 = pt * per, r1 = ((pt + 1) * per < nrows) ? (pt + 1) * per : nrows;
#pragma unroll 16
      for (int rw = r0; rw < r1; ++rw) { const int c = cnt[rw * 32 + e]; sa += c; sb += (rw < F.blk * 8) ? c : 0; }
      part[pt * 32 + e] = sa; part[512 + pt * 32 + e] = sb; }
    __syncthreads();
    if (F.tid < 32) { int sa = 0, sb = 0; for (int pt = 0; pt < 16; ++pt) { sa += part[pt * 32 + F.tid]; sb += part[512 + pt * 32 + F.tid]; } tot[F.tid] = sa; bef[F.tid] = sb; }
    __syncthreads();
    if (F.tid == 0) { int run = 0; for (int e = 0; e < 32; ++e) { pst[e] = run; run += (tot[e] + 255) / 256 * 256; }
        if (F.blk == 0) { tile[1000] = run / 256; } }
    __syncthreads();
    if (F.tid < 256) { const int w = F.tid >> 5, e = F.tid & 31; int s = pst[e] + bef[e]; for (int w2 = 0; w2 < w; ++w2) s += cnt[(F.blk * 8 + w2) * 32 + e]; base[w * 32 + e] = s; }
    if (F.blk == 0) { for (int i = F.tid; i < 544; i += 512) { int e = 0; for (int q = 0; q < 32; ++q) if (i * 256 >= pst[q] + (tot[q] + 255) / 256 * 256) e = q + 1; tile[i] = e < 31 ? e : 31; } }
    if (F.blk < 32) { const int e = F.blk; const int s0 = pst[e] + tot[e], s1 = pst[e] + (tot[e] + 255) / 256 * 256; for (int s = s0 + F.tid; s < s1; s += 512) rowtok[s] = 0; }
    __syncthreads();
    for (int it = 0;; ++it) {
        const int row0 = (it * F.G + F.blk) * 128; if (row0 >= T) break;
        const int wr0 = row0 + 16 * F.wave;
        const int ev = toke[wr0 * 4 + F.lane];
        for (int t = 0; t < 16; ++t) { const int row = wr0 + t; const int e = __shfl(ev, 4 * t + (F.lane & 3));
            if (F.lane < 4) { const int s = __hip_atomic_fetch_add(base + F.wave * 32 + e, 1, __ATOMIC_RELAXED, __HIP_MEMORY_SCOPE_WORKGROUP);
                toks[row * 4 + F.lane] = s; rowtok[s] = row; } }
    }
    __syncthreads();
}

DI void fp8x4_to_f32(unsigned w, float (&o)[4]) { typedef float f2_ __attribute__((ext_vector_type(2))); const f2_ a = __builtin_amdgcn_cvt_pk_f32_fp8(w, false), b = __builtin_amdgcn_cvt_pk_f32_fp8(w, true); o[0] = a[0]; o[1] = a[1]; o[2] = b[0]; o[3] = b[1]; }
DI void final_row_load(const bf16_t* X1B, const unsigned char* YA, int row, const i32x4 sl, int lane, u32x4 (&ya)[4], u32x4 (&x1)[2]) {
    const int c0 = 16 * lane;
#pragma unroll
    for (int k = 0; k < 4; ++k) ya[k] = *(const u32x4*)(YA + (size_t)sl[k] * 1024 + c0);
    x1[0] = *(const u32x4*)(X1B + (size_t)row * D + c0); x1[1] = *(const u32x4*)(X1B + (size_t)row * D + c0 + 8);
}
DI void final_row_finish(const float* modgt, const float* gfin, float* out, int row, const f32x4 gk, int lane, const u32x4 (&ya)[4], const u32x4 (&x1)[2]) {
    const int c0 = 16 * lane; float ss = 0.f; f32x4 xo[4];
#pragma unroll
    for (int q = 0; q < 4; ++q) {
        f32x4 m4 = (f32x4){0.f, 0.f, 0.f, 0.f};
#pragma unroll
        for (int k = 0; k < 4; ++k) { float y[4]; fp8x4_to_f32(ya[k][q], y); m4[0] += gk[k] * y[0]; m4[1] += gk[k] * y[1]; m4[2] += gk[k] * y[2]; m4[3] += gk[k] * y[3]; }
        const f32x4 gt = *(const f32x4*)(modgt + c0 + 4 * q);
        f32x4 g4; const unsigned ga = x1[q >> 1][2 * (q & 1)], gb = x1[q >> 1][2 * (q & 1) + 1]; g4[0] = bflo(ga); g4[1] = bfhi(ga); g4[2] = bflo(gb); g4[3] = bfhi(gb);
        const f32x4 x2 = g4 + gt * m4; xo[q] = x2; ss += x2[0] * x2[0] + x2[1] * x2[1] + x2[2] * x2[2] + x2[3] * x2[3]; }
    ss = wave_sum(ss); const float rstd = rsqrtf(ss * (1.0f / 1024.0f) + EPS);
#pragma unroll
    for (int q = 0; q < 4; ++q) { const f32x4 gg = *(const f32x4*)(gfin + c0 + 4 * q); *(f32x4*)(out + (size_t)row * D + c0 + 4 * q) = xo[q] * rstd * gg; }
}
DI void phase_final(const Frame& F) {
    const bf16_t* X1B = (const bf16_t*)(F.ws + WS_CAT); const unsigned char* YA = (const unsigned char*)(F.ws + WS_YA); const int* toks = (const int*)(F.ws + WS_TOKS); const float* tokg = (const float*)(F.ws + WS_TOKG);
    const float* mod = (const float*)(F.ws + WS_MOD); const float* gfin = F.in[I_GFIN]; float* out = F.out;
    for (int it = 0;; ++it) {
        const int row0 = (it * F.G + F.blk) * 128 + 16 * F.wave; if (row0 >= T) break;
        const float* modgt = mod + (row0 >> 12) * 6144 + 5120;
        const i32x4 slv = *(const i32x4*)(toks + (size_t)(row0 + (F.lane & 15)) * 4); const f32x4 gkv = *(const f32x4*)(tokg + (size_t)(row0 + (F.lane & 15)) * 4);
#pragma unroll 1
        for (int t = 0; t < 16; t += 4) {
            i32x4 s_[4]; f32x4 g_[4];
#pragma unroll
            for (int r = 0; r < 4; ++r)
#pragma unroll
                for (int k = 0; k < 4; ++k) { s_[r][k] = __shfl(slv[k], t + r); g_[r][k] = __shfl(gkv[k], t + r); }
            u32x4 ya_[4][4], x1_[4][2];
#pragma unroll
            for (int r = 0; r < 4; ++r) final_row_load(X1B, YA, row0 + t + r, s_[r], F.lane, ya_[r], x1_[r]);
#pragma unroll
            for (int r = 0; r < 4; ++r) final_row_finish(modgt, gfin, out, row0 + t + r, g_[r], F.lane, ya_[r], x1_[r]);
        }
    }
}

__global__ void __launch_bounds__(512, 2) fwd_kernel(Args args) {
    extern __shared__ __attribute__((aligned(16))) unsigned char lds_raw[];
    Frame F;
    F.lds = (LAS unsigned char*)lds_raw; F.tid = threadIdx.x; F.lane = F.tid & 63; F.wave = __builtin_amdgcn_readfirstlane(F.tid >> 6);
    F.G = gridDim.x; F.blk = blockIdx.x; F.vcu = (F.G % 8 == 0) ? (F.blk % 8) * (F.G / 8) + F.blk / 8 : F.blk;
#pragma unroll
    for (int i = 0; i < 27; ++i) F.in[i] = args.in[i];
    F.out = args.out; F.ws = args.ws;
    volatile LAS unsigned* MISC = (volatile LAS unsigned*)(F.lds + MISC_OFF);
    if (F.tid < 64) MISC[F.tid] = 0u;
    __syncthreads();
    const int lo = args.ph_lo, hi = args.ph_hi;
    unsigned* barw = (unsigned*)(F.ws + WS_CTL) + CW_BAR;
    XcdBarrier bar; bar.bar = barw; bar.x = 0; bar.st = nullptr;
    if (hi - lo > 1) bar = xcd_barrier_post(barw, MISC + 8);
#ifndef PH_MASK
#define PH_MASK 0xfff
#endif
#define IN(k) (((PH_MASK >> (k)) & 1) && lo <= (k) && (k) < hi)
#define SEAM(k) do { if (IN(k) && IN((k) + 1)) xcd_barrier(bar); } while (0)
    LAS unsigned char* ring = F.lds;

    if (IN(0)) { phase0(F); } SEAM(0);
    if (IN(1)) { phase1(F); } SEAM(1);
    if (IN(2)) {
        pg8::Gemm g{(const bf16_t*)(F.ws + WS_H), (const bf16_t*)(F.ws + WS_WIN), 1024};
        pg8::SchedPlain S{T / 256, 6, F.G, F.vcu}; pg8::EpiBf16Plain E{(bf16_t*)(F.ws + WS_XP), 1536};
        pg8::gemm_phase(ring, g, S, E);
    } SEAM(2);
    if (IN(3)) { phase3(F); } SEAM(3);
    if (IN(4)) { phase4(F); } SEAM(4);
    if (IN(6)) {
        pg8::Gemm g{(const bf16_t*)(F.ws + WS_CAT), (const bf16_t*)(F.ws + WS_WOUT), 1024};
        pg8::SchedPlain S{T / 256, 4, F.G, F.vcu}; pg8::EpiGmix E{(const float*)(F.ws + WS_MOD), (bf16_t*)(F.ws + WS_GMIX)};
        pg8::gemm_phase(ring, g, S, E);
    } SEAM(6);
    if (IN(7)) { phase_router(F); } SEAM(7);
    if (IN(8)) { phase_slots(F); } SEAM(8);
    if (IN(9)) {
        pg8::Gemm g{(const bf16_t*)(F.ws + WS_H), (const bf16_t*)(F.ws + WS_WGU), 512};
        pg8::SchedMoe::setup(F.lds, (const int*)(F.ws + WS_TILE), (const int*)(F.ws + WS_ROWTOK), F.in[I_BGU], 8, F.G, F.vcu, F.tid, false);
        pg8::SchedMoe S{(LAS const int*)(F.lds + UT_OFF), (LAS const unsigned short*)(F.lds + RTL_OFF), 8, F.G, F.vcu, true}; pg8::EpiAct E{(LAS const float*)(F.lds + BL_OFF), (unsigned char*)(F.ws + WS_ACT)};
        pg8::gemm_phase(ring, g, S, E);
    } SEAM(9);
    if (IN(10)) {
        pg8::Gemm g{(const bf16_t*)(F.ws + WS_ACT), (const bf16_t*)(F.ws + WS_WDOWN), 512};
        pg8::SchedMoe::setup(F.lds, (const int*)(F.ws + WS_TILE), nullptr, F.in[I_BD], 4, F.G, F.vcu, F.tid, true);
        pg8::SchedMoe S{(LAS const int*)(F.lds + UT_OFF), (LAS const unsigned short*)(F.lds + RTL_OFF), 4, F.G, F.vcu, false}; pg8::EpiDown E{(LAS const float*)(F.lds + BL_OFF), (unsigned char*)(F.ws + WS_YA)};
        pg8::gemm_phase(ring, g, S, E);
    } SEAM(10);
    if (IN(11)) { phase_final(F); }
#undef IN
#undef SEAM
}

extern "C" void kernel_launch(void* const* d_in, const int* in_sizes, int n_in, void* d_out, int out_size, void* d_ws, size_t ws_size, hipStream_t stream) {
    static int grid = 0;
    if (grid == 0) {
        if (n_in != 27 || out_size != T * D || ws_size < WS_END) { fprintf(stderr, "kernel_launch: unexpected shapes (n_in %d out %d ws %zu)\n", n_in, out_size, ws_size); grid = -1; return; }
        int dev = 0, cus = 0, per_cu = 0;
        if (hipGetDevice(&dev) != hipSuccess || hipDeviceGetAttribute(&cus, hipDeviceAttributeMultiprocessorCount, dev) != hipSuccess) { grid = -1; return; }
        if (hipFuncSetAttribute((const void*)fwd_kernel, hipFuncAttributeMaxDynamicSharedMemorySize, LDS_BYTES) != hipSuccess) { fprintf(stderr, "kernel_launch: hipFuncSetAttribute failed\n"); grid = -1; return; }
        if (hipOccupancyMaxActiveBlocksPerMultiprocessor(&per_cu, (const void*)fwd_kernel, 512, LDS_BYTES) != hipSuccess || per_cu < 1) { fprintf(stderr, "kernel_launch: occupancy query says %d\n", per_cu); }
        (void)hipGetLastError();
        grid = cus;
    }
    if (grid < 0) return;
    (void)hipMemsetAsync((char*)d_ws + WS_CTL, 0, CTL_BYTES, stream);
    Args a{};
    for (int i = 0; i < 27; ++i) a.in[i] = (const float*)d_in[i];
    a.out = (float*)d_out; a.ws = (unsigned char*)d_ws;
#if N_LAUNCH_MODE == 1
    a.ph_lo = 0; a.ph_hi = NPHASE;
    hipLaunchKernelGGL(fwd_kernel, dim3(grid), dim3(512), LDS_BYTES, stream, a);
#else
    for (int p = 0; p < NPHASE; ++p) { a.ph_lo = p; a.ph_hi = p + 1; hipLaunchKernelGGL(fwd_kernel, dim3(grid), dim3(512), LDS_BYTES, stream, a); }
#endif
}
```

```cpp
#include <hip/hip_runtime.h>
#include <stdint.h>
#include <stdio.h>

#define DI __device__ __forceinline__
#define LAS __attribute__((address_space(3)))
typedef unsigned short bf16_t;
typedef short bf16x8 __attribute__((ext_vector_type(8)));
typedef float f32x4 __attribute__((ext_vector_type(4)));
typedef float f32x16 __attribute__((ext_vector_type(16)));
typedef unsigned u32x4 __attribute__((ext_vector_type(4)));
typedef unsigned u32x2 __attribute__((ext_vector_type(2)));
typedef int i32x4 __attribute__((ext_vector_type(4)));
typedef int i32x8 __attribute__((ext_vector_type(8)));

constexpr int D = 1024, NB = 8, SEQ = 4096, T = NB * SEQ, CTXL = 256, TC = NB * CTXL, TT = T + TC;
constexpr int NE = 32;
constexpr int CAP = (T * 4 / 256 + NE) * 256;
constexpr int NCH = 68;
constexpr float EPS = 1e-6f;
#ifndef N_LAUNCH_MODE
#define N_LAUNCH_MODE 1
#endif
constexpr int NPHASE = 12;

constexpr size_t MiB = 1u << 20;
constexpr size_t WS_CTL = 0, CTL_BYTES = 1 * MiB;
constexpr size_t WS_MOD = 1 * MiB;
constexpr size_t WS_RGW = 1 * MiB + 256 * 1024;
constexpr size_t WS_SP8 = 1 * MiB + 576 * 1024;
constexpr size_t WS_TILE = 1 * MiB + 512 * 1024;
constexpr size_t WS_CNT = 2 * MiB;
constexpr size_t WS_CNTB = 2 * MiB + 384 * 1024;
constexpr size_t WS_CF = 2 * MiB + 256 * 1024;
constexpr size_t WS_WMF = 2 * MiB + 512 * 1024;
constexpr size_t WS_TOKE = 3 * MiB;
constexpr size_t WS_TOKG = 3 * MiB + 512 * 1024;
constexpr size_t WS_TOKS = 4 * MiB;
constexpr size_t WS_ROWTOK = 4 * MiB + 512 * 1024;
constexpr size_t WS_ROWGATE = 5 * MiB + 256 * 1024;
constexpr size_t WS_SUMP = 6 * MiB;
constexpr size_t WS_SUMH = 8 * MiB + 256 * 1024;
constexpr size_t WS_WIN = 11 * MiB;
constexpr size_t WS_WRT = 14 * MiB;
constexpr size_t WS_CBG = 2 * MiB + 320 * 1024;
constexpr size_t WS_WOUT = 15 * MiB;
constexpr size_t WS_WDOWN = 17 * MiB;
constexpr size_t WS_WGU = 49 * MiB;
constexpr size_t WS_H = 113 * MiB;
constexpr size_t WS_GMIX = 181 * MiB;
constexpr size_t WS_YA = 309 * MiB;
constexpr size_t WS_XP = 581 * MiB;
constexpr size_t WS_ZG = 683 * MiB;
constexpr size_t WS_CAT = 747 * MiB;
constexpr size_t WS_SS = 843 * MiB;
constexpr size_t WS_CAF = 875 * MiB;
constexpr size_t WS_CAB = 907 * MiB;
constexpr size_t WS_ACT = 581 * MiB;
constexpr size_t WS_END = 939 * MiB;
static_assert(WS_ACT + (size_t)CAP * 1024 <= WS_CAT && WS_YA + (size_t)CAP * 2048 <= WS_XP && WS_XP + (size_t)TT * 3072 <= WS_ZG && WS_ROWGATE + CAP * 4 <= WS_SUMP && WS_SUMH + 8 * 2 * 68 * 512 * 4 <= WS_WIN, "ws map");

constexpr int CW_BAR = 4096;
constexpr int LDS_BYTES = 163840;
constexpr int MISC_OFF = 135168;
constexpr int UT_OFF = MISC_OFF + 2048, RTL_OFF = MISC_OFF + 2560, BL_OFF = MISC_OFF + 11264, MAXU = 17;
static_assert(RTL_OFF + MAXU * 512 <= BL_OFF && BL_OFF + MAXU * 1024 <= LDS_BYTES, "LDS map");

DI unsigned cvt_pk_bf16(float lo, float hi) { unsigned r; asm("v_cvt_pk_bf16_f32 %0, %1, %2" : "=v"(r) : "v"(lo), "v"(hi)); return r; }
DI float bflo(unsigned w) { return __uint_as_float(w << 16); }
DI float bfhi(unsigned w) { return __uint_as_float(w & 0xffff0000u); }
DI float bf2f(bf16_t b) { return __uint_as_float(((unsigned)b) << 16); }
DI bf16_t f2bf(float f) { return (bf16_t)(cvt_pk_bf16(f, 0.f) & 0xffffu); }
#define GAS __attribute__((address_space(1)))
DI void stg16(bf16_t* p, bf16_t v) { *(GAS bf16_t*)p = v; }
DI void stg8(unsigned char* p, unsigned char v) { *(GAS unsigned char*)p = v; }
DI unsigned cvt_pk_fp8x4(float a, float b, float c, float d) { unsigned r = 0; r = __builtin_amdgcn_cvt_pk_fp8_f32(a, b, r, false); r = __builtin_amdgcn_cvt_pk_fp8_f32(c, d, r, true); return r; }
template <int CTRL, int ROWMASK> DI float dpp_get0(float v) { return __builtin_bit_cast(float, __builtin_amdgcn_update_dpp(0, __builtin_bit_cast(int, v), CTRL, ROWMASK, 0xF, false)); }
DI float wave_sum(float v) {
    v += dpp_get0<0xB1, 0xF>(v);
    v += dpp_get0<0x4E, 0xF>(v);
    v += dpp_get0<0x141, 0xF>(v);
    v += dpp_get0<0x140, 0xF>(v);
    v += dpp_get0<0x142, 0xA>(v);
    v += dpp_get0<0x143, 0xC>(v);
    return __builtin_bit_cast(float, __builtin_amdgcn_readlane(__builtin_bit_cast(int, v), 63));
}
DI float sigmoidf_(float x) { return __builtin_amdgcn_rcpf(1.0f + __expf(-x)); }
DI float gelu_tanh(float x) { const float z = 0.7978845608028654f * (x + 0.044715f * x * x * x); const float e = __expf(2.0f * z); return x * (1.0f - __builtin_amdgcn_rcpf(1.0f + e)); }

#define XB_TMO      128
#define XB_XCNT(j)  (256  + 64 * (j))
#define XB_XSUB(j)  (1280 + 64 * (j))
#define XB_XGEN(j)  (2304 + 64 * (j))
#define XB_TOP      3328
#define XB_TOPGEN   3392
#define XCD_BAR_WORDS 3456
#define XB_SPIN_CAP (1u << 18)
DI unsigned xb_ld(unsigned* p)              { return __hip_atomic_load(p, __ATOMIC_RELAXED, __HIP_MEMORY_SCOPE_AGENT); }
DI unsigned xb_add(unsigned* p, unsigned v) { return __hip_atomic_fetch_add(p, v, __ATOMIC_RELAXED, __HIP_MEMORY_SCOPE_AGENT); }
DI unsigned xb_xcc_id() { return (unsigned)__builtin_amdgcn_s_getreg((3 << 11) | 20) & 0xFu; }
#define XB_SPIN(cond, bar) do { unsigned _sp = 0; while (cond) { __builtin_amdgcn_s_sleep(1); \
    if ((++_sp & 255u) == 0u) { if (xb_ld(&(bar)[XB_TMO])) break; if (_sp > XB_SPIN_CAP) { atomicAdd(&(bar)[XB_TMO], 1u); break; } } } } while (0)
struct XcdBarrier { unsigned* bar; unsigned x; volatile LAS unsigned* st; };
DI XcdBarrier xcd_barrier_post(unsigned* bar, volatile LAS unsigned* st) {
    XcdBarrier b; b.bar = bar; b.x = xb_xcc_id(); b.st = st;
    if (threadIdx.x == 0) (void)xb_add(&bar[XB_XCNT(b.x)], 1u);
    return b;
}
DI void xcd_barrier_complete(unsigned* bar, unsigned x, unsigned& nloc, unsigned& nx) {
    const unsigned G = gridDim.x * gridDim.y * gridDim.z;
    unsigned sum, cnt, mine, sp = 0u;
    for (;;) {
        sum = 0u; cnt = 0u; mine = 0u;
#pragma unroll
        for (unsigned j = 0; j < 16; ++j) { const unsigned c = xb_ld(&bar[XB_XCNT(j)]); sum += c; cnt += (c > 0u) ? 1u : 0u; mine = (j == x) ? c : mine; }
        if (sum == G) break;
        __builtin_amdgcn_s_sleep(1);
        if ((++sp & 255u) == 0u) { if (xb_ld(&bar[XB_TMO])) break; if (sp > XB_SPIN_CAP) { atomicAdd(&bar[XB_TMO], 1u); break; } }
    }
    nloc = mine > 0u ? mine : 1u; nx = cnt > 0u ? cnt : 1u;
}
DI void subset_barrier(unsigned* ctr, unsigned n) {
    asm volatile("s_waitcnt vmcnt(0)" ::: "memory");
    __syncthreads();
    if (threadIdx.x == 0) {
        __builtin_amdgcn_fence(__ATOMIC_RELEASE, "agent");
        asm volatile("s_waitcnt vmcnt(0)" ::: "memory");
        (void)xb_add(ctr, 1u);
        unsigned sp = 0u; while (xb_ld(ctr) < n) { __builtin_amdgcn_s_sleep(1); if (++sp > (XB_SPIN_CAP << 2)) break; }
        __builtin_amdgcn_fence(__ATOMIC_ACQUIRE, "agent");
        asm volatile("s_waitcnt vmcnt(0)" ::: "memory");
    }
    __syncthreads();
}
DI void xcd_barrier(const XcdBarrier& b) {
    asm volatile("s_waitcnt vmcnt(0)" ::: "memory");
    __syncthreads();
    if (threadIdx.x == 0) {
        unsigned* bar = b.bar;
        __builtin_amdgcn_s_waitcnt(0);
        unsigned nloc = b.st[0], nx = b.st[1];
        if (nloc == 0u) { xcd_barrier_complete(bar, b.x, nloc, nx); b.st[0] = nloc; b.st[1] = nx; }
        const unsigned old = xb_add(&bar[XB_XSUB(b.x)], 1u);
        const unsigned gen = old / nloc;
        if (old + 1u == (gen + 1u) * nloc) {
            __builtin_amdgcn_fence(__ATOMIC_RELEASE, "agent");
            asm volatile("s_waitcnt vmcnt(0)" ::: "memory");
            const unsigned og = xb_add(&bar[XB_TOP], 1u);
            const unsigned tg = og / nx;
            if (og + 1u == (tg + 1u) * nx) xb_add(&bar[XB_TOPGEN], 1u);
            else XB_SPIN(xb_ld(&bar[XB_TOPGEN]) == tg, bar);
            __builtin_amdgcn_fence(__ATOMIC_ACQUIRE, "agent");
            xb_add(&bar[XB_XGEN(b.x)], 1u);
            asm volatile("s_waitcnt vmcnt(0)" ::: "memory");
        } else {
            XB_SPIN(xb_ld(&bar[XB_XGEN(b.x)]) == gen, bar);
            __builtin_amdgcn_fence(__ATOMIC_ACQUIRE, "agent");
            asm volatile("s_waitcnt vmcnt(0)" ::: "memory");
        }
    }
    __syncthreads();
}

namespace pg8 {
constexpr int BM = 256, BK = 64, HALF = 128, HTB = HALF * BK * 2;
DI int lds_byte(int r, int c) { const int st = (r >> 4) * 2 + (c >> 5), rr = r & 15, cc = c & 31, ob = rr * 64 + cc * 2; return st * 1024 + (ob ^ (((ob >> 9) & 1) << 5)); }
DI void stage_rc(int b, int& R, int& C) { const int st = b / 1024, sb = b % 1024, swz = sb ^ (((sb >> 9) & 1) << 5); R = (st >> 1) * 16 + swz / 64; C = (st & 1) * 32 + (swz % 64) / 2; }
DI int perm32(int rho) { const int n = rho >> 4, i = rho & 15; return 8 * (i >> 2) + 4 * n + (i & 3); }
struct Unit { int pm, pn, aux, ix; };
struct Gemm { const bf16_t* A; const bf16_t* Bt; int K; };

template <class Epi, class Sched>
DI void gemm_phase(LAS unsigned char* lds, const Gemm g, const Sched& S, const Epi& E) {
    const int tid = threadIdx.x, wid = __builtin_amdgcn_readfirstlane(tid >> 6), lane = tid & 63, wr = wid >> 2, wc = wid & 3, fr = lane & 15, fq = lane >> 4;
    const int K = g.K, nt = K / BK;
    int RA[2], CA[2]; unsigned voffB[2];
#pragma unroll
    for (int i = 0; i < 2; ++i) { int R, C; stage_rc(tid * 16 + i * 8192, R, C); const int Rb = Epi::PERM ? ((R & ~31) + perm32(R & 31)) : R;
        RA[i] = R; CA[i] = C; voffB[i] = Sched::TILED_B ? (unsigned)(Rb * 128 + C * 2) : (unsigned)(Rb * K + C) * 2u; }
    const unsigned kstep = Sched::TILED_B ? 32768u : (unsigned)(BK * 2), kstepA = S.kstep_a();
    const size_t hstep = Sched::TILED_B ? (size_t)HALF * 128 : (size_t)HALF * K * 2;
    const unsigned ldsw = (unsigned)wid * 1024u;
    const int aoff = lds_byte(wr * 64 + fr, fq * 8), boff = lds_byte(wc * 32 + fr, fq * 8);
#define PG8_SA(b, h) (((b) * 2 + (h)) * HTB)
#define PG8_SB(b, h) ((4 + (b) * 2 + (h)) * HTB)
#define PG8_STAGE_B(bufoff, gbase) do { _Pragma("unroll") for (int _i = 0; _i < 2; ++_i) \
        __builtin_amdgcn_global_load_lds((const unsigned*)((const char*)(gbase) + voffB[_i]), (LAS unsigned*)(lds + (bufoff) + ldsw + _i * 8192), 16, 0, 0); } while (0)
#define PG8_STAGE_A(bufoff, kb, o, h) do { _Pragma("unroll") for (int _i = 0; _i < 2; ++_i) \
        __builtin_amdgcn_global_load_lds((const unsigned*)((const char*)g.A + (size_t)(kb) + (o)[h][_i]), (LAS unsigned*)(lds + (bufoff) + ldsw + _i * 8192), 16, 0, 0); } while (0)
#define PG8_LDA(dst, b, h) do { if constexpr (Epi::FP8) { _Pragma("unroll") for (int m = 0; m < 4; ++m) { \
            const i32x4 lo_ = *(const LAS i32x4*)(lds + PG8_SA(b, h) + aoff + m * 2048), hi_ = *(const LAS i32x4*)(lds + PG8_SA(b, h) + aoff + m * 2048 + 1024); \
            dst##8[m] = __builtin_shufflevector(lo_, hi_, 0, 1, 2, 3, 4, 5, 6, 7); } } \
        else { _Pragma("unroll") for (int m = 0; m < 4; ++m) _Pragma("unroll") for (int k = 0; k < 2; ++k) dst[m][k] = *(const LAS bf16x8*)(lds + PG8_SA(b, h) + aoff + m * 2048 + k * 1024); } } while (0)
#define PG8_LDB(dst, b, h) do { if constexpr (Epi::FP8) { _Pragma("unroll") for (int n = 0; n < 2; ++n) { \
            const i32x4 lo_ = *(const LAS i32x4*)(lds + PG8_SB(b, h) + boff + n * 2048), hi_ = *(const LAS i32x4*)(lds + PG8_SB(b, h) + boff + n * 2048 + 1024); \
            dst##8[n] = __builtin_shufflevector(lo_, hi_, 0, 1, 2, 3, 4, 5, 6, 7); } } \
        else { _Pragma("unroll") for (int n = 0; n < 2; ++n) _Pragma("unroll") for (int k = 0; k < 2; ++k) dst[n][k] = *(const LAS bf16x8*)(lds + PG8_SB(b, h) + boff + n * 2048 + k * 1024); } } while (0)
#define PG8_MMA(ai, bj, At, Bt) do { if constexpr (!Epi::FP8) __builtin_amdgcn_s_setprio(1); \
        if constexpr (Epi::FP8) { _Pragma("unroll") for (int m = 0; m < 4; ++m) _Pragma("unroll") for (int n = 0; n < 2; ++n) \
            asm volatile("v_mfma_scale_f32_16x16x128_f8f6f4 %0, %1, %2, %0, %3, %4 op_sel_hi:[0,0,0]" : "+v"(acc[ai][bj][m][n]) : "v"(Bt##8[n]), "v"(At##8[m]), "v"(scale_w_), "v"(scale_a_)); } \
        else { _Pragma("unroll") for (int m = 0; m < 4; ++m) _Pragma("unroll") for (int n = 0; n < 2; ++n) _Pragma("unroll") for (int k = 0; k < 2; ++k) \
            acc[ai][bj][m][n] = __builtin_amdgcn_mfma_f32_16x16x32_bf16(Bt[n][k], At[m][k], acc[ai][bj][m][n], 0, 0, 0); } \
        if constexpr (!Epi::FP8) __builtin_amdgcn_s_setprio(0); } while (0)
#define PG8_WAIT_V(n) asm volatile("s_waitcnt vmcnt(" #n ")" ::: "memory")
#define PG8_WAIT_L(n) asm volatile("s_waitcnt lgkmcnt(" #n ")" ::: "memory")
#define PG8_BAR __builtin_amdgcn_s_barrier()
#define PG8_SCHED __builtin_amdgcn_sched_barrier(0)
    Unit cur, nxt; int ui = 0;
    if (!S.next(0, cur)) return;
    if constexpr (Epi::FP8) { if (wid >= 4) __builtin_amdgcn_s_setprio(1); }
    f32x4 acc[2][2][4][2];
    E.init(acc, cur, wc, fq);
    int scale_w_ = Epi::SCALE_W, scale_a_ = 0x7f7f7f7f; asm volatile("" : "+v"(scale_w_), "+v"(scale_a_));
    bf16x8 At[4][2], B0[2][2], B1[2][2]; i32x8 At8[4], B08[2], B18[2];
    unsigned oc[2][2], on[2][2];
    S.a_off(cur, RA, CA, K, oc);
    const char* cB = (const char*)g.Bt + S.b_off(cur, K);
    PG8_STAGE_B(PG8_SB(0, 0), cB); PG8_STAGE_A(PG8_SA(0, 0), 0u, oc, 0); PG8_STAGE_B(PG8_SB(0, 1), cB + hstep); PG8_STAGE_A(PG8_SA(0, 1), 0u, oc, 1);
    if (wr == 1) PG8_BAR;
    PG8_WAIT_V(4); PG8_BAR;
    PG8_STAGE_B(PG8_SB(1, 0), cB + kstep); PG8_STAGE_A(PG8_SA(1, 0), kstepA, oc, 0); PG8_STAGE_B(PG8_SB(1, 1), cB + hstep + kstep);
    PG8_WAIT_V(6); PG8_BAR;
    for (;;) {
        const bool has_next = S.next(ui + 1, nxt);
        const char* nB = cB;
        if (has_next) { S.a_off(nxt, RA, CA, K, on); nB = (const char*)g.Bt + S.b_off(nxt, K); }
        else {
#pragma unroll
            for (int h = 0; h < 2; ++h)
#pragma unroll
                for (int i = 0; i < 2; ++i) on[h][i] = oc[h][i];
        }
#pragma unroll 1
        for (int t = 0; t < nt; t += 2) {
            const bool last = (t == nt - 2);
            const unsigned k1 = (unsigned)(t + 1) * kstepA;
            const unsigned k2 = last ? 0u : (unsigned)(t + 2) * kstepA, k3 = k2 + kstepA;
            unsigned o2[2][2];
#pragma unroll
            for (int h = 0; h < 2; ++h)
#pragma unroll
                for (int i = 0; i < 2; ++i) o2[h][i] = last ? on[h][i] : oc[h][i];
            const char* b2 = last ? nB : cB + (size_t)(t + 2) * kstep; const char* b3 = b2 + kstep;
            PG8_LDB(B0, 0, 0); PG8_SCHED; PG8_LDA(At, 0, 0); PG8_STAGE_A(PG8_SA(1, 1), k1, oc, 1);
            PG8_WAIT_L(8); PG8_BAR; PG8_WAIT_L(0); PG8_MMA(0, 0, At, B0); PG8_BAR; PG8_SCHED;
            PG8_LDB(B1, 0, 1); PG8_STAGE_B(PG8_SB(0, 0), b2);
            PG8_BAR; PG8_WAIT_L(0); PG8_MMA(0, 1, At, B1); PG8_BAR;
            PG8_LDA(At, 0, 1); PG8_STAGE_A(PG8_SA(0, 0), k2, o2, 0);
            PG8_BAR; PG8_WAIT_L(0); PG8_MMA(1, 0, At, B0); PG8_BAR; PG8_SCHED;
            PG8_STAGE_B(PG8_SB(0, 1), b2 + hstep);
            PG8_WAIT_V(6); PG8_BAR; PG8_MMA(1, 1, At, B1); PG8_BAR;
            PG8_LDB(B0, 1, 0); PG8_SCHED; PG8_LDA(At, 1, 0); PG8_STAGE_A(PG8_SA(0, 1), k2, o2, 1);
            PG8_WAIT_L(8); PG8_BAR; PG8_WAIT_L(0); PG8_MMA(0, 0, At, B0); PG8_BAR; PG8_SCHED;
            PG8_LDB(B1, 1, 1); PG8_STAGE_B(PG8_SB(1, 0), b3);
            PG8_BAR; PG8_WAIT_L(0); PG8_MMA(0, 1, At, B1); PG8_BAR;
            PG8_LDA(At, 1, 1); PG8_STAGE_A(PG8_SA(1, 0), k3, o2, 0);
            PG8_BAR; PG8_WAIT_L(0); PG8_MMA(1, 0, At, B0); PG8_BAR; PG8_SCHED;
            PG8_STAGE_B(PG8_SB(1, 1), b3 + hstep);
            PG8_WAIT_V(6); PG8_BAR; PG8_MMA(1, 1, At, B1); PG8_BAR;
        }
        if constexpr (Epi::FP8) asm volatile("s_nop 15\n\ts_nop 15" ::: "memory");
        E(acc, cur, wr, wc, fr, fq);
        if (!has_next) break;
        E.init(acc, nxt, wc, fq);
        cur = nxt; cB = nB; ++ui;
#pragma unroll
        for (int h = 0; h < 2; ++h)
#pragma unroll
            for (int i = 0; i < 2; ++i) oc[h][i] = on[h][i];
    }
    PG8_WAIT_V(0);
    if constexpr (Epi::FP8) __builtin_amdgcn_s_setprio(0);
    if (wr == 0) PG8_BAR;
    PG8_BAR;
#undef PG8_SA
#undef PG8_SB
#undef PG8_STAGE_A
#undef PG8_STAGE_B
#undef PG8_LDA
#undef PG8_LDB
#undef PG8_MMA
#undef PG8_WAIT_V
#undef PG8_WAIT_L
#undef PG8_BAR
#undef PG8_SCHED
}

struct SchedPlain { static constexpr bool TILED_B = false;
    int nM, nN, G, vcu;
    DI bool next(int i, Unit& u) const { const int L = i * G + vcu; if (L >= nM * nN) return false; u.pm = L / nN; u.pn = L % nN; u.aux = 0; u.ix = i; return true; }
    DI void a_off(const Unit& u, const int (&R)[2], const int (&C)[2], int K, unsigned (&o)[2][2]) const {
#pragma unroll
        for (int h = 0; h < 2; ++h)
#pragma unroll
            for (int i = 0; i < 2; ++i) o[h][i] = (unsigned)((u.pm * 256 + h * 128 + R[i]) * K + C[i]) * 2u; }
    DI size_t b_off(const Unit& u, int K) const { return (size_t)u.pn * 256 * K * 2; }
    DI unsigned kstep_a() const { return 128u; }
};
struct SchedMoe { static constexpr bool TILED_B = true;
    LAS const int* ut; LAS const unsigned short* rtl; int nN, G, vcu; bool gather;
    static DI int tile_k(int k, int nmt, bool rev, int skf, int skw) {
        if (!rev) return k;
        if (skw == 0) return nmt - 1 - k;
        const int c0 = nmt - 32 * skf, seg = 32 - skw;
        if (k < c0) return nmt - 1 - k;
        k -= c0; if (k < seg) return 32 * (skf - 1) + seg - 1 - k;
        k -= seg; if (k < seg) return 32 * (skf - 2) + seg - 1 - k;
        return 32 * (skf - 2) - 1 - (k - seg);
    }
    static DI void setup(LAS unsigned char* lds, const int* tile, const int* rowtok, const float* bias, int nN, int G, int vcu, int tid, bool rev, int pre_pm = -1, int pre_pn = 0, int skf = 0, int skw = 0) {
        LAS int* ut = (LAS int*)(lds + UT_OFF); LAS unsigned short* rtl = (LAS unsigned short*)(lds + RTL_OFF); LAS float* bl = (LAS float*)(lds + BL_OFF);
        __syncthreads();
        const int nmt = tile[1000]; const int NU = pre_pm >= 0 ? 1 : (nmt - 2 * skw) * nN; int nu = 0;
        if (pre_pm >= 0) nu = 1;
        else for (int i = 0; i < MAXU; ++i) { const int L = i * G + vcu; if (L < NU) nu = i + 1; }
        if (tid < MAXU) {
            if (pre_pm >= 0) { if (tid == 0) { ut[1] = pre_pm; ut[2] = tile[pre_pm]; ut[3] = pre_pn; } }
            else { const int L = tid * G + vcu; if (L < NU) { const int pm = tile_k(L / nN, nmt, rev, skf, skw); ut[1 + 3 * tid] = pm; ut[2 + 3 * tid] = tile[pm]; ut[3 + 3 * tid] = L % nN; } } }
        if (tid == 0) ut[0] = nu;
        __syncthreads();
        for (int i = tid >> 8; i < nu; i += 2) { const int pm = ut[1 + 3 * i], e = ut[2 + 3 * i], pn = ut[3 + 3 * i], c = tid & 255;
            if (rowtok) rtl[i * 256 + c] = (unsigned short)rowtok[pm * 256 + c];
            bl[i * 256 + c] = nN == 8 ? bias[(size_t)e * 2048 + (c >> 7) * 1024 + 128 * pn + (c & 127)] : bias[(size_t)e * 1024 + 256 * pn + c]; }
        __syncthreads();
    }
    DI bool next(int i, Unit& u) const { if (i >= ut[0]) return false; u.pm = ut[1 + 3 * i]; u.aux = ut[2 + 3 * i]; u.pn = ut[3 + 3 * i]; u.ix = i; return true; }
    DI void a_off(const Unit& u, const int (&R)[2], const int (&C)[2], int K, unsigned (&o)[2][2]) const {
        if (gather) {
            LAS const unsigned short* rp = rtl + u.ix * 256;
            const int t0 = rp[R[0]], t1 = rp[R[1]], t2 = rp[128 + R[0]], t3 = rp[128 + R[1]];
            o[0][0] = (unsigned)(t0 * K + C[0]) * 2u; o[0][1] = (unsigned)(t1 * K + C[1]) * 2u; o[1][0] = (unsigned)(t2 * K + C[0]) * 2u; o[1][1] = (unsigned)(t3 * K + C[1]) * 2u;
        } else {
#pragma unroll
            for (int h = 0; h < 2; ++h)
#pragma unroll
                for (int i = 0; i < 2; ++i) o[h][i] = (unsigned)(u.pm * 262144 + (h * 128 + R[i]) * 128 + C[i] * 2);
        }
    }
    DI unsigned kstep_a() const { return gather ? 128u : 32768u; }
    DI size_t b_off(const Unit& u, int K) const { return (size_t)(u.aux * nN + u.pn) * 256 * K * 2; }
};

struct EpiBf16Plain {
    static constexpr bool PERM = true, FP8 = false; static constexpr int SCALE_W = 0x7f7f7f7f;
    bf16_t* O; int ldc;
    DI void init(f32x4 (&acc)[2][2][4][2], const Unit&, int, int) const {
#pragma unroll
        for (int a = 0; a < 2; ++a)
#pragma unroll
            for (int b = 0; b < 2; ++b)
#pragma unroll
                for (int m = 0; m < 4; ++m)
#pragma unroll
                    for (int n = 0; n < 2; ++n) acc[a][b][m][n] = (f32x4){0.f, 0.f, 0.f, 0.f}; }
    DI void operator()(const f32x4 (&acc)[2][2][4][2], const Unit& u, int wr, int wc, int fr, int fq) const {
        const int row0 = u.pm * BM + wr * 64 + fr, col0 = u.pn * BM + wc * 32 + 8 * fq;
#pragma unroll
        for (int ai = 0; ai < 2; ++ai)
#pragma unroll
            for (int m = 0; m < 4; ++m) { bf16_t* rowp = O + (size_t)(row0 + ai * HALF + m * 16) * ldc + col0;
#pragma unroll
                for (int bj = 0; bj < 2; ++bj) { const f32x4 v0 = acc[ai][bj][m][0], v1 = acc[ai][bj][m][1];
                    u32x4 w; w.x = cvt_pk_bf16(v0[0], v0[1]); w.y = cvt_pk_bf16(v0[2], v0[3]); w.z = cvt_pk_bf16(v1[0], v1[1]); w.w = cvt_pk_bf16(v1[2], v1[3]);
                    *(u32x4*)(rowp + bj * HALF) = w; } }
    }
};
struct EpiGmix {
    static constexpr bool PERM = true, FP8 = true; static constexpr int SCALE_W = 0x7a7a7a7a;
    const float* mod; bf16_t* O;
    DI void init(f32x4 (&acc)[2][2][4][2], const Unit&, int, int) const {
#pragma unroll
        for (int a = 0; a < 2; ++a)
#pragma unroll
            for (int b = 0; b < 2; ++b)
#pragma unroll
                for (int m = 0; m < 4; ++m)
#pragma unroll
                    for (int n = 0; n < 2; ++n) acc[a][b][m][n] = (f32x4){0.f, 0.f, 0.f, 0.f}; }
    DI void operator()(const f32x4 (&acc)[2][2][4][2], const Unit& u, int wr, int wc, int fr, int fq) const {
        const int row0 = u.pm * BM + wr * 64 + fr, col0 = u.pn * BM + wc * 32 + 8 * fq;
        const int b = (u.pm * BM) >> 12;
        f32x4 gt[2][2];
#pragma unroll
        for (int bj = 0; bj < 2; ++bj)
#pragma unroll
            for (int n = 0; n < 2; ++n) gt[bj][n] = *(const f32x4*)(mod + b * 6144 + 2048 + col0 + bj * HALF + 4 * n);
#pragma unroll
        for (int ai = 0; ai < 2; ++ai)
#pragma unroll
            for (int m = 0; m < 4; ++m) { bf16_t* rowp = O + (size_t)(row0 + ai * HALF + m * 16) * D + col0;
#pragma unroll
                for (int bj = 0; bj < 2; ++bj) { const f32x4 v0 = acc[ai][bj][m][0] * gt[bj][0], v1 = acc[ai][bj][m][1] * gt[bj][1];
                    u32x4 w; w.x = cvt_pk_bf16(v0[0], v0[1]); w.y = cvt_pk_bf16(v0[2], v0[3]); w.z = cvt_pk_bf16(v1[0], v1[1]); w.w = cvt_pk_bf16(v1[2], v1[3]);
                    *(u32x4*)(rowp + bj * HALF) = w; } }
    }
};
typedef float f32x2 __attribute__((ext_vector_type(2)));
constexpr float GU_C = -1.702f * 1.44269504089f;
struct EpiAct {
    static constexpr bool PERM = true, FP8 = true; static constexpr int SCALE_W = 0x7a7a7a7a;
    LAS const float* bl; unsigned char* O;
    DI void init(f32x4 (&acc)[2][2][4][2], const Unit& u, int wc, int fq) const {
        LAS const float* bp = bl + u.ix * 256 + wc * 32 + 8 * fq;
#pragma unroll
        for (int n = 0; n < 2; ++n) { const f32x4 bg = *(LAS const f32x4*)(bp + 4 * n) * GU_C, bu = (*(LAS const f32x4*)(bp + 128 + 4 * n) + 1.0f) * (1.0f / GU_C);
#pragma unroll
            for (int a = 0; a < 2; ++a)
#pragma unroll
                for (int m = 0; m < 4; ++m) { acc[a][0][m][n] = bg; acc[a][1][m][n] = bu; } } }
    DI void operator()(const f32x4 (&acc)[2][2][4][2], const Unit& u, int wr, int wc, int fr, int fq) const {
        const int rt0 = wr * 64 + fr, cl = wc * 32 + 8 * fq;
        const int odd = fq & 1;
#pragma unroll
        for (int ai = 0; ai < 2; ++ai)
#pragma unroll
            for (int mp = 0; mp < 4; mp += 2) {
                unsigned wq[2][2];
#pragma unroll
                for (int mm = 0; mm < 2; ++mm) { const int m = mp + mm;
                    f32x2 o[4];
#pragma unroll
                    for (int n = 0; n < 2; ++n) { const f32x4 gv = acc[ai][0][m][n], uv = acc[ai][1][m][n];
#pragma unroll
                        for (int j = 0; j < 2; ++j) {
                            f32x2 gt, up; gt.x = __builtin_amdgcn_fmed3f(gv[2 * j], 7.0f * GU_C, 3.0e38f); gt.y = __builtin_amdgcn_fmed3f(gv[2 * j + 1], 7.0f * GU_C, 3.0e38f);
                            up.x = __builtin_amdgcn_fmed3f(uv[2 * j], 8.0f / GU_C, -6.0f / GU_C); up.y = __builtin_amdgcn_fmed3f(uv[2 * j + 1], 8.0f / GU_C, -6.0f / GU_C);
                            f32x2 e; e.x = __builtin_amdgcn_exp2f(gt.x); e.y = __builtin_amdgcn_exp2f(gt.y);
                            const f32x2 d = e + 1.0f; f32x2 r; r.x = __builtin_amdgcn_rcpf(d.x); r.y = __builtin_amdgcn_rcpf(d.y);
                            o[2 * n + j] = up * (gt * r); } }
                    wq[mm][0] = cvt_pk_fp8x4(o[0].x, o[0].y, o[1].x, o[1].y); wq[mm][1] = cvt_pk_fp8x4(o[2].x, o[2].y, o[3].x, o[3].y); }
                const auto rx = __builtin_amdgcn_permlane16_swap(wq[0][0], wq[1][0], false, false); const auto ry = __builtin_amdgcn_permlane16_swap(wq[0][1], wq[1][1], false, false);
                u32x4 w; w.x = rx[0]; w.y = ry[0]; w.z = rx[1]; w.w = ry[1];
                *(u32x4*)(O + (size_t)u.pm * 262144 + u.pn * 32768 + (rt0 + ai * HALF + (mp + odd) * 16) * 128 + cl - 8 * odd) = w; }
    }
};
struct EpiDown {
    static constexpr bool PERM = true, FP8 = true; static constexpr int SCALE_W = 0x7a7a7a7a;
    LAS const float* bl; unsigned char* O;
    DI void init(f32x4 (&acc)[2][2][4][2], const Unit& u, int wc, int fq) const {
        LAS const float* bp = bl + u.ix * 256 + wc * 32 + 8 * fq;
#pragma unroll
        for (int bj = 0; bj < 2; ++bj)
#pragma unroll
            for (int n = 0; n < 2; ++n) { const f32x4 bv = *(LAS const f32x4*)(bp + bj * HALF + 4 * n);
#pragma unroll
                for (int a = 0; a < 2; ++a)
#pragma unroll
                    for (int m = 0; m < 4; ++m) acc[a][bj][m][n] = bv; } }
    DI void operator()(const f32x4 (&acc)[2][2][4][2], const Unit& u, int wr, int wc, int fr, int fq) const {
        const int row0 = u.pm * BM + wr * 64 + fr, cl = wc * 32 + 8 * fq, col0 = u.pn * BM + cl;
        const int odd = fq & 1;
#pragma unroll
        for (int ai = 0; ai < 2; ++ai)
#pragma unroll
            for (int mp = 0; mp < 4; mp += 2) { unsigned char* rowp = O + (size_t)(row0 + ai * HALF + (mp + odd) * 16) * 1024 + col0 - 8 * odd;
#pragma unroll
                for (int bj = 0; bj < 2; ++bj) {
                    const f32x4 a0 = acc[ai][bj][mp][0], a1 = acc[ai][bj][mp][1], b0 = acc[ai][bj][mp + 1][0], b1 = acc[ai][bj][mp + 1][1];
                    const unsigned ax = cvt_pk_fp8x4(a0[0], a0[1], a0[2], a0[3]), ay = cvt_pk_fp8x4(a1[0], a1[1], a1[2], a1[3]), bx = cvt_pk_fp8x4(b0[0], b0[1], b0[2], b0[3]), by = cvt_pk_fp8x4(b1[0], b1[1], b1[2], b1[3]);
                    const auto rx = __builtin_amdgcn_permlane16_swap(ax, bx, false, false); const auto ry = __builtin_amdgcn_permlane16_swap(ay, by, false, false);
                    u32x4 w; w.x = rx[0]; w.y = ry[0]; w.z = rx[1]; w.w = ry[1];
                    *(u32x4*)(rowp + bj * HALF) = w; } }
    }
};
}

struct Args { const float* in[27]; float* out; unsigned char* ws; int ph_lo, ph_hi; };
struct Frame {
    LAS unsigned char* lds; int tid, lane, wave, G, blk, vcu;
    const float* in[27]; float* out; unsigned char* ws;
};
enum { I_X = 0, I_C, I_CTX, I_CCTX, I_WMOD, I_BMOD, I_GMIX, I_GFFN, I_WIN, I_WF, I_CONVW, I_CONVB, I_RGWA, I_RGBA, I_RGWX, I_RGBX, I_LAM, I_GOF, I_GOR, I_WOUT, I_WR, I_BR, I_WGU, I_BGU, I_WD, I_BD, I_GFIN };

constexpr int IT_TR = 8 + 24 + 1 + 32;

DI void p0_adaln(const Frame& F, int cb) {
    LAS float* sc = (LAS float*)F.lds; LAS float* red = (LAS float*)(F.lds + 36864);
    const float* c = F.in[I_C]; const float* cctx = F.in[I_CCTX]; const float* wmod = F.in[I_WMOD]; const float* bmod = F.in[I_BMOD];
    float* mod = (float*)(F.ws + WS_MOD);
    for (int i = F.tid; i < 9 * 1024; i += 512) { const int r = i >> 10, k = i & 1023; const float v = r < 8 ? c[r * 1024 + k] : cctx[k]; sc[i] = v / (1.0f + __expf(-v)); }
    __syncthreads();
    f32x4 acc[9];
#pragma unroll
    for (int r = 0; r < 9; ++r) acc[r] = (f32x4){0.f, 0.f, 0.f, 0.f};
    const float* wp = wmod + (size_t)(128 * F.wave) * 6144 + cb * 256 + 4 * F.lane;
    for (int kk = 0; kk < 128; kk += 8) {
        f32x4 wv[8];
#pragma unroll
        for (int j = 0; j < 8; ++j) wv[j] = *(const f32x4*)(wp + (size_t)(kk + j) * 6144);
#pragma unroll
        for (int j = 0; j < 8; ++j)
#pragma unroll
            for (int r = 0; r < 9; ++r) { const float s = sc[r * 1024 + 128 * F.wave + kk + j]; acc[r] += s * wv[j]; }
    }
#pragma unroll
    for (int r = 0; r < 9; ++r) *(LAS f32x4*)(red + (F.wave * 9 + r) * 256 + 4 * F.lane) = acc[r];
    __syncthreads();
    for (int i = F.tid; i < 9 * 256; i += 512) { const int r = i >> 8, cc = i & 255; float s = bmod[cb * 256 + cc];
        for (int w = 0; w < 8; ++w) s += red[(w * 9 + r) * 256 + cc];
        mod[r * 6144 + cb * 256 + cc] = s; }
    __syncthreads();
}

DI void p0_wmf(const Frame& F, int it) {
    const int g = it >> 1, rip = it & 1;
    LAS float* tw = (LAS float*)F.lds;
    LAS float* wfs = tw + 128;
    LAS float* Fm = wfs + 128 * 128;
    const float* wf = F.in[I_WF] + (size_t)g * 128 * 128;
    bf16_t* WMF = (bf16_t*)(F.ws + WS_WMF);
    const float norm = 0.0013810679320049757f;
    __syncthreads();
    if (F.tid < 128) { const float rev = (float)F.tid * (1.0f / 128.0f); tw[F.tid] = rip ? __builtin_amdgcn_sinf(rev) : __builtin_amdgcn_cosf(rev); }
    for (int i = F.tid; i < 128 * 128; i += 512) wfs[i] = wf[i];
    __syncthreads();
    { const int jp = F.tid & 127, j0 = F.tid >> 7; float sacc[32];
#pragma unroll
      for (int i = 0; i < 32; ++i) sacc[i] = 0.f;
#pragma unroll 4
      for (int l = 0; l < 128; ++l) { const float w = wfs[l * 128 + jp];
#pragma unroll
          for (int i = 0; i < 32; ++i) sacc[i] += tw[(l * (j0 + 4 * i)) & 127] * w; }
#pragma unroll
      for (int i = 0; i < 32; ++i) Fm[(j0 + 4 * i) * 128 + jp] = sacc[i] * norm; }
    __syncthreads();
    for (int i = 0; i < 4; ++i) { const int idx = F.tid + 512 * i;
        const int ln = idx & 63, nt = (idx >> 6) & 3, sx = (idx >> 8) & 1, jt = idx >> 9; const int hh = ln >> 5, n = ln & 31;
        float v[8];
#pragma unroll
        for (int jj = 0; jj < 8; ++jj) v[jj] = Fm[(32 * jt + 16 * sx + 8 * (jj >> 2) + 4 * hh + (jj & 3)) * 128 + 32 * nt + n];
        u32x4 w; w.x = cvt_pk_bf16(v[0], v[1]); w.y = cvt_pk_bf16(v[2], v[3]); w.z = cvt_pk_bf16(v[4], v[5]); w.w = cvt_pk_bf16(v[6], v[7]);
        *(u32x4*)(WMF + ((size_t)((((g * 2 + rip) * 4 + jt) * 2 + sx) * 4 + nt) * 64 + ln) * 8) = w; }
    __syncthreads();
}
DI void p0_cf(const Frame& F) {
    for (int i = F.tid; i < 1024; i += 512) { const float nl = -F.in[I_LAM][i]; ((float*)(F.ws + WS_SP8))[i] = 8.0f * (fmaxf(nl, 0.f) + log1pf(expf(-fabsf(nl)))); }
    bf16_t* CF = (bf16_t*)(F.ws + WS_CF);
    for (int i = 0; i < 4; ++i) { const int idx = F.tid + 512 * i; const int ln = idx & 63, ks = (idx >> 6) & 7, rip = (idx >> 9) & 1, pt = idx >> 10; const int hh = ln >> 5, p = 32 * pt + (ln & 31);
        float v[8];
#pragma unroll
        for (int jj = 0; jj < 8; ++jj) { const int k2 = 16 * ks + 8 * hh + jj, ri = k2 >> 6, c = k2 & 63; const float rev = (float)((c * p) & 63) * (1.0f / 64.0f);
            const float cs = __builtin_amdgcn_cosf(rev), sn = __builtin_amdgcn_sinf(rev); v[jj] = rip == 0 ? (ri == 0 ? cs : sn) : (ri == 0 ? -sn : cs); }
        u32x4 w; w.x = cvt_pk_bf16(v[0], v[1]); w.y = cvt_pk_bf16(v[2], v[3]); w.z = cvt_pk_bf16(v[4], v[5]); w.w = cvt_pk_bf16(v[6], v[7]);
        *(u32x4*)(CF + (size_t)idx * 8) = w; }
}
DI void p0_rgw(const Frame& F, int it) {
    const int type = it >> 4, d = (it >> 3) & 1, h = it & 7;
    const float* src = (type ? F.in[I_RGWX] : F.in[I_RGWA]) + (size_t)(d * 8 + h) * 4096;
    bf16_t* dst = (bf16_t*)(F.ws + WS_RGW) + (size_t)((d * 2 + type) * 8 + h) * 4096;
    for (int i = F.tid; i < 4096; i += 512) { const int j = i >> 6, ii = i & 63; dst[i] = f2bf(src[ii * 64 + j]); }
}
DI void p0_tr_fp8(const float* src, int ldn, int k0, int n0, unsigned char* dst, int dbase, bool gu, int lane) {
    typedef float f32x2_ __attribute__((ext_vector_type(2)));
    const float* sp = src + (size_t)k0 * ldn + n0 + 2 * lane;
    f32x2_ v[64];
#pragma unroll
    for (int i = 0; i < 64; ++i) v[i] = *(const f32x2_*)(sp + (size_t)i * ldn);
#pragma unroll
    for (int c = 0; c < 2; ++c) { const int n = n0 + 2 * lane + c; const int jn = n & 1023; const int drow = dbase + (gu ? 256 * (jn >> 7) + 128 * (n >> 10) + (jn & 127) : n);
        unsigned char* dp = dst + (size_t)drow * 1024 + k0;
#pragma unroll
        for (int h = 0; h < 4; ++h) { u32x4 w;
            w.x = cvt_pk_fp8x4(32.f * v[16 * h + 0][c], 32.f * v[16 * h + 1][c], 32.f * v[16 * h + 2][c], 32.f * v[16 * h + 3][c]); w.y = cvt_pk_fp8x4(32.f * v[16 * h + 4][c], 32.f * v[16 * h + 5][c], 32.f * v[16 * h + 6][c], 32.f * v[16 * h + 7][c]);
            w.z = cvt_pk_fp8x4(32.f * v[16 * h + 8][c], 32.f * v[16 * h + 9][c], 32.f * v[16 * h + 10][c], 32.f * v[16 * h + 11][c]); w.w = cvt_pk_fp8x4(32.f * v[16 * h + 12][c], 32.f * v[16 * h + 13][c], 32.f * v[16 * h + 14][c], 32.f * v[16 * h + 15][c]);
            *(u32x4*)(dp + h * 16) = w; } }
}
DI void p0_tr_bf16(const float* src, int ldn, int k0, int n0, bf16_t* dst, int lane) {
    const float* sp = src + (size_t)k0 * ldn + n0 + 4 * lane;
    f32x4 v[32];
#pragma unroll
    for (int i = 0; i < 32; ++i) v[i] = *(const f32x4*)(sp + (size_t)i * ldn);
#pragma unroll
    for (int c = 0; c < 4; ++c) { bf16_t* dp = dst + (size_t)(n0 + 4 * lane + c) * 1024 + k0;
#pragma unroll
        for (int h = 0; h < 4; ++h) { u32x4 w; w.x = cvt_pk_bf16(v[8 * h][c], v[8 * h + 1][c]); w.y = cvt_pk_bf16(v[8 * h + 2][c], v[8 * h + 3][c]); w.z = cvt_pk_bf16(v[8 * h + 4][c], v[8 * h + 5][c]); w.w = cvt_pk_bf16(v[8 * h + 6][c], v[8 * h + 7][c]);
            *(u32x4*)(dp + h * 8) = w; } }
}
struct P0Tile { const float* src; int ldn, k0, colA, colB; unsigned char* dst; };
constexpr int NT_GU2 = 32 * 8 * 4, NT_D = 32 * 4 * 8;
DI P0Tile p0_tile_of(const Frame& F, int it) {
    P0Tile t; const int e = it >> 5, kt = (it >> 2) & 7, pn = it & 3;
    t.src = F.in[I_WD] + (size_t)e * 1024 * 1024; t.ldn = 1024; t.k0 = kt * 128; t.colA = 256 * pn; t.colB = 256 * pn + 128; t.dst = (unsigned char*)(F.ws + WS_WDOWN) + (size_t)((e * 4 + pn) * 8 + kt) * 32768;
    return t;
}
DI void p0_gu_load(const float* src, int k0, int pp, int hs, int tid, f32x4 (&v)[16]) {
    const int w = tid >> 6, l = tid & 63;
    const float* sp = src + (size_t)(k0 + 16 * w + 8 * hs) * 2048 + 256 * pp + 4 * l;
#pragma unroll
    for (int i = 0; i < 8; ++i) { v[2 * i] = *(const f32x4*)(sp + (size_t)i * 2048); v[2 * i + 1] = *(const f32x4*)(sp + (size_t)i * 2048 + 1024); }
}
DI void p0_gu_pack(LAS unsigned char* tl, int hs, int tid, const f32x4 (&v)[16]) {
    const int w = tid >> 6, l = tid & 63, c4 = (l & 31) * 4;
    LAS unsigned char* base = tl + (l >> 5) * 36864 + 16 * w + 8 * hs;
#pragma unroll
    for (int sg = 0; sg < 2; ++sg)
#pragma unroll
        for (int c = 0; c < 4; ++c) { u32x2 q;
            const float sc = sg ? 32.f / pg8::GU_C : 32.f * pg8::GU_C;
            q.x = cvt_pk_fp8x4(sc * v[0 + sg][c], sc * v[2 + sg][c], sc * v[4 + sg][c], sc * v[6 + sg][c]); q.y = cvt_pk_fp8x4(sc * v[8 + sg][c], sc * v[10 + sg][c], sc * v[12 + sg][c], sc * v[14 + sg][c]);
            *(LAS u32x2*)(base + (sg * 128 + c4 + c) * 144) = q; }
}
DI void p0_tile_load(const P0Tile& t, int tid, f32x4 (&v)[16]) {
    const int w = tid >> 6, l = tid & 63, seg = l >> 5, c4 = (l & 31) * 4;
    const float* sp = t.src + (size_t)(t.k0 + 16 * w) * t.ldn + (seg ? t.colB : t.colA) + c4;
#pragma unroll
    for (int i = 0; i < 16; ++i) v[i] = *(const f32x4*)(sp + (size_t)i * t.ldn);
}
DI void p0_tile_finish(const Frame& F, const P0Tile& t, int tid, const f32x4 (&v)[16]) {
    LAS unsigned char* tl = F.lds;
    const int w = tid >> 6, l = tid & 63, seg = l >> 5, c4 = (l & 31) * 4;
#pragma unroll
    for (int c = 0; c < 4; ++c) { u32x4 q;
        q.x = cvt_pk_fp8x4(32.f * v[0][c], 32.f * v[1][c], 32.f * v[2][c], 32.f * v[3][c]); q.y = cvt_pk_fp8x4(32.f * v[4][c], 32.f * v[5][c], 32.f * v[6][c], 32.f * v[7][c]);
        q.z = cvt_pk_fp8x4(32.f * v[8][c], 32.f * v[9][c], 32.f * v[10][c], 32.f * v[11][c]); q.w = cvt_pk_fp8x4(32.f * v[12][c], 32.f * v[13][c], 32.f * v[14][c], 32.f * v[15][c]);
        *(LAS u32x4*)(tl + (seg * 128 + c4 + c) * 144 + 16 * w) = q; }
    __syncthreads();
#pragma unroll
    for (int i = 0; i < 4; ++i) { const int q = tid + 512 * i; const u32x4 d = *(const LAS u32x4*)(tl + (q >> 3) * 144 + 16 * (q & 7)); *(u32x4*)(t.dst + (size_t)q * 16) = d; }
}
constexpr int WT_WIN = 6 * 32, WT_WOUT = 4 * 32, WT_END = WT_WIN + WT_WOUT;
constexpr int CW_Q0 = 512, CW_Q1 = 576, CW_Q2 = 832, CW_Q5 = 960, CW_EARLY = 704;
DI void phase0(const Frame& F) {
    unsigned* ctl = (unsigned*)(F.ws + WS_CTL);
    volatile LAS int* bq = (volatile LAS int*)(F.lds + MISC_OFF + 64);
    constexpr int NB_WT = WT_END / 8, NB_HEAD = IT_TR + NB_WT;
    const bool headless = F.G > NB_HEAD + 32;
    for (int q = F.blk; q < IT_TR; q += headless ? IT_TR : F.G) {
        __syncthreads();
        if (q < 8) p0_wmf(F, q);
        else if (q < 32) p0_adaln(F, q - 8);
        else if (q < 33) p0_cf(F);
        else p0_rgw(F, q - 33);
    }
    for (int wb = headless ? F.blk - IT_TR : F.blk; wb >= 0 && wb < NB_WT; wb += headless ? NB_WT : F.G) {
        int j = wb * 8 + F.wave;
        if (j < WT_WIN) { const int kb = j / 6, nb = j % 6; p0_tr_bf16(F.in[I_WIN], 1536, kb * 32, nb * 256, (bf16_t*)(F.ws + WS_WIN), F.lane); }
        else { j -= WT_WIN; const int kb = j >> 3, nb = j & 7; p0_tr_fp8(F.in[I_WOUT], 1024, kb * 64, nb * 128, (unsigned char*)(F.ws + WS_WOUT), 0, false, F.lane); }
    }
    const int gu_static = headless ? F.G - NB_HEAD : 0;
    int tid = F.tid; asm volatile("" : "+v"(tid));
    f32x4 va[16], vb[16];
    {
        __syncthreads();
        if (F.tid == 0) { const bool st = headless && F.blk >= NB_HEAD;
            bq[0] = st ? F.blk - NB_HEAD : gu_static + (int)__hip_atomic_fetch_add(ctl + CW_Q2, 1u, __ATOMIC_RELAXED, __HIP_MEMORY_SCOPE_AGENT); }
        __syncthreads();
        int cur = bq[0];
        if (cur < NT_GU2) p0_gu_load(F.in[I_WGU] + (size_t)(cur >> 5) * 1024 * 2048, ((cur >> 2) & 7) * 128, cur & 3, 0, tid, va);
        __syncthreads(); if (F.tid == 0) bq[1] = gu_static + (int)__hip_atomic_fetch_add(ctl + CW_Q2, 1u, __ATOMIC_RELAXED, __HIP_MEMORY_SCOPE_AGENT); __syncthreads();
        int nxt = bq[1];
#pragma unroll 1
        while (cur < NT_GU2) {
            int nn = 0; if (F.tid == 0) nn = gu_static + (int)__hip_atomic_fetch_add(ctl + CW_Q2, 1u, __ATOMIC_RELAXED, __HIP_MEMORY_SCOPE_AGENT);
            const int e = cur >> 5, kt = (cur >> 2) & 7, pp = cur & 3;
            p0_gu_load(F.in[I_WGU] + (size_t)e * 1024 * 2048, kt * 128, pp, 1, tid, vb);
            p0_gu_pack(F.lds, 0, tid, va);
            if (nxt < NT_GU2) p0_gu_load(F.in[I_WGU] + (size_t)(nxt >> 5) * 1024 * 2048, ((nxt >> 2) & 7) * 128, nxt & 3, 0, tid, va);
            p0_gu_pack(F.lds, 1, tid, vb);
            __syncthreads();
            unsigned char* d0 = (unsigned char*)(F.ws + WS_WGU) + (size_t)((e * 8 + 2 * pp) * 8 + kt) * 32768;
#pragma unroll
            for (int i = 0; i < 8; ++i) { const int q = tid + 512 * i, tsel = q >> 11, qq = q & 2047; const u32x4 d = *(const LAS u32x4*)(F.lds + tsel * 36864 + (qq >> 3) * 144 + 16 * (qq & 7));
                *(u32x4*)(d0 + (size_t)tsel * 262144 + (size_t)qq * 16) = d; }
            __syncthreads(); if (F.tid == 0) bq[0] = nn; __syncthreads();
            cur = nxt; nxt = bq[0];
        }
    }
    {
        __syncthreads(); if (F.tid == 0) bq[0] = (int)__hip_atomic_fetch_add(ctl + CW_Q5, 1u, __ATOMIC_RELAXED, __HIP_MEMORY_SCOPE_AGENT); __syncthreads();
        int cur = bq[0];
        if (cur < NT_D) p0_tile_load(p0_tile_of(F, cur), tid, va);
        __syncthreads(); if (F.tid == 0) bq[1] = (int)__hip_atomic_fetch_add(ctl + CW_Q5, 1u, __ATOMIC_RELAXED, __HIP_MEMORY_SCOPE_AGENT); __syncthreads();
        int nxt = bq[1];
#pragma unroll 1
        while (cur < NT_D) {
            int nn = 0; if (F.tid == 0) nn = (int)__hip_atomic_fetch_add(ctl + CW_Q5, 1u, __ATOMIC_RELAXED, __HIP_MEMORY_SCOPE_AGENT);
            if (nxt < NT_D) p0_tile_load(p0_tile_of(F, nxt), tid, vb);
            p0_tile_finish(F, p0_tile_of(F, cur), tid, va);
            __syncthreads(); if (F.tid == 0) bq[0] = nn; __syncthreads();
            cur = nxt; nxt = bq[0];
#pragma unroll
            for (int i = 0; i < 16; ++i) va[i] = vb[i];
        }
    }
}

template <int NR> DI void norm_rows(const float* xr, const float* g, const float* modb, bf16_t* hrow, int lane) {
    f32x4 v[NR][4]; float ss[NR];
#pragma unroll
    for (int r = 0; r < NR; ++r)
#pragma unroll
        for (int q = 0; q < 4; ++q) v[r][q] = *(const f32x4*)(xr + (size_t)r * D + 4 * lane + 256 * q);
#pragma unroll
    for (int r = 0; r < NR; ++r) { float a = 0.f;
#pragma unroll
        for (int q = 0; q < 4; ++q) a += v[r][q][0] * v[r][q][0] + v[r][q][1] * v[r][q][1] + v[r][q][2] * v[r][q][2] + v[r][q][3] * v[r][q][3];
        ss[r] = rsqrtf(wave_sum(a) * (1.0f / 1024.0f) + EPS); }
#pragma unroll
    for (int q = 0; q < 4; ++q) { const int k = 4 * lane + 256 * q;
        const f32x4 gg = *(const f32x4*)(g + k), sh = *(const f32x4*)(modb + k), sc = *(const f32x4*)(modb + 1024 + k); const f32x4 gm = gg * (1.0f + sc);
#pragma unroll
        for (int r = 0; r < NR; ++r) { const f32x4 y = v[r][q] * ss[r] * gm + sh;
            u32x2 w; w.x = cvt_pk_bf16(y[0], y[1]); w.y = cvt_pk_bf16(y[2], y[3]);
            *(u32x2*)(hrow + (size_t)r * D + k) = w; } }
}
struct SchedOne { static constexpr bool TILED_B = false; int pm, pn; bool used;
    DI bool next(int i, pg8::Unit& u) const { if (i > 0) return false; u.pm = pm; u.pn = pn; u.aux = 0; u.ix = 0; return true; }
    DI void a_off(const pg8::Unit& u, const int (&R)[2], const int (&C)[2], int K, unsigned (&o)[2][2]) const {
#pragma unroll
        for (int h = 0; h < 2; ++h)
#pragma unroll
            for (int i = 0; i < 2; ++i) o[h][i] = (unsigned)((u.pm * 256 + h * 128 + R[i]) * K + C[i]) * 2u; }
    DI size_t b_off(const pg8::Unit& u, int K) const { return (size_t)u.pn * 256 * K * 2; }
    DI unsigned kstep_a() const { return 128u; }
};
DI void router_tables(const Frame& F) {
    const float* wrt = F.in[I_WR]; const float* brt = F.in[I_BR]; const float* g = F.in[I_GFFN]; const float* mod = (const float*)(F.ws + WS_MOD);
    for (int it = F.blk; it < 256; it += F.G) { const int b = it >> 5, part = it & 31;
        const float* shp = mod + b * 6144 + 3072; const float* scp = mod + b * 6144 + 4096;
        unsigned char* Wh = F.ws + WS_WRT + (size_t)b * 131072; unsigned char* Wl = Wh + 65536;
#pragma unroll
        for (int jx = 0; jx < 2; ++jx) { const int idx = F.tid + 512 * jx; const int e = idx & 31, k = 32 * part + (idx >> 5);
            const float v = g[k] * (1.0f + scp[k]) * wrt[k * 32 + e]; const unsigned hi = cvt_pk_bf16(v, 0.f) & 0xffffu; const float lo = v - __uint_as_float(hi << 16);
            const int kk = k & 31, chn = 4 * (k >> 5) + ((kk & 15) >> 2), jj = (kk & 3) + 4 * (kk >> 4);
            const int off = e * 2048 + ((chn ^ (e & 15)) << 4) + jj * 2;
            *(bf16_t*)(Wh + off) = (bf16_t)hi; *(bf16_t*)(Wl + off) = f2bf(lo); }
        if (F.wave == 0) { float sacc = 0.f;
#pragma unroll
            for (int i = 0; i < 16; ++i) { const int k = F.lane + 64 * i; sacc += shp[k] * wrt[k * 32 + part]; }
            sacc = wave_sum(sacc); if (F.lane == 0) ((float*)(F.ws + WS_CBG))[b * 32 + part] = sacc + brt[part]; }
    }
}
DI void phase1(const Frame& F) {
    const float* x = F.in[I_X]; const float* ctx = F.in[I_CTX]; const float* g = F.in[I_GMIX]; const float* mod = (const float*)(F.ws + WS_MOD);
    bf16_t* H = (bf16_t*)(F.ws + WS_H);
    router_tables(F);
    const int nb = F.G, bb = F.blk;
    const int ngt = T / 4, nfull = ngt / (nb * 8);
#pragma unroll 1
    for (int it = 0; it < nfull; ++it) {
        const int row = ((it * nb + bb) * 8 + F.wave) * 4;
        norm_rows<4>(x + (size_t)row * D, g, mod + (row >> 12) * 6144, H + (size_t)row * D, F.lane);
    }
    { const int gi = nfull * nb * 8 + F.wave * nb + bb;
      if (gi < ngt) { const int row = gi * 4; norm_rows<4>(x + (size_t)row * D, g, mod + (row >> 12) * 6144, H + (size_t)row * D, F.lane); } }
    for (int row = F.blk * 8 + F.wave; row < TC; row += F.G * 8) norm_rows<1>(ctx + (size_t)row * D, g, mod + 8 * 6144, H + (size_t)(T + row) * D, F.lane);
}

DI int serp_tok(int b, int P) { const int rr = P >> 6, cc = P & 63; return b * SEQ + (rr << 6) + ((rr & 1) ? 63 - cc : cc); }
DI void rg_wload(const bf16_t* RGW, const float* rba, const float* rbx, const float* lamp, int d, int hh, int chl, int hf, bf16x8 (&wq)[2][4], float (&pq)[3]) {
    const bf16_t* wr_ = RGW + (size_t)(((d * 2 + 0) * 8 + hh) * 64 + chl) * 64; const bf16_t* wi_ = RGW + (size_t)(((d * 2 + 1) * 8 + hh) * 64 + chl) * 64;
#pragma unroll
    for (int ks = 0; ks < 4; ++ks) { wq[0][ks] = *(const bf16x8*)(wr_ + 16 * ks + 8 * hf); wq[1][ks] = *(const bf16x8*)(wi_ + 16 * ks + 8 * hf); }
    const int ch = 64 * hh + chl; pq[0] = rba[d * 512 + ch]; pq[1] = rbx[d * 512 + ch]; pq[2] = lamp[d * 512 + ch];
}
DI void rg_unit(const Frame& F, int u) {
    LAS unsigned char* xcl = F.lds;
    const bf16_t* XR = (const bf16_t*)(F.ws + WS_XP) + 512; const bf16_t* RGW = (const bf16_t*)(F.ws + WS_RGW);
    const float* convw = F.in[I_CONVW]; const float* convb = F.in[I_CONVB];
    float* sumP = (float*)(F.ws + WS_SUMP); float* sumH = (float*)(F.ws + WS_SUMH);
    bf16_t* SSb = (bf16_t*)(F.ws + WS_SS); bf16_t* CAF = (bf16_t*)(F.ws + WS_CAF); bf16_t* CAB = (bf16_t*)(F.ws + WS_CAB);
    int tid = F.tid; asm volatile("" : "+v"(tid));
    const int lane = tid & 63, hh = F.wave, hf = lane >> 5;
    bf16x8 wq[2][4]; float pq[3];
    {
        const bool lat = u < 512; const int b = lat ? (u >> 6) : ((u - 512) >> 2), r = lat ? (u & 63) : ((u - 512) & 3); const int L = lat ? SEQ : CTXL;
        rg_wload(RGW, F.in[I_RGBA], F.in[I_RGBX], (const float*)(F.ws + WS_SP8), 0, hh, lane & 31, hf, wq, pq);
        {
            const int cg = tid & 63, w8 = (tid >> 6) * 8; float w[4][8], bs[8];
#pragma unroll
            for (int k = 0; k < 4; ++k) { const f32x4 a = *(const f32x4*)(convw + k * 512 + 8 * cg), c2 = *(const f32x4*)(convw + k * 512 + 8 * cg + 4);
                w[k][0] = a[0]; w[k][1] = a[1]; w[k][2] = a[2]; w[k][3] = a[3]; w[k][4] = c2[0]; w[k][5] = c2[1]; w[k][6] = c2[2]; w[k][7] = c2[3]; }
            { const f32x4 a = *(const f32x4*)(convb + 8 * cg), c2 = *(const f32x4*)(convb + 8 * cg + 4); bs[0] = a[0]; bs[1] = a[1]; bs[2] = a[2]; bs[3] = a[3]; bs[4] = c2[0]; bs[5] = c2[1]; bs[6] = c2[2]; bs[7] = c2[3]; }
            u32x4 xv[11];
#pragma unroll
            for (int j = 0; j < 11; ++j) { const int P = 64 * r + w8 + j - 2; xv[j] = (u32x4){0u, 0u, 0u, 0u};
                if (P >= 0 && P < L) { const int tk = lat ? serp_tok(b, P) : T + b * CTXL + P; xv[j] = *(const u32x4*)(XR + (size_t)tk * 1536 + 8 * cg); } }
#pragma unroll
            for (int i = 0; i < 8; ++i) { const int p = w8 + i; float a[8];
#pragma unroll
                for (int j = 0; j < 8; ++j) a[j] = bs[j];
#pragma unroll
                for (int k = 0; k < 4; ++k) { const u32x4 xq = xv[i + k];
#pragma unroll
                    for (int j = 0; j < 4; ++j) { a[2 * j] += w[k][2 * j] * bflo(xq[j]); a[2 * j + 1] += w[k][2 * j + 1] * bfhi(xq[j]); } }
                u32x4 o; o.x = cvt_pk_bf16(a[0], a[1]); o.y = cvt_pk_bf16(a[2], a[3]); o.z = cvt_pk_bf16(a[4], a[5]); o.w = cvt_pk_bf16(a[6], a[7]);
                *(LAS u32x4*)(xcl + p * 1040 + cg * 16) = o; }
        }
        __syncthreads();
        const int cidx = lat ? 4 + r : r; const int tokbase = b * SEQ + 64 * r;
#pragma unroll 1
        for (int nt = 0; nt < 2; ++nt) {
            const int chl = 32 * nt + (lane & 31), ch = 64 * hh + chl;
            unsigned hlp[2][8];
#pragma unroll
            for (int d = 0; d < 2; ++d) {
                f32x16 ar[2], ai[2];
#pragma unroll
                for (int t = 0; t < 2; ++t)
#pragma unroll
                    for (int i = 0; i < 16; ++i) { ar[t][i] = 0.f; ai[t][i] = 0.f; }
                bf16x8 brv[4], biv[4];
#pragma unroll
                for (int ks = 0; ks < 4; ++ks) { brv[ks] = wq[0][ks]; biv[ks] = wq[1][ks]; }
                const float ba = pq[0], bx = pq[1], lam = pq[2];
#pragma unroll
                for (int ks = 0; ks < 4; ++ks) {
                    const bf16x8 br = brv[ks], bi = biv[ks];
#pragma unroll
                    for (int t = 0; t < 2; ++t) { const int m = lane & 31; const int pos = 32 * ((m >> 2) & 1) + 16 * t + 4 * (m >> 3) + (m & 3);
                        const bf16x8 a = *(const LAS bf16x8*)(xcl + pos * 1040 + (64 * hh + 16 * ks + 8 * hf) * 2);
                        ar[t] = __builtin_amdgcn_mfma_f32_32x32x16_bf16(a, br, ar[t], 0, 0, 0); ai[t] = __builtin_amdgcn_mfma_f32_32x32x16_bf16(a, bi, ai[t], 0, 0, 0); }
                }
                { const int d2 = d ^ 1, nt2 = nt + d; if (nt2 < 2) rg_wload(RGW, F.in[I_RGBA], F.in[I_RGBX], (const float*)(F.ws + WS_SP8), d2, hh, 32 * nt2 + (lane & 31), hf, wq, pq); }
                const float sp8 = lam;
                const float LG = 1.44269504089f, nbaL = -ba * LG, nbxL = -bx * LG, nspL = -sp8 * LG;
#pragma unroll
                for (int t = 0; t < 2; ++t)
#pragma unroll
                    for (int i = 0; i < 16; i += 2) { const int p = 32 * hf + 16 * t + i;
                        pg8::f32x2 vr, vi, xc; vr.x = ar[t][i]; vr.y = ar[t][i + 1]; vi.x = ai[t][i]; vi.y = ai[t][i + 1];
                        xc.x = bf2f(*(const LAS bf16_t*)(xcl + p * 1040 + ch * 2)); xc.y = bf2f(*(const LAS bf16_t*)(xcl + (p + 1) * 1040 + ch * 2));
                        const pg8::f32x2 t1 = vr * (-LG) + nbaL, t2 = vi * (-LG) + nbxL;
                        pg8::f32x2 e1, e2; e1.x = __builtin_amdgcn_exp2f(t1.x); e1.y = __builtin_amdgcn_exp2f(t1.y); e2.x = __builtin_amdgcn_exp2f(t2.x); e2.y = __builtin_amdgcn_exp2f(t2.y);
                        const pg8::f32x2 d1 = e1 + 1.0f, d2 = e2 + 1.0f;
                        pg8::f32x2 rr; rr.x = __builtin_amdgcn_rcpf(d1.x); rr.y = __builtin_amdgcn_rcpf(d1.y);
                        const pg8::f32x2 mm = rr * nspL;
                        pg8::f32x2 a; a.x = __builtin_amdgcn_exp2f(mm.x); a.y = __builtin_amdgcn_exp2f(mm.y);
                        pg8::f32x2 y = 1.0f - a * a; y.x = fmaxf(y.x, 1e-30f); y.y = fmaxf(y.y, 1e-30f);
                        const pg8::f32x2 z = (y * d2) * d2;
                        pg8::f32x2 rs; rs.x = __builtin_amdgcn_rsqf(z.x); rs.y = __builtin_amdgcn_rsqf(z.y);
                        const pg8::f32x2 o = (y * rs) * xc;
                        ar[t][i] = a.x; ar[t][i + 1] = a.y; ai[t][i] = o.x; ai[t][i + 1] = o.y; }
                float hl = 0.f, ca = 1.f;
                if (d == 0) {
#pragma unroll
                    for (int t = 0; t < 2; ++t)
#pragma unroll
                        for (int i = 0; i < 16; ++i) { const float a = ar[t][i]; hl = a * hl + ai[t][i]; ca *= a; ai[t][i] = hl; ar[t][i] = ca; }
                    const float P0 = __shfl(ca, lane & 31), H0 = __shfl(hl, lane & 31);
                    if (hf == 1) {
#pragma unroll
                        for (int t = 0; t < 2; ++t)
#pragma unroll
                            for (int i = 0; i < 16; ++i) { ai[t][i] += ar[t][i] * H0; ar[t][i] *= P0; }
                        sumP[(size_t)((b * 2 + 0) * NCH + cidx) * 512 + ch] = ar[1][15]; sumH[(size_t)((b * 2 + 0) * NCH + cidx) * 512 + ch] = ai[1][15];
                    }
#pragma unroll
                    for (int t = 0; t < 2; ++t)
#pragma unroll
                        for (int i = 0; i < 8; ++i) hlp[t][i] = cvt_pk_bf16(ai[t][2 * i], ai[t][2 * i + 1]);
                    if (lat) {
                        const int p0 = 32 * hf; bf16_t* pc = CAF + (size_t)(tokbase + ((r & 1) ? 63 - p0 : p0)) * 512 + ch; const long stride = (r & 1) ? -512 : 512;
#pragma unroll
                        for (int t = 0; t < 2; ++t)
#pragma unroll
                            for (int i = 0; i < 16; ++i) { stg16(pc, f2bf(ar[t][i])); pc += stride; asm volatile("" : "+v"(pc)); }
                    }
                } else {
#pragma unroll
                    for (int t = 1; t >= 0; --t)
#pragma unroll
                        for (int i = 15; i >= 0; --i) { const float a = ar[t][i]; hl = a * hl + ai[t][i]; ca *= a; ai[t][i] = hl; ar[t][i] = ca; }
                    const float P1 = __shfl(ca, (lane & 31) + 32), H1 = __shfl(hl, (lane & 31) + 32);
                    if (hf == 0) {
#pragma unroll
                        for (int t = 0; t < 2; ++t)
#pragma unroll
                            for (int i = 0; i < 16; ++i) { ai[t][i] += ar[t][i] * H1; ar[t][i] *= P1; }
                        sumP[(size_t)((b * 2 + 1) * NCH + cidx) * 512 + ch] = ar[0][0]; sumH[(size_t)((b * 2 + 1) * NCH + cidx) * 512 + ch] = ai[0][0];
                    }
                    if (lat) {
                        const int p0 = 32 * hf; const size_t o0 = (size_t)(tokbase + ((r & 1) ? 63 - p0 : p0)) * 512 + ch; bf16_t* pc = CAB + o0; bf16_t* ps = SSb + o0; const long stride = (r & 1) ? -512 : 512;
#pragma unroll
                        for (int t = 0; t < 2; ++t)
#pragma unroll
                            for (int i = 0; i < 16; ++i) { stg16(pc, f2bf(ar[t][i])); stg16(ps, f2bf(((i & 1) ? bfhi(hlp[t][i >> 1]) : bflo(hlp[t][i >> 1])) + ai[t][i])); pc += stride; ps += stride; asm volatile("" : "+v"(pc), "+v"(ps)); }
                    }
                }
            }
        }
        __syncthreads();
    }
}

typedef short s16x4 __attribute__((ext_vector_type(4)));
DI unsigned pk_bf16c(float a, float b) { typedef float f2_ __attribute__((ext_vector_type(2))); typedef __bf16 b2_ __attribute__((ext_vector_type(2))); const b2_ r = __builtin_convertvector((f2_){a, b}, b2_); return __builtin_bit_cast(unsigned, r); }
DI unsigned img_off(int row, int ch) { return 256u * row + 16u * (ch ^ (((row & 3) << 2) | ((row >> 2) & 3))); }
DI unsigned tr_addr(int lane, int cc, int t) { const int h = lane >> 5, blk = (lane >> 4) & 1, q4 = (lane & 15) >> 2, p = lane & 3; return img_off(8 * h + 4 * t + q4, 4 * cc + 2 * blk + (p >> 1)) + 8u * (p & 1); }

constexpr int FFTA_OFF = 81920;
DI void fftR_table(const Frame& F) {
#pragma unroll 1
    for (int i = 0; i < 2; ++i) { const int idx = F.tid + 512 * i; const int ln = idx & 63, ks = (idx >> 6) & 3, mt = idx >> 8; const int h = ln >> 5, m = ln & 31;
        float v[8];
#pragma unroll
        for (int jj = 0; jj < 8; ++jj) { const int r = 16 * ks + 8 * h + jj, q = 32 * (mt & 1) + m; const float rev = (float)((r * q) & 63) * (1.0f / 64.0f); v[jj] = mt < 2 ? __builtin_amdgcn_cosf(rev) : -__builtin_amdgcn_sinf(rev); }
        u32x4 w; w.x = pk_bf16c(v[0], v[1]); w.y = pk_bf16c(v[2], v[3]); w.z = pk_bf16c(v[4], v[5]); w.w = pk_bf16c(v[6], v[7]);
        *(LAS u32x4*)(F.lds + FFTA_OFF + idx * 16) = w; }
}
DI void fftR_unit(const Frame& F, int u) {
    int lane = F.lane; asm volatile("" : "+v"(lane));
    const int h = lane >> 5, m = lane & 31;
    const bf16_t* XP = (const bf16_t*)(F.ws + WS_XP); bf16_t* ZG = (bf16_t*)(F.ws + WS_ZG);
    const unsigned ldsb = (unsigned)(__SIZE_TYPE__)F.lds;
    {
        const int b = u >> 6, c = u & 63;
        __syncthreads();
#pragma unroll
        for (int i = 0; i < 8; ++i) { const int idx = F.tid + 512 * i; const int r = idx >> 6, ch8 = idx & 63;
            const u32x4 v = *(const u32x4*)(XP + (size_t)(b * SEQ + 64 * r + c) * 1536 + 8 * ch8);
            *(LAS u32x4*)(F.lds + (ch8 >> 4) * 16384 + img_off(r, ch8 & 15)) = v; }
        __syncthreads();
#pragma unroll 1
        for (int nn = 0; nn < 2; ++nn) {
            const int nt = F.wave * 2 + nn, slab = nt >> 2, cc = nt & 3;
            const unsigned a0 = ldsb + slab * 16384 + tr_addr(lane, cc, 0), a1 = ldsb + slab * 16384 + tr_addr(lane, cc, 1);
            s16x4 lo[4], hi[4];
            asm volatile("ds_read_b64_tr_b16 %0, %8\n\tds_read_b64_tr_b16 %1, %9\n\tds_read_b64_tr_b16 %2, %8 offset:4096\n\tds_read_b64_tr_b16 %3, %9 offset:4096\n\t"
                         "ds_read_b64_tr_b16 %4, %8 offset:8192\n\tds_read_b64_tr_b16 %5, %9 offset:8192\n\tds_read_b64_tr_b16 %6, %8 offset:12288\n\tds_read_b64_tr_b16 %7, %9 offset:12288\n\ts_waitcnt lgkmcnt(0)"
                         : "=&v"(lo[0]), "=&v"(hi[0]), "=&v"(lo[1]), "=&v"(hi[1]), "=&v"(lo[2]), "=&v"(hi[2]), "=&v"(lo[3]), "=&v"(hi[3]) : "v"(a0), "v"(a1) : "memory");
            f32x16 acc[4];
#pragma unroll
            for (int mt = 0; mt < 4; ++mt)
#pragma unroll
                for (int i = 0; i < 16; ++i) acc[mt][i] = 0.f;
#pragma unroll
            for (int ks = 0; ks < 4; ++ks) { const bf16x8 Bf = __builtin_shufflevector(lo[ks], hi[ks], 0, 1, 2, 3, 4, 5, 6, 7);
#pragma unroll
                for (int mt = 0; mt < 4; ++mt) { const bf16x8 Af = *(const LAS bf16x8*)(F.lds + FFTA_OFF + ((mt * 4 + ks) * 64 + lane) * 16); acc[mt] = __builtin_amdgcn_mfma_f32_32x32x16_bf16(Af, Bf, acc[mt], 0, 0, 0); } }
            const int ch = 32 * nt + m;
#pragma unroll
            for (int qh = 0; qh < 2; ++qh) {
                bf16_t* pz = ZG + ((size_t)((b * 64 + 32 * qh + 4 * h) * 2) * 64 + c) * 512 + ch;
#pragma unroll
                for (int i = 0; i < 16; ++i) { const int q = 32 * qh + (i & 3) + 8 * (i >> 2) + 4 * h;
                    const float rev = (float)((c * q) & 4095) * (1.0f / 4096.0f); const float cw = __builtin_amdgcn_cosf(rev), sw = __builtin_amdgcn_sinf(rev);
                    const float yr = acc[qh][i], yi = acc[2 + qh][i];
                    stg16(pz, (bf16_t)(pk_bf16c(yr * cw + yi * sw, 0.f) & 0xffffu)); stg16(pz + 64 * 512, (bf16_t)(pk_bf16c(yi * cw - yr * sw, 0.f) & 0xffffu));
                    pz += ((i & 3) == 3 ? 5 : 1) * (2 * 64 * 512); asm volatile("" : "+v"(pz)); }
            }
        }
    }
}
constexpr int CW_Q3 = 640, CW_CTXG = 896;
DI void phase3(const Frame& F) {
    unsigned* ctl = (unsigned*)(F.ws + WS_CTL);
    volatile LAS int* bq = (volatile LAS int*)(F.lds + MISC_OFF + 64);
    constexpr int NGC = 16;
    int cur;
    if (F.blk < NGC && F.G > NGC) {
        pg8::Gemm gg{(const bf16_t*)(F.ws + WS_H), (const bf16_t*)(F.ws + WS_WIN), 1024};
        SchedOne S{T / 256 + (F.blk >> 1), 2 + (F.blk & 1), true}; pg8::EpiBf16Plain E{(bf16_t*)(F.ws + WS_XP), 1536};
        pg8::gemm_phase(F.lds, gg, S, E);
        asm volatile("s_waitcnt vmcnt(0)" ::: "memory"); __syncthreads();
        if (F.tid == 0) { __builtin_amdgcn_fence(__ATOMIC_RELEASE, "agent"); asm volatile("s_waitcnt vmcnt(0)" ::: "memory"); (void)xb_add(ctl + CW_CTXG, 1u);
            bq[0] = (F.G - NGC) + (int)__hip_atomic_fetch_add(ctl + CW_Q3, 1u, __ATOMIC_RELAXED, __HIP_MEMORY_SCOPE_AGENT); }
        fftR_table(F);
        __syncthreads(); cur = bq[0];
    } else { fftR_table(F); cur = F.G > NGC ? F.blk - NGC : F.blk; }
    const int qbase = F.G > NGC ? F.G - NGC : F.G;
    while (cur < 544 + 512) {
        int nxt = 0; if (F.tid == 0) nxt = qbase + (int)__hip_atomic_fetch_add(ctl + CW_Q3, 1u, __ATOMIC_RELAXED, __HIP_MEMORY_SCOPE_AGENT);
        if (cur >= 512 && cur < 544) {
            if (F.tid == 0) { unsigned sp = 0u; while (xb_ld(ctl + CW_CTXG) < (unsigned)NGC) { __builtin_amdgcn_s_sleep(1); if (++sp > (XB_SPIN_CAP << 2)) break; }
                __builtin_amdgcn_fence(__ATOMIC_ACQUIRE, "agent"); asm volatile("s_waitcnt vmcnt(0)" ::: "memory"); }
            __syncthreads();
        }
        if (cur < 544) rg_unit(F, cur); else fftR_unit(F, cur - 544);
        __syncthreads(); if (F.tid == 0) bq[0] = nxt; __syncthreads(); cur = bq[0];
    }
    __syncthreads();
}

constexpr int FRED_OFF = 131072;
DI void fftC_unit(const Frame& F, int u) {
    int lane = F.lane; asm volatile("" : "+v"(lane));
    const int h = lane >> 5, m = lane & 31, g = F.wave >> 1, pt = F.wave & 1;
    const unsigned ldsb = (unsigned)(__SIZE_TYPE__)F.lds + g * 32768;
    unsigned ta[4][2];
#pragma unroll
    for (int jt = 0; jt < 4; ++jt) { ta[jt][0] = ldsb + tr_addr(lane, jt, 0); ta[jt][1] = ldsb + tr_addr(lane, jt, 1); }
    const bf16_t* ZG = (const bf16_t*)(F.ws + WS_ZG); const bf16_t* CF = (const bf16_t*)(F.ws + WS_CF); const bf16_t* WMF = (const bf16_t*)(F.ws + WS_WMF); unsigned char* CAT = F.ws + WS_CAT;
    LAS float* fred = (LAS float*)(F.lds + FRED_OFF);
    {
        const int b = u >> 6, q = u & 63;
        __syncthreads();
        const bf16_t* zsrc = ZG + (size_t)(b * 64 + q) * 2 * 64 * 512;
#pragma unroll
        for (int i = 0; i < 16; ++i) { const int idx = F.tid + 512 * i; const int k2 = idx >> 6, ch8 = idx & 63;
            const u32x4 v = *(const u32x4*)(zsrc + (size_t)k2 * 512 + 8 * ch8);
            *(LAS u32x4*)(F.lds + (ch8 >> 4) * 32768 + img_off(k2, ch8 & 15)) = v; }
        __syncthreads();
        f32x16 out[4];
#pragma unroll
        for (int n = 0; n < 4; ++n)
#pragma unroll
            for (int i = 0; i < 16; ++i) out[n][i] = 0.f;
#pragma unroll 1
        for (int rj = 0; rj < 4; ++rj) {
            const int rip = rj >> 1, jp = rj & 1;
            f32x16 xt[2];
#pragma unroll
            for (int jt = 0; jt < 2; ++jt)
#pragma unroll
                for (int i = 0; i < 16; ++i) xt[jt][i] = 0.f;
            const unsigned t00 = ta[0][0], t01 = ta[0][1], t10 = ta[1][0], t11 = ta[1][1], t20 = ta[2][0], t21 = ta[2][1], t30 = ta[3][0], t31 = ta[3][1];
            const unsigned a0 = jp ? t20 : t00, a1 = jp ? t21 : t01, a2 = jp ? t30 : t10, a3 = jp ? t31 : t11;
            bf16x8 Bcv[8];
#pragma unroll
            for (int ks = 0; ks < 8; ++ks) Bcv[ks] = *(const bf16x8*)(CF + ((size_t)((pt * 2 + rip) * 8 + ks) * 64 + lane) * 8);
#pragma unroll
            for (int ks = 0; ks < 8; ++ks) {
                const bf16x8 Bc = Bcv[ks];
                s16x4 lo[2], hi[2]; const unsigned ko = 4096u * ks;
                asm volatile("ds_read_b64_tr_b16 %0, %4\n\tds_read_b64_tr_b16 %1, %5\n\tds_read_b64_tr_b16 %2, %6\n\tds_read_b64_tr_b16 %3, %7\n\ts_waitcnt lgkmcnt(0)"
                             : "=&v"(lo[0]), "=&v"(hi[0]), "=&v"(lo[1]), "=&v"(hi[1]) : "v"(a0 + ko), "v"(a1 + ko), "v"(a2 + ko), "v"(a3 + ko) : "memory");
#pragma unroll
                for (int jt = 0; jt < 2; ++jt) { const bf16x8 Af = __builtin_shufflevector(lo[jt], hi[jt], 0, 1, 2, 3, 4, 5, 6, 7); xt[jt] = __builtin_amdgcn_mfma_f32_32x32x16_bf16(Af, Bc, xt[jt], 0, 0, 0); }
            }
#pragma unroll
            for (int jt = 0; jt < 2; ++jt) {
                bf16x8 Bwv[2][4];
#pragma unroll
                for (int sx = 0; sx < 2; ++sx)
#pragma unroll
                    for (int n = 0; n < 4; ++n) Bwv[sx][n] = *(const bf16x8*)(WMF + ((size_t)(((((g * 2 + rip) * 4 + 2 * jp + jt) * 2 + sx) * 4 + n) * 64) + lane) * 8);
#pragma unroll
                for (int sx = 0; sx < 2; ++sx) {
                    u32x4 w; w.x = pk_bf16c(xt[jt][8 * sx + 0], xt[jt][8 * sx + 1]); w.y = pk_bf16c(xt[jt][8 * sx + 2], xt[jt][8 * sx + 3]); w.z = pk_bf16c(xt[jt][8 * sx + 4], xt[jt][8 * sx + 5]); w.w = pk_bf16c(xt[jt][8 * sx + 6], xt[jt][8 * sx + 7]);
                    const bf16x8 Af = __builtin_bit_cast(bf16x8, w);
#pragma unroll
                    for (int n = 0; n < 4; ++n) out[n] = __builtin_amdgcn_mfma_f32_32x32x16_bf16(Af, Bwv[sx][n], out[n], 0, 0, 0);
                }
                asm volatile("" ::: "memory");
            }
        }
#pragma unroll
        for (int i = 0; i < 16; ++i) { float a = out[0][i] * out[0][i] + out[1][i] * out[1][i] + out[2][i] * out[2][i] + out[3][i] * out[3][i];
            a += dpp_get0<0xB1, 0xF>(a); a += dpp_get0<0x4E, 0xF>(a); a += dpp_get0<0x141, 0xF>(a); a += dpp_get0<0x140, 0xF>(a); a += dpp_get0<0x142, 0xA>(a);
            if (m == 16) fred[g * 64 + 32 * pt + (i & 3) + 8 * (i >> 2) + 4 * h] = a;
            asm volatile("" ::: "memory"); }
        __syncthreads();
        float gsc[4];
#pragma unroll
        for (int n = 0; n < 4; ++n) gsc[n] = F.in[I_GOF][128 * g + 32 * n + m];
        unsigned char* pf = CAT + ((size_t)(b * SEQ + 64 * (32 * pt + 4 * h) + q)) * 1024 + 128 * g + m;
#pragma unroll
        for (int i = 0; i < 16; ++i) { const int p = 32 * pt + (i & 3) + 8 * (i >> 2) + 4 * h;
            const float tot = (fred[p] + fred[64 + p]) + (fred[128 + p] + fred[192 + p]); const float rs = rsqrtf(tot * (1.0f / 512.0f) + EPS);
#pragma unroll
            for (int n = 0; n < 4; ++n) { const float ov = out[n][i] * rs * gsc[n]; stg8(pf + 32 * n, (unsigned char)(__builtin_amdgcn_cvt_pk_fp8_f32(ov, ov, 0u, false) & 0xffu)); }
            pf += ((i & 3) == 3 ? 5 : 1) * (64 * 1024); asm volatile("" : "+v"(pf) :: "memory"); }
    }
}

DI void catrg_unit(const Frame& F, int u) {
    LAS float* cinf = (LAS float*)F.lds; LAS float* cinb = cinf + 4 * 512;
    const float* sumP = (const float*)(F.ws + WS_SUMP); const float* sumH = (const float*)(F.ws + WS_SUMH);
    const bf16_t* SSb = (const bf16_t*)(F.ws + WS_SS); const bf16_t* CAF = (const bf16_t*)(F.ws + WS_CAF); const bf16_t* CAB = (const bf16_t*)(F.ws + WS_CAB);
    const bf16_t* GR = (const bf16_t*)(F.ws + WS_XP) + 1024; unsigned char* CAT = F.ws + WS_CAT;
    const float* gor = F.in[I_GOR];
    {
        const int b = u >> 4, r0 = (u & 15) * 4;
        float gr_[8];
#pragma unroll
        for (int j = 0; j < 8; ++j) gr_[j] = gor[8 * F.lane + j];
        __syncthreads();
        { const int t = F.tid; float hfw = 0.f, hbw = 0.f;
          const float* pf = sumP + (size_t)((b * 2 + 0) * NCH) * 512 + t; const float* qf = sumH + (size_t)((b * 2 + 0) * NCH) * 512 + t;
#pragma unroll 1
          for (int cb = 0; cb < 4 + r0; cb += 16) { float pp[16], qq[16];
#pragma unroll
              for (int j = 0; j < 16; ++j) { const int c = cb + j; const bool on = c < 4 + r0; pp[j] = on ? pf[c * 512] : 1.0f; qq[j] = on ? qf[c * 512] : 0.0f; }
#pragma unroll
              for (int j = 0; j < 16; ++j) hfw = pp[j] * hfw + qq[j]; }
          cinf[t] = hfw;
#pragma unroll
          for (int k = 1; k < 4; ++k) { hfw = pf[(3 + r0 + k) * 512] * hfw + qf[(3 + r0 + k) * 512]; cinf[k * 512 + t] = hfw; }
          const float* pb = sumP + (size_t)((b * 2 + 1) * NCH) * 512 + t; const float* qb = sumH + (size_t)((b * 2 + 1) * NCH) * 512 + t;
          for (int c = 3; c >= 0; --c) hbw = pb[c * 512] * hbw + qb[c * 512];
#pragma unroll 1
          for (int cb = NCH - 1; cb > 4 + r0 + 3; cb -= 16) { float pp[16], qq[16];
#pragma unroll
              for (int j = 0; j < 16; ++j) { const int c = cb - j; const bool on = c > 4 + r0 + 3; pp[j] = on ? pb[c * 512] : 1.0f; qq[j] = on ? qb[c * 512] : 0.0f; }
#pragma unroll
              for (int j = 0; j < 16; ++j) hbw = pp[j] * hbw + qq[j]; }
          cinb[3 * 512 + t] = hbw;
#pragma unroll
          for (int k = 2; k >= 0; --k) { hbw = pb[(4 + r0 + k + 1) * 512] * hbw + qb[(4 + r0 + k + 1) * 512]; cinb[k * 512 + t] = hbw; }
        }
        __syncthreads();
#pragma unroll 1
        for (int k = 0; k < 4; ++k) {
            float cf[8], cb[8];
#pragma unroll
            for (int j = 0; j < 8; ++j) { cf[j] = cinf[k * 512 + 8 * F.lane + j]; cb[j] = cinb[k * 512 + 8 * F.lane + j]; }
#pragma unroll 2
            for (int i = 0; i < 8; ++i) {
                const int tk = b * SEQ + 64 * (r0 + k) + i * 8 + F.wave;
                const u32x4 s4 = *(const u32x4*)(SSb + (size_t)tk * 512 + 8 * F.lane), a4 = *(const u32x4*)(CAF + (size_t)tk * 512 + 8 * F.lane), b4 = *(const u32x4*)(CAB + (size_t)tk * 512 + 8 * F.lane);
                const u32x4 g4 = *(const u32x4*)(GR + (size_t)tk * 1536 + 8 * F.lane);
                float rg[8]; float sr = 0.f;
#pragma unroll
                for (int j = 0; j < 4; ++j) {
                    const float y0 = bflo(s4[j]) + bflo(a4[j]) * cf[2 * j] + bflo(b4[j]) * cb[2 * j], y1 = bfhi(s4[j]) + bfhi(a4[j]) * cf[2 * j + 1] + bfhi(b4[j]) * cb[2 * j + 1];
                    rg[2 * j] = y0 * gelu_tanh(bflo(g4[j])); rg[2 * j + 1] = y1 * gelu_tanh(bfhi(g4[j]));
                    sr += rg[2 * j] * rg[2 * j] + rg[2 * j + 1] * rg[2 * j + 1]; }
                sr = wave_sum(sr);
                const float rr = rsqrtf(sr * (1.0f / 512.0f) + EPS);
                u32x2 orr;
                orr.x = cvt_pk_fp8x4(rg[0] * rr * gr_[0], rg[1] * rr * gr_[1], rg[2] * rr * gr_[2], rg[3] * rr * gr_[3]); orr.y = cvt_pk_fp8x4(rg[4] * rr * gr_[4], rg[5] * rr * gr_[5], rg[6] * rr * gr_[6], rg[7] * rr * gr_[7]);
                *(u32x2*)(CAT + (size_t)tk * 1024 + 512 + 8 * F.lane) = orr;
            }
        }
    }
}
constexpr int CW_Q4 = 768;
DI void phase4(const Frame& F) {
    unsigned* ctl = (unsigned*)(F.ws + WS_CTL);
    volatile LAS int* bq = (volatile LAS int*)(F.lds + MISC_OFF + 64);
    int cur = F.blk;
    while (cur < 512 + 128) {
        int nxt = 0; if (F.tid == 0) nxt = F.G + (int)__hip_atomic_fetch_add(ctl + CW_Q4, 1u, __ATOMIC_RELAXED, __HIP_MEMORY_SCOPE_AGENT);
        if (cur < 128) catrg_unit(F, cur); else fftC_unit(F, cur - 128);
        __syncthreads(); if (F.tid == 0) bq[0] = nxt; __syncthreads(); cur = bq[0];
    }
    __syncthreads();
}

DI void router_image_load(const Frame& F, int b) {
    LAS unsigned char* WTh = F.lds; LAS float* cbl = (LAS float*)(F.lds + 131072);
    const u32x4* src = (const u32x4*)(F.ws + WS_WRT + (size_t)b * 131072);
#pragma unroll
    for (int i = 0; i < 16; ++i) { const int idx = F.tid + 512 * i; *(LAS u32x4*)(WTh + idx * 16) = src[idx]; }
    if (F.tid < 32) cbl[F.tid] = ((const float*)(F.ws + WS_CBG))[b * 32 + F.tid];
}
DI void phase_router(const Frame& F, int pre_b) {
    LAS unsigned char* WTh = F.lds; LAS unsigned char* WTl = F.lds + 65536;
    LAS float* cbl = (LAS float*)(F.lds + 131072);
    LAS int* wcnt = (LAS int*)(F.lds + MISC_OFF + 1024);
    const float* g = F.in[I_GFFN]; const float* mod = (const float*)(F.ws + WS_MOD);
    const float* X = F.in[I_X]; const bf16_t* GM = (const bf16_t*)(F.ws + WS_GMIX); unsigned char* H8 = (unsigned char*)(F.ws + WS_H); bf16_t* X1B = (bf16_t*)(F.ws + WS_CAT);
    int* toke = (int*)(F.ws + WS_TOKE); float* tokg = (float*)(F.ws + WS_TOKG); int* cnt = (int*)(F.ws + WS_CNT);
    if (F.tid < 256) wcnt[F.tid] = 0;
    int bcur = pre_b;
    __syncthreads();
    for (int it = 0;; ++it) {
        const int row0 = (it * F.G + F.blk) * 128; if (row0 >= T) break;
        const int b = row0 >> 12;
        const float* shp = mod + b * 6144 + 3072; const float* scp = mod + b * 6144 + 4096;
        if (b != bcur) { bcur = b; __syncthreads(); router_image_load(F, b); __syncthreads(); }
        const int tl = F.lane & 15, kg = F.lane >> 4; const int tok = row0 + 16 * F.wave + tl;
        f32x4 acc0 = (f32x4){0.f, 0.f, 0.f, 0.f}, acc1 = acc0; float ssq = 0.f;
        const float* xp = X + (size_t)tok * D + 4 * kg; const bf16_t* gp = GM + (size_t)tok * D + 4 * kg;
        const int krot = (5 * F.wave + 11 * F.blk) & 31;
#pragma unroll 16
        for (int ks_ = 0; ks_ < 32; ++ks_) { const int ks = (ks_ + krot) & 31;
            f32x4 xa = *(const f32x4*)(xp + 32 * ks), xb = *(const f32x4*)(xp + 32 * ks + 16);
            const u32x2 ga = *(const u32x2*)(gp + 32 * ks), gb = *(const u32x2*)(gp + 32 * ks + 16);
            xa[0] += bflo(ga.x); xa[1] += bfhi(ga.x); xa[2] += bflo(ga.y); xa[3] += bfhi(ga.y); xb[0] += bflo(gb.x); xb[1] += bfhi(gb.x); xb[2] += bflo(gb.y); xb[3] += bfhi(gb.y);
            ssq += xa[0] * xa[0] + xa[1] * xa[1] + xa[2] * xa[2] + xa[3] * xa[3] + xb[0] * xb[0] + xb[1] * xb[1] + xb[2] * xb[2] + xb[3] * xb[3];
            u32x4 hv, lv;
            hv.x = cvt_pk_bf16(xa[0], xa[1]); hv.y = cvt_pk_bf16(xa[2], xa[3]); hv.z = cvt_pk_bf16(xb[0], xb[1]); hv.w = cvt_pk_bf16(xb[2], xb[3]);
            lv.x = cvt_pk_bf16(xa[0] - bflo(hv.x), xa[1] - bfhi(hv.x)); lv.y = cvt_pk_bf16(xa[2] - bflo(hv.y), xa[3] - bfhi(hv.y));
            lv.z = cvt_pk_bf16(xb[0] - bflo(hv.z), xb[1] - bfhi(hv.z)); lv.w = cvt_pk_bf16(xb[2] - bflo(hv.w), xb[3] - bfhi(hv.w));
            { bf16_t* xo_ = X1B + (size_t)tok * D + 4 * kg + 32 * ks; u32x2 s0_, s1_; s0_.x = hv.x; s0_.y = hv.y; s1_.x = hv.z; s1_.y = hv.w; *(u32x2*)xo_ = s0_; *(u32x2*)(xo_ + 16) = s1_; }
            const bf16x8 Bh = __builtin_bit_cast(bf16x8, hv), Bl = __builtin_bit_cast(bf16x8, lv);
            const int ch = ((4 * ks + kg) ^ tl) << 4;
            const bf16x8 A0h = *(const LAS bf16x8*)(WTh + tl * 2048 + ch), A0l = *(const LAS bf16x8*)(WTl + tl * 2048 + ch);
            const bf16x8 A1h = *(const LAS bf16x8*)(WTh + (16 + tl) * 2048 + ch), A1l = *(const LAS bf16x8*)(WTl + (16 + tl) * 2048 + ch);
            acc0 = __builtin_amdgcn_mfma_f32_16x16x32_bf16(A0h, Bh, acc0, 0, 0, 0); acc0 = __builtin_amdgcn_mfma_f32_16x16x32_bf16(A0h, Bl, acc0, 0, 0, 0); acc0 = __builtin_amdgcn_mfma_f32_16x16x32_bf16(A0l, Bh, acc0, 0, 0, 0);
            acc1 = __builtin_amdgcn_mfma_f32_16x16x32_bf16(A1h, Bh, acc1, 0, 0, 0); acc1 = __builtin_amdgcn_mfma_f32_16x16x32_bf16(A1h, Bl, acc1, 0, 0, 0); acc1 = __builtin_amdgcn_mfma_f32_16x16x32_bf16(A1l, Bh, acc1, 0, 0, 0);
        }
        ssq += __shfl_xor(ssq, 16); ssq += __shfl_xor(ssq, 32);
        const float rstd = rsqrtf(ssq * (1.0f / 1024.0f) + EPS);
        float lg[8];
#pragma unroll
        for (int i = 0; i < 4; ++i) { lg[i] = rstd * acc0[i] + cbl[4 * kg + i]; lg[4 + i] = rstd * acc1[i] + cbl[16 + 4 * kg + i]; }
        int sel[4]; float val[4];
#pragma unroll
        for (int p = 0; p < 4; ++p) {
            float bv = lg[0]; int bi = 4 * kg;
#pragma unroll
            for (int i = 1; i < 8; ++i) { const int ei = (i < 4 ? 0 : 12) + 4 * kg + i; if (lg[i] > bv) { bv = lg[i]; bi = ei; } }
#pragma unroll
            for (int o = 16; o <= 32; o <<= 1) { const float ov = __shfl_xor(bv, o); const int oi = __shfl_xor(bi, o); if (ov > bv || (ov == bv && oi < bi)) { bv = ov; bi = oi; } }
            sel[p] = bi; val[p] = bv;
#pragma unroll
            for (int i = 0; i < 8; ++i) { const int ei = (i < 4 ? 0 : 12) + 4 * kg + i; if (ei == bi) lg[i] = -3.0e38f; }
        }
        const float e1 = __expf(val[1] - val[0]), e2 = __expf(val[2] - val[0]), e3 = __expf(val[3] - val[0]); const float inv = 1.0f / (1.0f + e1 + e2 + e3);
        if (kg == 0) {
            *(i32x4*)(toke + (size_t)tok * 4) = (i32x4){sel[0], sel[1], sel[2], sel[3]}; *(f32x4*)(tokg + (size_t)tok * 4) = (f32x4){inv, e1 * inv, e2 * inv, e3 * inv};
#pragma unroll
            for (int p = 0; p < 4; ++p) __hip_atomic_fetch_add(wcnt + F.wave * 32 + sel[p], 1, __ATOMIC_RELAXED, __HIP_MEMORY_SCOPE_WORKGROUP);
        }
        float gm[16], sh[16];
#pragma unroll
        for (int q = 0; q < 4; ++q) { const f32x4 gg = *(const f32x4*)(g + 16 * F.lane + 4 * q), sc = *(const f32x4*)(scp + 16 * F.lane + 4 * q), s4 = *(const f32x4*)(shp + 16 * F.lane + 4 * q);
#pragma unroll
            for (int jx = 0; jx < 4; ++jx) { gm[4 * q + jx] = gg[jx] * (1.0f + sc[jx]); sh[4 * q + jx] = s4[jx]; } }
        asm volatile("s_waitcnt vmcnt(0)" ::: "memory");
#pragma unroll 4
        for (int t_ = 0; t_ < 16; ++t_) { const int t = (t_ + 2 * F.wave + F.blk) & 15;
            const float rs = __shfl(rstd, t); const size_t ro = (size_t)(row0 + 16 * F.wave + t) * D + 16 * F.lane;
            f32x4 xv[4];
            { const u32x4 g0 = *(const u32x4*)(X1B + ro), g1 = *(const u32x4*)(X1B + ro + 8);
              xv[0][0] = bflo(g0.x); xv[0][1] = bfhi(g0.x); xv[0][2] = bflo(g0.y); xv[0][3] = bfhi(g0.y); xv[1][0] = bflo(g0.z); xv[1][1] = bfhi(g0.z); xv[1][2] = bflo(g0.w); xv[1][3] = bfhi(g0.w);
              xv[2][0] = bflo(g1.x); xv[2][1] = bfhi(g1.x); xv[2][2] = bflo(g1.y); xv[2][3] = bfhi(g1.y); xv[3][0] = bflo(g1.z); xv[3][1] = bfhi(g1.z); xv[3][2] = bflo(g1.w); xv[3][3] = bfhi(g1.w); }
            u32x4 w;
            w.x = cvt_pk_fp8x4(xv[0][0] * rs * gm[0] + sh[0], xv[0][1] * rs * gm[1] + sh[1], xv[0][2] * rs * gm[2] + sh[2], xv[0][3] * rs * gm[3] + sh[3]);
            w.y = cvt_pk_fp8x4(xv[1][0] * rs * gm[4] + sh[4], xv[1][1] * rs * gm[5] + sh[5], xv[1][2] * rs * gm[6] + sh[6], xv[1][3] * rs * gm[7] + sh[7]);
            w.z = cvt_pk_fp8x4(xv[2][0] * rs * gm[8] + sh[8], xv[2][1] * rs * gm[9] + sh[9], xv[2][2] * rs * gm[10] + sh[10], xv[2][3] * rs * gm[11] + sh[11]);
            w.w = cvt_pk_fp8x4(xv[3][0] * rs * gm[12] + sh[12], xv[3][1] * rs * gm[13] + sh[13], xv[3][2] * rs * gm[14] + sh[14], xv[3][3] * rs * gm[15] + sh[15]);
            *(u32x4*)(H8 + ro) = w;
        }
    }
    __syncthreads();
    if (F.tid < 256) cnt[F.blk * 256 + F.tid] = wcnt[F.tid];
    if (F.tid < 32) { int sblk = 0; for (int w = 0; w < 8; ++w) sblk += wcnt[w * 32 + F.tid]; ((int*)(F.ws + WS_CNTB))[F.blk * 32 + F.tid] = sblk; }
    __syncthreads();
}

DI void phase_slots(const Frame& F) {
    LAS int* part = (LAS int*)F.lds;
    LAS int* tot = part + 1024; LAS int* bef = tot + 32; LAS int* pst = bef + 32; LAS int* base = pst + 32;
    const int* cnt = (const int*)(F.ws + WS_CNT); const int* toke = (const int*)(F.ws + WS_TOKE);
    const int ev0 = (F.blk * 128 < T) ? toke[(F.blk * 128 + 16 * F.wave) * 4 + F.lane] : 0;
    int* toks = (int*)(F.ws + WS_TOKS); int* rowtok = (int*)(F.ws + WS_ROWTOK); int* tile = (int*)(F.ws + WS_TILE);
    const int nrows = F.G; const int* cntb = (const int*)(F.ws + WS_CNTB);
    { const int e = F.tid & 31, pt = F.tid >> 5; int sa = 0, sb = 0; const int per = (nrows + 15) / 16;
      const int r0 = pt * per, r1 = ((pt + 1) * per < nrows) ? (pt + 1) * per : nrows;
#pragma unroll 16
      for (int rw = r0; rw < r1; ++rw) { const int c = cntb[rw * 32 + e]; sa += c; sb += (rw < F.blk) ? c : 0; }
      part[pt * 32 + e] = sa; part[512 + pt * 32 + e] = sb; }
    __syncthreads();
    if (F.tid < 32) { int sa = 0, sb = 0; for (int pt = 0; pt < 16; ++pt) { sa += part[pt * 32 + F.tid]; sb += part[512 + pt * 32 + F.tid]; } tot[F.tid] = sa; bef[F.tid] = sb; }
    __syncthreads();
    if (F.tid == 0) { int run = 0; for (int e = 0; e < 32; ++e) { pst[e] = run; run += (tot[e] + 255) / 256 * 256; }
        if (F.blk == 0) { tile[1000] = run / 256; } }
    __syncthreads();
    if (F.tid < 256) { const int w = F.tid >> 5, e = F.tid & 31; int s = pst[e] + bef[e];
#pragma unroll
        for (int w2 = 0; w2 < 7; ++w2) s += (w2 < w) ? cnt[(F.blk * 8 + w2) * 32 + e] : 0;
        base[w * 32 + e] = s; }
    if (F.tid < 3) { const int i = F.blk + F.G * F.tid; if (i < 544) { int e = 0; for (int q = 0; q < 32; ++q) if (i * 256 >= pst[q] + (tot[q] + 255) / 256 * 256) e = q + 1; tile[i] = e < 31 ? e : 31; } }
    if (F.blk < 32) { const int e = F.blk; const int s0 = pst[e] + tot[e], s1 = pst[e] + (tot[e] + 255) / 256 * 256; for (int s = s0 + F.tid; s < s1; s += 512) rowtok[s] = 0; }
    __syncthreads();
    for (int it = 0;; ++it) {
        const int row0 = (it * F.G + F.blk) * 128; if (row0 >= T) break;
        const int wr0 = row0 + 16 * F.wave;
        const int ev = it == 0 ? ev0 : toke[wr0 * 4 + F.lane];
        for (int t = 0; t < 16; ++t) { const int row = wr0 + t; const int e = __shfl(ev, 4 * t + (F.lane & 3));
            if (F.lane < 4) { const int s = __hip_atomic_fetch_add(base + F.wave * 32 + e, 1, __ATOMIC_RELAXED, __HIP_MEMORY_SCOPE_WORKGROUP);
                toks[row * 4 + F.lane] = s; rowtok[s] = row; } }
    }
    __syncthreads();
}

DI void fp8x4_to_f32(unsigned w, float (&o)[4]) { typedef float f2_ __attribute__((ext_vector_type(2))); const f2_ a = __builtin_amdgcn_cvt_pk_f32_fp8(w, false), b = __builtin_amdgcn_cvt_pk_f32_fp8(w, true); o[0] = a[0]; o[1] = a[1]; o[2] = b[0]; o[3] = b[1]; }
DI void final_row_load(const bf16_t* X1B, const unsigned char* YA, int row, const i32x4 sl, int lane, u32x4 (&ya)[4], u32x4 (&x1)[2]) {
    const int c0 = 16 * lane;
#pragma unroll
    for (int k = 0; k < 4; ++k) ya[k] = *(const u32x4*)(YA + (size_t)sl[k] * 1024 + c0);
    x1[0] = *(const u32x4*)(X1B + (size_t)row * D + c0); x1[1] = *(const u32x4*)(X1B + (size_t)row * D + c0 + 8);
}
DI float final_row_mix(const f32x4 (&gtv)[4], const f32x4 gk, const u32x4 (&ya)[4], const u32x4 (&x1)[2], f32x4 (&xo)[4]) {
    float ss = 0.f;
#pragma unroll
    for (int q = 0; q < 4; ++q) {
        f32x4 m4 = (f32x4){0.f, 0.f, 0.f, 0.f};
#pragma unroll
        for (int k = 0; k < 4; ++k) { float y[4]; fp8x4_to_f32(ya[k][q], y); m4[0] += gk[k] * y[0]; m4[1] += gk[k] * y[1]; m4[2] += gk[k] * y[2]; m4[3] += gk[k] * y[3]; }
        f32x4 g4; const unsigned ga = x1[q >> 1][2 * (q & 1)], gb = x1[q >> 1][2 * (q & 1) + 1]; g4[0] = bflo(ga); g4[1] = bfhi(ga); g4[2] = bflo(gb); g4[3] = bfhi(gb);
        const f32x4 x2 = g4 + gtv[q] * m4; xo[q] = x2; ss += x2[0] * x2[0] + x2[1] * x2[1] + x2[2] * x2[2] + x2[3] * x2[3]; }
    return ss;
}
DI void phase_final(const Frame& F) {
    const bf16_t* X1B = (const bf16_t*)(F.ws + WS_CAT); const unsigned char* YA = (const unsigned char*)(F.ws + WS_YA); const int* toks = (const int*)(F.ws + WS_TOKS); const float* tokg = (const float*)(F.ws + WS_TOKG);
    const float* mod = (const float*)(F.ws + WS_MOD); const float* gfin = F.in[I_GFIN]; float* out = F.out;
    const int nwv = F.G * 8, wv = F.blk * 8 + F.wave, ngt = T / 4;
    if (wv >= ngt) return;
    f32x4 ggv[4];
#pragma unroll
    for (int q = 0; q < 4; ++q) ggv[q] = *(const f32x4*)(gfin + 16 * F.lane + 4 * q);
    i32x4 slv = *(const i32x4*)(toks + (size_t)(wv * 4 + (F.lane & 3)) * 4); f32x4 gkv = *(const f32x4*)(tokg + (size_t)(wv * 4 + (F.lane & 3)) * 4);
#pragma unroll 1
    for (int gi = wv; gi < ngt; gi += nwv) {
        const int row0 = gi * 4;
        const float* modgt = mod + (row0 >> 12) * 6144 + 5120;
        f32x4 gtv[4];
#pragma unroll
        for (int q = 0; q < 4; ++q) gtv[q] = *(const f32x4*)(modgt + 16 * F.lane + 4 * q);
        i32x4 s_[4]; f32x4 g_[4];
#define FIN_QB(r_) _Pragma("unroll") for (int k = 0; k < 4; ++k) { s_[r_][k] = __builtin_amdgcn_update_dpp(0, slv[k], (r_) * 0x55, 0xF, 0xF, false); g_[r_][k] = dpp_get0<(r_) * 0x55, 0xF>(gkv[k]); }
        FIN_QB(0) FIN_QB(1) FIN_QB(2) FIN_QB(3)
#undef FIN_QB
        const int gn = gi + nwv;
        if (gn < ngt) { slv = *(const i32x4*)(toks + (size_t)(gn * 4 + (F.lane & 3)) * 4); gkv = *(const f32x4*)(tokg + (size_t)(gn * 4 + (F.lane & 3)) * 4); }
        u32x4 ya_[4][4], x1_[4][2];
#pragma unroll
        for (int r = 0; r < 4; ++r) final_row_load(X1B, YA, row0 + r, s_[r], F.lane, ya_[r], x1_[r]);
        f32x4 xo[4][4]; float ss[4];
#pragma unroll
        for (int r = 0; r < 4; ++r) ss[r] = final_row_mix(gtv, g_[r], ya_[r], x1_[r], xo[r]);
#pragma unroll
        for (int r = 0; r < 4; ++r) ss[r] = wave_sum(ss[r]);
#pragma unroll
        for (int r = 0; r < 4; ++r) { const float rstd = rsqrtf(ss[r] * (1.0f / 1024.0f) + EPS);
#pragma unroll
            for (int q = 0; q < 4; ++q) *(f32x4*)(out + (size_t)(row0 + r) * D + 16 * F.lane + 4 * q) = xo[r][q] * rstd * ggv[q]; }
    }
}

__global__ void __launch_bounds__(512, 2) fwd_kernel(Args args) {
    extern __shared__ __attribute__((aligned(16))) unsigned char lds_raw[];
    Frame F;
    F.lds = (LAS unsigned char*)lds_raw; F.tid = threadIdx.x; F.lane = F.tid & 63; F.wave = __builtin_amdgcn_readfirstlane(F.tid >> 6);
    F.G = gridDim.x; F.blk = blockIdx.x; F.vcu = (F.G % 8 == 0) ? (F.blk % 8) * (F.G / 8) + F.blk / 8 : F.blk;
#pragma unroll
    for (int i = 0; i < 27; ++i) F.in[i] = args.in[i];
    F.out = args.out; F.ws = args.ws;
    volatile LAS unsigned* MISC = (volatile LAS unsigned*)(F.lds + MISC_OFF);
    if (F.tid < 64) MISC[F.tid] = 0u;
    __syncthreads();
    const int lo = args.ph_lo, hi = args.ph_hi;
    unsigned* barw = (unsigned*)(F.ws + WS_CTL) + CW_BAR;
    XcdBarrier bar; bar.bar = barw; bar.x = 0; bar.st = nullptr;
    if (hi - lo > 1) bar = xcd_barrier_post(barw, MISC + 8);
#ifndef PH_MASK
#define PH_MASK 0xfff
#endif
#define IN(k) (((PH_MASK >> (k)) & 1) && lo <= (k) && (k) < hi)
#define SEAM(k) do { if (IN(k) && IN((k) + 1)) xcd_barrier(bar); } while (0)
    LAS unsigned char* ring = F.lds;

    if (IN(0)) { phase0(F); } SEAM(0);
    if (IN(1)) { phase1(F); } SEAM(1);
    if (IN(2)) {
        pg8::Gemm g{(const bf16_t*)(F.ws + WS_H), (const bf16_t*)(F.ws + WS_WIN), 1024};
        pg8::SchedPlain S{T / 256, 6, F.G, F.vcu}; pg8::EpiBf16Plain E{(bf16_t*)(F.ws + WS_XP), 1536};
        pg8::gemm_phase(ring, g, S, E);
    } SEAM(2);
    if (IN(3)) { phase3(F); } SEAM(3);
    if (IN(4)) { phase4(F); } SEAM(4);
    if (IN(6)) {
        pg8::Gemm g{(const bf16_t*)(F.ws + WS_CAT), (const bf16_t*)(F.ws + WS_WOUT), 512};
        pg8::SchedPlain S{T / 256, 4, F.G, F.vcu}; pg8::EpiGmix E{(const float*)(F.ws + WS_MOD), (bf16_t*)(F.ws + WS_GMIX)};
        pg8::gemm_phase(ring, g, S, E);
        if (IN(7) && F.blk * 128 < T) router_image_load(F, (F.blk * 128) >> 12);
    } SEAM(6);
    if (IN(7)) { phase_router(F, (IN(6) && F.blk * 128 < T) ? (F.blk * 128) >> 12 : -1); } SEAM(7);
    if (IN(8)) { phase_slots(F); } SEAM(8);
    if (IN(9)) {
        pg8::Gemm g{(const bf16_t*)(F.ws + WS_H), (const bf16_t*)(F.ws + WS_WGU), 512};
        pg8::SchedMoe::setup(F.lds, (const int*)(F.ws + WS_TILE), (const int*)(F.ws + WS_ROWTOK), F.in[I_BGU], 8, F.G, F.vcu, F.tid, false);
        pg8::SchedMoe S{(LAS const int*)(F.lds + UT_OFF), (LAS const unsigned short*)(F.lds + RTL_OFF), 8, F.G, F.vcu, true}; pg8::EpiAct E{(LAS const float*)(F.lds + BL_OFF), (unsigned char*)(F.ws + WS_ACT)};
        pg8::gemm_phase(ring, g, S, E);
    }
    {
        int f9 = 0, rem9 = 0, wE = 0; bool pre = false;
        if (IN(10)) { const int nmt10 = __builtin_amdgcn_readfirstlane(((const int*)(F.ws + WS_TILE))[1000]); f9 = (nmt10 * 8) / 256; rem9 = (nmt10 * 8) % 256; wE = (256 - rem9) >> 3;
            pre = IN(9) && F.G == 256 && rem9 > 0 && f9 >= 2; }
        if (pre && F.vcu >= rem9) {
            const int e = F.vcu - rem9, te = e >> 2; const int ppn = e & 3, ppm = 32 * (f9 - 1 - te / wE) + 31 - te % wE;
            pg8::Gemm g{(const bf16_t*)(F.ws + WS_ACT), (const bf16_t*)(F.ws + WS_WDOWN), 512};
            pg8::SchedMoe::setup(F.lds, (const int*)(F.ws + WS_TILE), nullptr, F.in[I_BD], 4, F.G, F.vcu, F.tid, true, ppm, ppn, 0, 0);
            subset_barrier((unsigned*)(F.ws + WS_CTL) + CW_EARLY, (unsigned)(256 - rem9));
            pg8::SchedMoe S{(LAS const int*)(F.lds + UT_OFF), (LAS const unsigned short*)(F.lds + RTL_OFF), 4, F.G, F.vcu, false}; pg8::EpiDown E{(LAS const float*)(F.lds + BL_OFF), (unsigned char*)(F.ws + WS_YA)};
            pg8::gemm_phase(ring, g, S, E);
        }
        if (IN(10)) pg8::SchedMoe::setup(F.lds, (const int*)(F.ws + WS_TILE), nullptr, F.in[I_BD], 4, F.G, F.vcu, F.tid, true, -1, 0, pre ? f9 : 0, pre ? wE : 0);
        SEAM(9);
        if (IN(10)) {
            pg8::Gemm g{(const bf16_t*)(F.ws + WS_ACT), (const bf16_t*)(F.ws + WS_WDOWN), 512};
            pg8::SchedMoe S{(LAS const int*)(F.lds + UT_OFF), (LAS const unsigned short*)(F.lds + RTL_OFF), 4, F.G, F.vcu, false}; pg8::EpiDown E{(LAS const float*)(F.lds + BL_OFF), (unsigned char*)(F.ws + WS_YA)};
            pg8::gemm_phase(ring, g, S, E);
        }
    } SEAM(10);
    if (IN(11)) { phase_final(F); }
#undef IN
#undef SEAM
}

extern "C" void kernel_launch(void* const* d_in, const int* in_sizes, int n_in, void* d_out, int out_size, void* d_ws, size_t ws_size, hipStream_t stream) {
    static int grid = 0;
    if (grid == 0) {
        if (n_in != 27 || out_size != T * D || ws_size < WS_END) { fprintf(stderr, "kernel_launch: unexpected shapes (n_in %d out %d ws %zu)\n", n_in, out_size, ws_size); grid = -1; return; }
        int dev = 0, cus = 0, per_cu = 0;
        if (hipGetDevice(&dev) != hipSuccess || hipDeviceGetAttribute(&cus, hipDeviceAttributeMultiprocessorCount, dev) != hipSuccess) { grid = -1; return; }
        if (hipFuncSetAttribute((const void*)fwd_kernel, hipFuncAttributeMaxDynamicSharedMemorySize, LDS_BYTES) != hipSuccess) { fprintf(stderr, "kernel_launch: hipFuncSetAttribute failed\n"); grid = -1; return; }
        if (hipOccupancyMaxActiveBlocksPerMultiprocessor(&per_cu, (const void*)fwd_kernel, 512, LDS_BYTES) != hipSuccess || per_cu < 1) { fprintf(stderr, "kernel_launch: occupancy query says %d\n", per_cu); }
        (void)hipGetLastError();
        grid = cus;
    }
    if (grid < 0) return;
    (void)hipMemsetAsync((char*)d_ws + WS_CTL, 0, CTL_BYTES, stream);
    Args a{};
    for (int i = 0; i < 27; ++i) a.in[i] = (const float*)d_in[i];
    a.out = (float*)d_out; a.ws = (unsigned char*)d_ws;
#if N_LAUNCH_MODE == 1
    a.ph_lo = 0; a.ph_hi = NPHASE;
    hipLaunchKernelGGL(fwd_kernel, dim3(grid), dim3(512), LDS_BYTES, stream, a);
#else
    for (int p = 0; p < NPHASE; ++p) { a.ph_lo = p; a.ph_hi = p + 1; hipLaunchKernelGGL(fwd_kernel, dim3(grid), dim3(512), LDS_BYTES, stream, a); }
#endif
}
```
